# Optimizing an MI355X kernel written in HIP

```python
import jax, jax.numpy as jnp
from jax import lax
import numpy as np

D_MODEL = 1024
BATCH = 2
SEQ = 8192
DEPTH = 1

EXPAND = 2
D_INNER = EXPAND * D_MODEL
SSD_WIDTH = D_INNER // 2
ATT_WIDTH = D_INNER - SSD_WIDTH
SSD_HEAD_DIM = 64
SSD_HEADS = SSD_WIDTH // SSD_HEAD_DIM
N_GROUPS = 2
HEADS_PER_GROUP = SSD_HEADS // N_GROUPS
D_STATE = 128
CONV_WIDTH = 4
CHUNK = 128
ATT_HEAD_DIM = 64
ATT_HEADS = ATT_WIDTH // ATT_HEAD_DIM
Q_BLOCK = 128
PLE_DIM = 256
EPS = 1e-6
CONV_CH = SSD_WIDTH + 2 * N_GROUPS * D_STATE
IN_SPLITS = (SSD_WIDTH, CONV_CH, SSD_HEADS, ATT_WIDTH, ATT_WIDTH, ATT_WIDTH, ATT_WIDTH, ATT_HEADS)
IN_COLS = sum(IN_SPLITS)

kernel_name = "hymba_ssd_fox_hybrid_layer"


def _split_points(sizes):
    return [int(v) for v in np.cumsum(sizes)[:-1]]


def rms_norm(x, g):
    xf = x.astype(jnp.float32)
    y = xf * lax.rsqrt(jnp.mean(xf * xf, axis=-1, keepdims=True) + EPS)
    return (y * g.astype(jnp.float32)).astype(x.dtype)


def causal_depthwise_conv(u, w, b):
    out = lax.conv_general_dilated(
        u, w[:, None, :].astype(u.dtype), window_strides=(1,),
        padding=((CONV_WIDTH - 1, 0),), dimension_numbers=('NWC', 'WIO', 'NWC'),
        feature_group_count=u.shape[-1])
    return out + b.astype(u.dtype)


def ssd_scan(x, dt, a, b_mat, c_mat):
    bsz, seqlen = x.shape[0], x.shape[1]
    nc = seqlen // CHUNK
    f32 = jnp.float32
    xdt = (x.astype(f32) * dt[..., None]).reshape(
        bsz, nc, CHUNK, N_GROUPS, HEADS_PER_GROUP, SSD_HEAD_DIM)
    a_dt = (dt * a).reshape(bsz, nc, CHUNK, N_GROUPS, HEADS_PER_GROUP)
    a_cs = jnp.cumsum(jnp.moveaxis(a_dt, 2, -1), axis=-1)
    bm = b_mat.astype(f32).reshape(bsz, nc, CHUNK, N_GROUPS, D_STATE)
    cm = c_mat.astype(f32).reshape(bsz, nc, CHUNK, N_GROUPS, D_STATE)
    idx = jnp.arange(CHUNK)
    causal = idx[:, None] >= idx[None, :]
    seg = a_cs[..., :, None] - a_cs[..., None, :]
    decay = jnp.exp(jnp.where(causal, seg, -jnp.inf))
    cb = jnp.einsum('bclgn,bcsgn->bcgls', cm, bm)
    y_diag = jnp.einsum('bcgls,bcgrls,bcsgrp->bclgrp', cb, decay, xdt)
    decay_to_end = jnp.exp(a_cs[..., -1:] - a_cs)
    chunk_states = jnp.einsum('bclgn,bcgrl,bclgrp->bcgrpn', bm, decay_to_end, xdt)
    chunk_decay = jnp.exp(a_cs[..., -1])

    def step(h, inp):
        s_c, d_c = inp
        return h * d_c[..., None, None] + s_c, h

    h0 = jnp.zeros((bsz, N_GROUPS, HEADS_PER_GROUP, SSD_HEAD_DIM, D_STATE), f32)
    _, prev = lax.scan(step, h0, (jnp.moveaxis(chunk_states, 1, 0),
                                  jnp.moveaxis(chunk_decay, 1, 0)))
    prev = jnp.moveaxis(prev, 0, 1)
    y_off = jnp.einsum('bclgn,bcgrpn,bcgrl->bclgrp', cm, prev, jnp.exp(a_cs))
    return (y_diag + y_off).reshape(bsz, seqlen, SSD_HEADS, SSD_HEAD_DIM)


def forgetting_attention(q, k, v, log_f):
    bsz, seqlen = q.shape[0], q.shape[1]
    nblk = seqlen // Q_BLOCK
    cum = jnp.moveaxis(jnp.cumsum(log_f, axis=1), 1, 2)
    qh = jnp.moveaxis(q, 1, 2)
    kh = jnp.moveaxis(k, 1, 2)
    vh = jnp.moveaxis(v, 1, 2)
    scale = ATT_HEAD_DIM ** -0.5
    q_blocks = qh.reshape(bsz, ATT_HEADS, nblk, Q_BLOCK, ATT_HEAD_DIM).transpose(2, 0, 1, 3, 4)
    cq_blocks = cum.reshape(bsz, ATT_HEADS, nblk, Q_BLOCK).transpose(2, 0, 1, 3)
    kpos = jnp.arange(seqlen)
    starts = jnp.arange(nblk) * Q_BLOCK

    def block(args):
        qb, cqb, start = args
        s = jnp.einsum('bhqd,bhkd->bhqk', qb, kh,
                       preferred_element_type=jnp.float32) * scale
        s = s + cqb[..., None] - cum[:, :, None, :]
        qpos = start + jnp.arange(Q_BLOCK)
        s = jnp.where(qpos[:, None] >= kpos[None, :], s, -jnp.inf)
        pr = jax.nn.softmax(s, axis=-1)
        return jnp.einsum('bhqk,bhkd->bhqd', pr.astype(vh.dtype), vh)

    out = lax.map(block, (q_blocks, cq_blocks, starts))
    return out.transpose(1, 0, 3, 2, 4).reshape(bsz, seqlen, ATT_HEADS, ATT_HEAD_DIM)


def setup_inputs(seed: int = 0) -> dict:
    key = jax.random.key(seed)
    ks = jax.random.split(key, 20)
    f32 = jnp.float32
    nrm = lambda k, shape, s: (jax.random.normal(k, shape, f32) * s)
    x = jax.random.normal(ks[0], (BATCH, SEQ, D_MODEL), f32)
    p = jax.random.normal(ks[1], (DEPTH, BATCH, SEQ, PLE_DIM), f32)
    norm_g = 1.0 + nrm(ks[2], (DEPTH, D_MODEL), 0.02)
    w_in = nrm(ks[3], (DEPTH, D_MODEL, IN_COLS), D_MODEL ** -0.5)
    conv_w = nrm(ks[4], (DEPTH, CONV_WIDTH, CONV_CH), CONV_WIDTH ** -0.5)
    conv_b = nrm(ks[5], (DEPTH, CONV_CH), 0.02)
    dt0 = jnp.exp(jax.random.uniform(ks[6], (DEPTH, SSD_HEADS), f32,
                                     jnp.log(1e-3), jnp.log(1e-1)))
    dt_bias = dt0 + jnp.log(-jnp.expm1(-dt0))
    a_log = jnp.log(jax.random.uniform(ks[7], (DEPTH, SSD_HEADS), f32, 1.0, 16.0))
    d_skip = 1.0 + nrm(ks[8], (DEPTH, SSD_HEADS), 0.02)
    ssd_norm_g = 1.0 + nrm(ks[9], (DEPTH, SSD_WIDTH), 0.02)
    fg_bias = jax.random.uniform(ks[10], (DEPTH, ATT_HEADS), f32, 1.0, 5.0)
    att_norm_g = 1.0 + nrm(ks[11], (DEPTH, ATT_HEAD_DIM), 0.02)
    w_out = nrm(ks[12], (DEPTH, D_INNER, D_MODEL), D_INNER ** -0.5)
    ple_norm_g = 1.0 + nrm(ks[13], (DEPTH, D_MODEL), 0.02)
    w_ple_gate = nrm(ks[14], (DEPTH, D_MODEL, D_MODEL), D_MODEL ** -0.5)
    w_ple_proj = nrm(ks[15], (DEPTH, PLE_DIM, D_MODEL), PLE_DIM ** -0.5)
    final_norm_g = 1.0 + nrm(ks[16], (D_MODEL,), 0.02)
    return {"x": x, "p": p, "norm_g": norm_g, "w_in": w_in, "conv_w": conv_w,
            "conv_b": conv_b, "dt_bias": dt_bias, "a_log": a_log, "d_skip": d_skip,
            "ssd_norm_g": ssd_norm_g, "fg_bias": fg_bias, "att_norm_g": att_norm_g,
            "w_out": w_out, "ple_norm_g": ple_norm_g, "w_ple_gate": w_ple_gate,
            "w_ple_proj": w_ple_proj, "final_norm_g": final_norm_g}


def reference(x, p, norm_g, w_in, conv_w, conv_b, dt_bias, a_log, d_skip, ssd_norm_g,
              fg_bias, att_norm_g, w_out, ple_norm_g, w_ple_gate, w_ple_proj, final_norm_g):
    f32 = jnp.float32
    bsz, seqlen = x.shape[0], x.shape[1]
    in_pts = _split_points(IN_SPLITS)
    h = x
    for i in range(DEPTH):
        u = rms_norm(h, norm_g[i])
        proj = u @ w_in[i]
        z_ssd, xbc, dt_raw, z_att, q, k, v, f_raw = jnp.split(proj, in_pts, axis=-1)

        xbc = jax.nn.silu(causal_depthwise_conv(xbc, conv_w[i], conv_b[i]))
        xs, bm, cm = jnp.split(xbc, [SSD_WIDTH, SSD_WIDTH + N_GROUPS * D_STATE], axis=-1)
        xs = xs.reshape(bsz, seqlen, SSD_HEADS, SSD_HEAD_DIM)
        bm = bm.reshape(bsz, seqlen, N_GROUPS, D_STATE)
        cm = cm.reshape(bsz, seqlen, N_GROUPS, D_STATE)
        dt = jax.nn.softplus(dt_raw.astype(f32) + dt_bias[i].astype(f32))
        a = -jnp.exp(a_log[i].astype(f32))
        y = ssd_scan(xs, dt, a, bm, cm)
        y = y + d_skip[i].astype(f32)[:, None] * xs.astype(f32)
        y = y.reshape(bsz, seqlen, SSD_WIDTH).astype(x.dtype) * jax.nn.silu(z_ssd)
        y = rms_norm(y.reshape(bsz, seqlen, N_GROUPS, SSD_WIDTH // N_GROUPS),
                     ssd_norm_g[i].reshape(N_GROUPS, SSD_WIDTH // N_GROUPS))
        y_ssd = y.reshape(bsz, seqlen, SSD_WIDTH)

        log_f = jax.nn.log_sigmoid(f_raw.astype(f32) + fg_bias[i].astype(f32))
        hs = (bsz, seqlen, ATT_HEADS, ATT_HEAD_DIM)
        att = forgetting_attention(q.reshape(hs), k.reshape(hs), v.reshape(hs), log_f)
        att = rms_norm(att, att_norm_g[i])
        y_att = att.reshape(bsz, seqlen, ATT_WIDTH) * jax.nn.silu(z_att)

        h = h + jnp.concatenate([y_ssd, y_att], axis=-1) @ w_out[i]

        gate = jax.nn.sigmoid(rms_norm(h, ple_norm_g[i]) @ w_ple_gate[i])
        h = h + gate * (p[i].astype(h.dtype) @ w_ple_proj[i])
    return rms_norm(h, final_norm_g)
```

```cpp
#include <hip/hip_runtime.h>
#include <cstdio>
#include <cstdint>
namespace pg8 {
#define PG8_LAS __attribute__((address_space(3)))
typedef unsigned short bf16_t;
typedef short bf16x8 __attribute__((ext_vector_type(8)));
typedef float f32x4 __attribute__((ext_vector_type(4)));
typedef unsigned u32x4 __attribute__((ext_vector_type(4)));
constexpr int BM = 256, BK = 64, HALF = 128, HTB = HALF * BK * 2  , STAGE_BYTES = 8 * HTB, NXCD = 8, WGM = 8;

__host__ __device__ __forceinline__ int lds_byte(int r, int c) { const int st = (r >> 4) * 2 + (c >> 5), rr = r & 15, cc = c & 31, ob = rr * 64 + cc * 2; return st * 1024 + (ob ^ (((ob >> 9) & 1) << 5)); }
__host__ __device__ __forceinline__ void stage_rc(int b, int& R, int& C) { const int st = b / 1024, sb = b % 1024, swz = sb ^ (((sb >> 9) & 1) << 5); R = (st >> 1) * 16 + swz / 64; C = (st & 1) * 32 + (swz % 64) / 2; }
__host__ __device__ __forceinline__ int perm32(int rho) { const int n = rho >> 4, i = rho & 15; return 8 * (i >> 2) + 4 * n + (i & 3); }

struct Unit { int pm, pn; };
struct Gemm { const bf16_t* A; const bf16_t* Bt; int M, N, K; int lda; int ksplit; long asadj; };

struct StaticOrder {
    int nM, nN, nwg, G, c;
    __host__ __device__ void init(int M, int N, int G_, int c_) { nM = M / BM; nN = N / BM; nwg = nM * nN; G = G_; c = c_; }
    __host__ __device__ bool next(int i, Unit& u) const {
        const long L = (long)i * G + c; if (L >= nwg) return false;
        int wgid = (int)L; { const int q = nwg / NXCD, r = nwg % NXCD, xcd = wgid % NXCD, off = wgid / NXCD; wgid = (xcd < r ? xcd * (q + 1) : r * (q + 1) + (xcd - r) * q) + off; }
        const int nig = WGM * nN, gid = wgid / nig, fm = gid * WGM, gsz = (nM - fm) < WGM ? (nM - fm) : WGM;
        u.pm = fm + ((wgid % nig) % gsz); u.pn = (wgid % nig) / gsz; return true;
    }
    __device__ __forceinline__ void a_ready(const Unit&) const {}
    __device__ __forceinline__ void done(const Unit&) const {}
};

__device__ __forceinline__ unsigned cvt_pk_bf16(float lo, float hi) { unsigned r; asm volatile("v_cvt_pk_bf16_f32 %0, %1, %2" : "=v"(r) : "v"(lo), "v"(hi)); return r; }
typedef float f32x2 __attribute__((ext_vector_type(2)));
__device__ __forceinline__ f32x2 gelu_pk(f32x2 v) {
    const f32x2 av = __builtin_elementwise_abs(v), d = av * 0.2316418882f + 1.0f;
    f32x2 t; t.x = __builtin_amdgcn_rcpf(d.x); t.y = __builtin_amdgcn_rcpf(d.y);
    f32x2 q = t * 0.5307027145f + (-0.7265760135f); q = q * t + 0.7107068705f; q = q * t + (-0.142248368f); q = q * t + 0.127414796f; q = q * t;
    const f32x2 s = (v * v) * (-0.72134752044f);
    f32x2 e; e.x = __builtin_amdgcn_exp2f(s.x); e.y = __builtin_amdgcn_exp2f(s.y);
    const f32x2 m = v * (q * e), r = v - m;
    f32x2 o; o.x = v.x < 0.f ? m.x : r.x; o.y = v.y < 0.f ? m.y : r.y; return o;
}

template <int ACT  > struct EpiBf16 {
    static constexpr bool PERM = true, AFTER_DRAIN = false; static_assert(ACT == 0 || ACT == 1, "EpiBf16: ACT is 0 (none) or 1 (gelu_pk)");
    bf16_t* O; int ldc; const float* bias; int split_cols; size_t split_stride; float scale0;
    __device__ __forceinline__ void operator()(const f32x4 (&acc)[2][2][4][2], const Unit& u, int wr, int wc, int fr, int fq) const {
        const int row0 = u.pm * BM + wr * 64 + fr; int colt = u.pn * BM; bf16_t* base = O;
        float sc = 1.f; if (split_cols) { const int t = colt / split_cols; base += (size_t)t * split_stride; colt -= t * split_cols; if (t == 0) sc = scale0; }
        const int col0 = colt + wc * 32 + 8 * fq, bcol0 = u.pn * BM + wc * 32 + 8 * fq;
        f32x4 bv[2][2];
#pragma unroll
        for (int bj = 0; bj < 2; ++bj)
#pragma unroll
            for (int n = 0; n < 2; ++n) bv[bj][n] = bias ? *(const f32x4*)(bias + bcol0 + bj * HALF + 4 * n) : (f32x4){0.f, 0.f, 0.f, 0.f};
#pragma unroll
        for (int ai = 0; ai < 2; ++ai)
#pragma unroll
            for (int m = 0; m < 4; ++m) { bf16_t* rowp = base + (size_t)(row0 + ai * HALF + m * 16) * ldc + col0;
#pragma unroll
                for (int bj = 0; bj < 2; ++bj) { f32x4 v0 = acc[ai][bj][m][0] + bv[bj][0], v1 = acc[ai][bj][m][1] + bv[bj][1];
                    if (ACT == 1) { f32x2 a = gelu_pk((f32x2){v0[0], v0[1]}), b = gelu_pk((f32x2){v0[2], v0[3]}), c = gelu_pk((f32x2){v1[0], v1[1]}), d = gelu_pk((f32x2){v1[2], v1[3]});
                        v0 = (f32x4){a.x, a.y, b.x, b.y}; v1 = (f32x4){c.x, c.y, d.x, d.y}; }
                    v0 = v0 * sc; v1 = v1 * sc; u32x4 w; w.x = cvt_pk_bf16(v0[0], v0[1]); w.y = cvt_pk_bf16(v0[2], v0[3]); w.z = cvt_pk_bf16(v1[0], v1[1]); w.w = cvt_pk_bf16(v1[2], v1[3]);
                    *(u32x4*)(rowp + bj * HALF) = w; } }
    }
};

struct PanelStats {
    unsigned* xbuf;
    unsigned* cnt;
    unsigned* tmo;
    int ntn; float eps;
    unsigned code;
    __device__ __forceinline__ bool run(const f32x4 (&v)[2][2][4][2], const Unit& u, int wr, int wc, int fr, int fq, PG8_LAS unsigned char* lds, int wid, int lane) const {
        typedef float f32x2v __attribute__((ext_vector_type(2)));
        PG8_LAS f32x2v* P = (PG8_LAS f32x2v*)lds;
        PG8_LAS f32x2v* S = (PG8_LAS f32x2v*)(lds + 8192);
        PG8_LAS unsigned* flag = (PG8_LAS unsigned*)(lds + 8192 + 2048);
#pragma unroll
        for (int ai = 0; ai < 2; ++ai)
#pragma unroll
            for (int m = 0; m < 4; ++m) {
                float s = 0.f;
#pragma unroll
                for (int bj = 0; bj < 2; ++bj)
#pragma unroll
                    for (int n = 0; n < 2; ++n) { const f32x4 x = v[ai][bj][m][n]; s += (x[0] + x[1]) + (x[2] + x[3]); }
                s += __shfl_xor(s, 16); s += __shfl_xor(s, 32);
                const float mw = s * (1.0f / 64.0f); float q = 0.f;
#pragma unroll
                for (int bj = 0; bj < 2; ++bj)
#pragma unroll
                    for (int n = 0; n < 2; ++n) { const f32x4 d = v[ai][bj][m][n] - mw; q += (d[0] * d[0] + d[1] * d[1]) + (d[2] * d[2] + d[3] * d[3]); }
                q += __shfl_xor(q, 16); q += __shfl_xor(q, 32);
                if (fq == 0) P[(ai * HALF + wr * 64 + m * 16 + fr) * 4 + wc] = (f32x2v){mw, q};
            }
        asm volatile("s_waitcnt lgkmcnt(0)" ::: "memory"); __builtin_amdgcn_s_barrier(); asm volatile("" ::: "memory");
#if defined(BROKEN_EXCHANGE_NO_WAIT)
#warning BROKEN CONTROL BUILD: the row-statistics exchange does not wait; results are wrong by design
        if (blockIdx.x >= 64) { const long long t0_ = clock64(); while (clock64() - t0_ < 60000) __builtin_amdgcn_s_sleep(8); }
#endif
        const int row = wid * 32 + (lane & 31);
        if (lane < 32) {
            const f32x2v a = P[row * 4 + 0], b = P[row * 4 + 1], c = P[row * 4 + 2], d = P[row * 4 + 3];
            const float mt = (a.x + b.x + c.x + d.x) * 0.25f;
            const float da = a.x - mt, db = b.x - mt, dc = c.x - mt, dd = d.x - mt;
            const float m2 = (a.y + b.y) + (c.y + d.y) + 64.0f * ((da * da + db * db) + (dc * dc + dd * dd));
            unsigned long long* slot = (unsigned long long*)xbuf + ((size_t)(u.pm * BM + row) * 4 + u.pn);
            __hip_atomic_store(slot, ((unsigned long long)__float_as_uint(m2) << 32) | __float_as_uint(mt), __ATOMIC_RELAXED, __HIP_MEMORY_SCOPE_AGENT);
        }
        asm volatile("s_waitcnt vmcnt(0)" ::: "memory");
        if (lane == 0) __hip_atomic_fetch_add(cnt + 64 * u.pm, 1u, __ATOMIC_RELAXED, __HIP_MEMORY_SCOPE_AGENT);
        if (wid == 0) {
            bool dead = false; const unsigned long long t0 = __builtin_amdgcn_s_memrealtime(); const unsigned want = 8u * (unsigned)ntn;
            for (;;) {
#if defined(BROKEN_EXCHANGE_NO_WAIT)
                break;
#endif
                if ((unsigned)__builtin_amdgcn_readfirstlane(__hip_atomic_load(cnt + 64 * u.pm, __ATOMIC_RELAXED, __HIP_MEMORY_SCOPE_AGENT)) >= want) break;
                if (__builtin_amdgcn_s_memrealtime() - t0 > 2000000ull) {
                    if (lane == 0) { unsigned expect = 0u; __hip_atomic_compare_exchange_strong(tmo + 1, &expect, code | (unsigned)(u.pm & 0xff), __ATOMIC_RELAXED, __ATOMIC_RELAXED, __HIP_MEMORY_SCOPE_AGENT);
                                     __hip_atomic_store(tmo, 1u, __ATOMIC_RELAXED, __HIP_MEMORY_SCOPE_AGENT); }
                    dead = true; break; }
                __builtin_amdgcn_s_sleep(2);
            }
            __builtin_amdgcn_fence(__ATOMIC_ACQUIRE, "agent");
            if (lane == 0) flag[0] = dead ? 1u : 0u;
        }
        asm volatile("s_waitcnt vmcnt(0) lgkmcnt(0)" ::: "memory"); __builtin_amdgcn_s_barrier(); asm volatile("" ::: "memory");
        const bool bad = flag[0] != 0u;
        if (lane < 32) {
            const unsigned long long* slot = (const unsigned long long*)xbuf + (size_t)(u.pm * BM + row) * 4; float mt[4], m2[4]; float ms = 0.f;
#pragma unroll
            for (int t = 0; t < 4; ++t) { if (t < ntn) { const unsigned long long w = __hip_atomic_load(slot + t, __ATOMIC_RELAXED, __HIP_MEMORY_SCOPE_AGENT); mt[t] = __uint_as_float((unsigned)w); m2[t] = __uint_as_float((unsigned)(w >> 32)); } else { mt[t] = 0.f; m2[t] = 0.f; } ms += mt[t]; }
            const float mean = ms / (float)ntn; float q = 0.f;
#pragma unroll
            for (int t = 0; t < 4; ++t) if (t < ntn) { const float dm = mt[t] - mean; q += m2[t] + 256.0f * dm * dm; }
            S[row] = (f32x2v){mean, 1.0f / sqrtf(q / (256.0f * (float)ntn) + eps)};
        }
        asm volatile("s_waitcnt lgkmcnt(0)" ::: "memory"); __builtin_amdgcn_s_barrier(); asm volatile("" ::: "memory");
        return bad;
    }
};
struct EpiLnRes {
    static constexpr bool PERM = false, AFTER_DRAIN = true;
    const float* base; float* out; int ldc; const float* bias; PanelStats st; unsigned poison;
    __device__ __forceinline__ void fused(f32x4 (&acc)[2][2][4][2], const Unit& u, int wr, int wc, int fr, int fq, PG8_LAS unsigned char* lds, int wid, int lane) const {
        typedef float f32x2v __attribute__((ext_vector_type(2)));
        const PG8_LAS f32x2v* S = (const PG8_LAS f32x2v*)(lds + 8192);
        const int col0 = u.pn * BM + wc * 32 + 4 * fq;
#pragma unroll
        for (int bj = 0; bj < 2; ++bj)
#pragma unroll
            for (int n = 0; n < 2; ++n) { const f32x4 bv = bias ? *(const f32x4*)(bias + col0 + bj * HALF + n * 16) : (f32x4){0.f, 0.f, 0.f, 0.f};
#pragma unroll
                for (int ai = 0; ai < 2; ++ai)
#pragma unroll
                    for (int m = 0; m < 4; ++m) acc[ai][bj][m][n] += bv; }
        f32x4 pre[4][2][2];
#pragma unroll
        for (int m = 0; m < 4; ++m) { const size_t off = (size_t)(u.pm * BM + wr * 64 + m * 16 + fr) * ldc + col0;
#pragma unroll
            for (int bj = 0; bj < 2; ++bj)
#pragma unroll
                for (int n = 0; n < 2; ++n) pre[m][bj][n] = *(const f32x4*)(base + off + bj * HALF + n * 16); }
        const bool bad = st.run(acc, u, wr, wc, fr, fq, lds, wid, lane) || poison != 0u;
        const float qnan = __builtin_nanf("");
#pragma unroll
        for (int ai = 0; ai < 2; ++ai)
#pragma unroll
            for (int m = 0; m < 4; ++m) { const int r = ai * HALF + wr * 64 + m * 16 + fr; const f32x2v sr = S[r]; const size_t off = (size_t)(u.pm * BM + r) * ldc + col0;
#pragma unroll
                for (int bj = 0; bj < 2; ++bj)
#pragma unroll
                    for (int n = 0; n < 2; ++n) { const f32x4 bs = ai == 0 ? pre[m][bj][n] : *(const f32x4*)(base + off + bj * HALF + n * 16); f32x4 o = bs + (acc[ai][bj][m][n] - sr.x) * sr.y;
                        if (bad) o = (f32x4){qnan, qnan, qnan, qnan}; *(f32x4*)(out + off + bj * HALF + n * 16) = o; }
                if (m & 1) asm volatile("" ::: "memory"); }
    }
};
struct EpiLnResLn {
    static constexpr bool PERM = false, AFTER_DRAIN = true;
    const float* base; float* out; bf16_t* xn; int ldc; const float* bias; PanelStats st1, st2; unsigned poison;
    __device__ __forceinline__ void fused(f32x4 (&acc)[2][2][4][2], const Unit& u, int wr, int wc, int fr, int fq, PG8_LAS unsigned char* lds, int wid, int lane) const {
        typedef float f32x2v __attribute__((ext_vector_type(2))); typedef unsigned u32x2v __attribute__((ext_vector_type(2)));
        const PG8_LAS f32x2v* S = (const PG8_LAS f32x2v*)(lds + 8192);
        const int col0 = u.pn * BM + wc * 32 + 4 * fq;
#pragma unroll
        for (int bj = 0; bj < 2; ++bj)
#pragma unroll
            for (int n = 0; n < 2; ++n) { const f32x4 bv = bias ? *(const f32x4*)(bias + col0 + bj * HALF + n * 16) : (f32x4){0.f, 0.f, 0.f, 0.f};
#pragma unroll
                for (int ai = 0; ai < 2; ++ai)
#pragma unroll
                    for (int m = 0; m < 4; ++m) acc[ai][bj][m][n] += bv; }
        bool bad = st1.run(acc, u, wr, wc, fr, fq, lds, wid, lane) || poison != 0u;
        const float qnan = __builtin_nanf("");
#pragma unroll
        for (int ai = 0; ai < 2; ++ai)
#pragma unroll
            for (int m = 0; m < 4; ++m) { const int r = ai * HALF + wr * 64 + m * 16 + fr; const f32x2v sr = S[r]; const size_t off = (size_t)(u.pm * BM + r) * ldc + col0;
#pragma unroll
                for (int bj = 0; bj < 2; ++bj)
#pragma unroll
                    for (int n = 0; n < 2; ++n) { const f32x4 bs = *(const f32x4*)(base + off + bj * HALF + n * 16); acc[ai][bj][m][n] = bs + (acc[ai][bj][m][n] - sr.x) * sr.y; }
                asm volatile("" : "+v"(acc[ai][0][m][0]), "+v"(acc[ai][0][m][1]), "+v"(acc[ai][1][m][0]), "+v"(acc[ai][1][m][1]));
                if (m & 1) asm volatile("" ::: "memory"); }
        const bool bad1 = bad;
        bad = st2.run(acc, u, wr, wc, fr, fq, lds, wid, lane) || bad;
#pragma unroll
        for (int ai = 0; ai < 2; ++ai)
#pragma unroll
            for (int m = 0; m < 4; ++m) { const int r = ai * HALF + wr * 64 + m * 16 + fr; const f32x2v sr = S[r]; const size_t off = (size_t)(u.pm * BM + r) * ldc + col0;
#pragma unroll
                for (int bj = 0; bj < 2; ++bj)
#pragma unroll
                    for (int n = 0; n < 2; ++n) { const f32x4 x1 = acc[ai][bj][m][n]; *(f32x4*)(out + off + bj * HALF + n * 16) = bad1 ? (f32x4){qnan, qnan, qnan, qnan} : x1;
                        const f32x4 o = (x1 - sr.x) * sr.y; u32x2v w; w.x = cvt_pk_bf16(o[0], o[1]); w.y = cvt_pk_bf16(o[2], o[3]);
                        if (bad) { w.x = 0x7fc07fc0u; w.y = 0x7fc07fc0u; } *(u32x2v*)(xn + off + bj * HALF + n * 16) = w; }
                asm volatile("" ::: "memory"); }
    }
};

template <class Epi, class Sched, bool ALIGN_EPI = false, bool SP2 = false>
__device__ __forceinline__ void gemm_phase(PG8_LAS unsigned char* lds, const Gemm g, const Sched& S, const Epi& E) {
    static_assert(SP2, "only the SP2 loop carries the lda / split-A changes");
    const int tid = threadIdx.x, wid = __builtin_amdgcn_readfirstlane(tid >> 6), lane = tid & 63, wr = wid >> 2, wc = wid & 3, fr = lane & 15, fq = lane >> 4;
    const int K = g.K, nt = K / BK;
    unsigned voffA[2], voffB[2];
#pragma unroll
    for (int i = 0; i < 2; ++i) { int R, C; stage_rc(tid * 16 + i * 8192, R, C); const int Rb = Epi::PERM ? ((R & ~31) + perm32(R & 31)) : R;
        voffA[i] = (unsigned)(R * g.lda + C) * 2u; voffB[i] = (unsigned)(Rb * K + C) * 2u; }
    const size_t kstep = (size_t)(BK * 2);
    const size_t hstep = (size_t)HALF * K * 2, hstepA = (size_t)HALF * g.lda * 2;
    const size_t tstep = 2 * hstep, tstepA = 2 * hstepA; const int ksplit = g.ksplit; const long asadj = g.asadj;
    const unsigned ldsw = (unsigned)wid * 1024u;
    const int aoff = lds_byte(wr * 64 + fr, fq * 8), boff = lds_byte(wc * 32 + fr, fq * 8);
#define PG8_SA(b, h) (((b) * 2 + (h)) * HTB)
#define PG8_SB(b, h) ((4 + (b) * 2 + (h)) * HTB)
#define PG8_STAGE(bufoff, gbase, voff) do { _Pragma("unroll") for (int _i = 0; _i < 2; ++_i) \
        __builtin_amdgcn_global_load_lds((const unsigned*)((const char*)(gbase) + (voff)[_i]), (PG8_LAS unsigned*)(lds + (bufoff) + ldsw + _i * 8192), 16, 0, 0); } while (0)
#define PG8_LDA(dst, b, h) do { _Pragma("unroll") for (int m = 0; m < 4; ++m) _Pragma("unroll") for (int k = 0; k < 2; ++k) dst[m][k] = *(const PG8_LAS bf16x8*)(lds + PG8_SA(b, h) + aoff + m * 2048 + k * 1024); } while (0)
#define PG8_LDB(dst, b, h) do { _Pragma("unroll") for (int n = 0; n < 2; ++n) _Pragma("unroll") for (int k = 0; k < 2; ++k) dst[n][k] = *(const PG8_LAS bf16x8*)(lds + PG8_SB(b, h) + boff + n * 2048 + k * 1024); } while (0)
#define PG8_MMA(ai, bj, At, Bt) do { __builtin_amdgcn_s_setprio(1); _Pragma("unroll") for (int m = 0; m < 4; ++m) _Pragma("unroll") for (int n = 0; n < 2; ++n) _Pragma("unroll") for (int k = 0; k < 2; ++k) \
        acc[ai][bj][m][n] = __builtin_amdgcn_mfma_f32_16x16x32_bf16(Bt[n][k], At[m][k], acc[ai][bj][m][n], 0, 0, 0); __builtin_amdgcn_s_setprio(0); } while (0)
#define PG8_WAIT_V(n) asm volatile("s_waitcnt vmcnt(" #n ")" ::: "memory")
#define PG8_WAIT_L(n) asm volatile("s_waitcnt lgkmcnt(" #n ")" ::: "memory")
#define PG8_BAR __builtin_amdgcn_s_barrier()
#define PG8_SCHED __builtin_amdgcn_sched_barrier(0)
    Unit cur, nxt; int ui = 0;
    if (!S.next(0, cur)) return;
    f32x4 acc[2][2][4][2];
#pragma unroll
    for (int a = 0; a < 2; ++a)
#pragma unroll
        for (int b = 0; b < 2; ++b)
#pragma unroll
            for (int m = 0; m < 4; ++m)
#pragma unroll
                for (int n = 0; n < 2; ++n) acc[a][b][m][n] = (f32x4){0.f, 0.f, 0.f, 0.f};
    bf16x8 At[4][2], B0[2][2], B1[2][2];
    const char* cA = (const char*)g.A + (size_t)cur.pm * tstepA; const char* cB = (const char*)g.Bt + (size_t)cur.pn * tstep;
    S.a_ready(cur);
    if constexpr (SP2) {
        PG8_STAGE(PG8_SB(0, 0), cB, voffB); PG8_STAGE(PG8_SB(0, 1), cB + hstep, voffB); PG8_STAGE(PG8_SA(0, 0), cA, voffA); PG8_STAGE(PG8_SA(0, 1), cA + hstepA, voffA);
        if (wr == 1) PG8_BAR;
        PG8_WAIT_V(2); PG8_BAR;
        PG8_STAGE(PG8_SB(1, 0), cB + kstep, voffB); PG8_STAGE(PG8_SA(1, 0), cA + kstep, voffA); PG8_STAGE(PG8_SB(1, 1), cB + hstep + kstep, voffB);
        PG8_WAIT_V(6); PG8_BAR;
    } else {
        PG8_STAGE(PG8_SB(0, 0), cB, voffB); PG8_STAGE(PG8_SA(0, 0), cA, voffA); PG8_STAGE(PG8_SB(0, 1), cB + hstep, voffB); PG8_STAGE(PG8_SA(0, 1), cA + hstep, voffA);
        if (wr == 1) PG8_BAR;
        PG8_WAIT_V(4); PG8_BAR;
        PG8_STAGE(PG8_SB(1, 0), cB + kstep, voffB); PG8_STAGE(PG8_SA(1, 0), cA + kstep, voffA); PG8_STAGE(PG8_SB(1, 1), cB + hstep + kstep, voffB);
        PG8_WAIT_V(6); PG8_BAR;
    }
    for (;;) {
        const bool has_next = S.next(ui + 1, nxt);
        const char* nA = has_next ? (const char*)g.A + (size_t)nxt.pm * tstepA : cA; const char* nB = has_next ? (const char*)g.Bt + (size_t)nxt.pn * tstep : cB;
        for (int t = 0; t < nt; t += 2) {
            const bool last = (t == nt - 2);
            const char* a1 = cA + (size_t)(t + 1) * kstep + ((t + 1) >= ksplit ? asadj : 0);
            const char* a2 = last ? nA : cA + (size_t)(t + 2) * kstep + ((t + 2) >= ksplit ? asadj : 0); const char* b2 = last ? nB : cB + (size_t)(t + 2) * kstep;
            const char* a3 = a2 + kstep; const char* b3 = b2 + kstep;
            if (last && has_next) S.a_ready(nxt);
            if constexpr (SP2) {
            PG8_LDB(B0, 0, 0); PG8_LDB(B1, 0, 1); PG8_SCHED; PG8_LDA(At, 0, 0); PG8_STAGE(PG8_SA(1, 1), a1 + hstepA, voffA);
            PG8_WAIT_V(8); PG8_WAIT_L(0); PG8_BAR; PG8_MMA(0, 0, At, B0); PG8_MMA(0, 1, At, B1); PG8_BAR; PG8_SCHED;
            PG8_LDA(At, 0, 1); PG8_STAGE(PG8_SB(0, 0), b2, voffB); PG8_STAGE(PG8_SB(0, 1), b2 + hstep, voffB); PG8_STAGE(PG8_SA(0, 0), a2, voffA);
            PG8_WAIT_V(8); PG8_WAIT_L(0); PG8_BAR; PG8_MMA(1, 0, At, B0); PG8_MMA(1, 1, At, B1); PG8_BAR; PG8_SCHED;
            PG8_LDB(B0, 1, 0); PG8_LDB(B1, 1, 1); PG8_SCHED; PG8_LDA(At, 1, 0); PG8_STAGE(PG8_SA(0, 1), a2 + hstepA, voffA);
            PG8_WAIT_V(8); PG8_WAIT_L(0); PG8_BAR; PG8_MMA(0, 0, At, B0); PG8_MMA(0, 1, At, B1); PG8_BAR; PG8_SCHED;
            PG8_LDA(At, 1, 1); PG8_STAGE(PG8_SB(1, 0), b3, voffB); PG8_STAGE(PG8_SB(1, 1), b3 + hstep, voffB); PG8_STAGE(PG8_SA(1, 0), a3, voffA);
            PG8_WAIT_V(8); PG8_WAIT_L(0); PG8_BAR; PG8_MMA(1, 0, At, B0); PG8_MMA(1, 1, At, B1); PG8_BAR; PG8_SCHED;
            } else {
            PG8_LDB(B0, 0, 0); PG8_SCHED; PG8_LDA(At, 0, 0); PG8_STAGE(PG8_SA(1, 1), a1 + hstep, voffA);
            PG8_WAIT_L(8); PG8_BAR; PG8_WAIT_L(0); PG8_MMA(0, 0, At, B0); PG8_BAR; PG8_SCHED;
            PG8_LDB(B1, 0, 1); PG8_STAGE(PG8_SB(0, 0), b2, voffB);
            PG8_BAR; PG8_WAIT_L(0); PG8_MMA(0, 1, At, B1); PG8_BAR;
            PG8_LDA(At, 0, 1); PG8_STAGE(PG8_SA(0, 0), a2, voffA);
            PG8_BAR; PG8_WAIT_L(0); PG8_MMA(1, 0, At, B0); PG8_BAR; PG8_SCHED;
            PG8_STAGE(PG8_SB(0, 1), b2 + hstep, voffB);
            PG8_WAIT_V(6); PG8_BAR; PG8_MMA(1, 1, At, B1); PG8_BAR;
            PG8_LDB(B0, 1, 0); PG8_SCHED; PG8_LDA(At, 1, 0); PG8_STAGE(PG8_SA(0, 1), a2 + hstep, voffA);
            PG8_WAIT_L(8); PG8_BAR; PG8_WAIT_L(0); PG8_MMA(0, 0, At, B0); PG8_BAR; PG8_SCHED;
            PG8_LDB(B1, 1, 1); PG8_STAGE(PG8_SB(1, 0), b3, voffB);
            PG8_BAR; PG8_WAIT_L(0); PG8_MMA(0, 1, At, B1); PG8_BAR;
            PG8_LDA(At, 1, 1); PG8_STAGE(PG8_SA(1, 0), a3, voffA);
            PG8_BAR; PG8_WAIT_L(0); PG8_MMA(1, 0, At, B0); PG8_BAR; PG8_SCHED;
            PG8_STAGE(PG8_SB(1, 1), b3 + hstep, voffB);
            PG8_WAIT_V(6); PG8_BAR; PG8_MMA(1, 1, At, B1); PG8_BAR;
            }
        }
        if constexpr (ALIGN_EPI) { if (wr == 0) PG8_BAR; }
        if constexpr (!Epi::AFTER_DRAIN) { E(acc, cur, wr, wc, fr, fq); S.done(cur); }
        if (!has_next) break;
#pragma unroll
        for (int a = 0; a < 2; ++a)
#pragma unroll
            for (int b = 0; b < 2; ++b)
#pragma unroll
                for (int m = 0; m < 4; ++m)
#pragma unroll
                    for (int n = 0; n < 2; ++n) acc[a][b][m][n] = (f32x4){0.f, 0.f, 0.f, 0.f};
        cur = nxt; cA = nA; cB = nB; ++ui;
        if constexpr (ALIGN_EPI) { if (wr == 1) PG8_BAR; }
    }
    PG8_WAIT_V(0);
    if constexpr (!ALIGN_EPI) { if (wr == 0) PG8_BAR; }
    PG8_BAR;
    if constexpr (Epi::AFTER_DRAIN) { E.fused(acc, cur, wr, wc, fr, fq, lds, wid, lane); S.done(cur); }
#undef PG8_SA
#undef PG8_SB
#undef PG8_STAGE
#undef PG8_LDA
#undef PG8_LDB
#undef PG8_MMA
#undef PG8_WAIT_V
#undef PG8_WAIT_L
#undef PG8_BAR
#undef PG8_SCHED
}
}

#ifndef PG8_SP2
#define PG8_SP2 true
#endif
#ifndef PG8_ALIGN
#define PG8_ALIGN true
#endif
#include <hip/hip_bf16.h>
#include <cmath>
namespace attn_body {
using bf16=__hip_bfloat16;
using bf16x8=__attribute__((ext_vector_type(8)))short;
using s16x4=__attribute__((ext_vector_type(4)))short;
using f32x16=__attribute__((ext_vector_type(16)))float;
using u32x4=__attribute__((ext_vector_type(4)))unsigned;
constexpr int BATCH=2,NHEAD=16,SEQ=8192,D=64,DM=NHEAD*D;
constexpr int NW=8,QBLK=32,QB=QBLK*NW,KVBLK=64,NQB=SEQ/QB;
constexpr int ATTN_PITCH=DM, ATTN_UNIT_ROWS=QB;
__device__ __forceinline__ int crow(int r,int hi){return (r&3)+8*(r>>2)+4*hi;}
#define SBAR() __builtin_amdgcn_sched_barrier(0)
__device__ __forceinline__ void cmask(f32x16&p0,f32x16&p1,int jb,int qrel,int hi){
  const float NEG=-INFINITY; int kb=64*jb+4*hi;
  #pragma unroll
  for(int r=0;r<16;++r){int kv=kb+(r&3)+8*(r>>2); if(kv>qrel)p0[r]=NEG; if(kv+32>qrel)p1[r]=NEG;}
}

constexpr int NSLOT=3, SLOTB=8192;
constexpr int LDS_K=0, LDS_V=NSLOT*SLOTB, LDS_WS=2*NSLOT*SLOTB, LDS_OST=LDS_WS+NW*64*4, LDS_BIAS=LDS_OST+NW*4096, LDS_BYTES=LDS_BIAS+SEQ*4;
constexpr float C2=0.125f*1.4426950408889634f;
__device__ __forceinline__ void glds16(const void*gsrc,unsigned lds_dst){unsigned keep;
  asm volatile("s_mov_b32 %0, m0\n\ts_mov_b32 m0, %2\n\ts_nop 0\n\tglobal_load_lds_dwordx4 %1, off\n\ts_mov_b32 m0, %0":"=&s"(keep):"v"(gsrc),"s"(lds_dst):"memory");}
__device__ __forceinline__ float max3f(float a,float b,float c){float r;asm("v_max3_f32 %0, %1, %2, %3":"=v"(r):"v"(a),"v"(b),"v"(c));return r;}
__device__ __forceinline__ float max2f(float a,float b){float r;asm("v_max_f32_e32 %0, %1, %2":"=v"(r):"v"(a),"v"(b));return r;}
__device__ __forceinline__ float fadd_s(float a,float b){float r;asm("v_add_f32_e32 %0, %1, %2":"=v"(r):"v"(a),"v"(b));return r;}
__device__ __forceinline__ float fsub_s(float a,float b){float r;asm("v_sub_f32_e32 %0, %1, %2":"=v"(r):"v"(a),"v"(b));return r;}
typedef float f32x2_t __attribute__((ext_vector_type(2))); typedef __bf16 bf16x2_t __attribute__((ext_vector_type(2)));
__device__ __forceinline__ unsigned cvtpk_s(float lo,float hi){f32x2_t v={lo,hi};bf16x2_t b=__builtin_convertvector(v,bf16x2_t);return __builtin_bit_cast(unsigned,b);}
#define WAIT_BAR(N) asm volatile("s_waitcnt vmcnt(" #N ") lgkmcnt(0)\n\ts_barrier":::"memory")

__device__ __forceinline__ void qkt(f32x16&p0,f32x16&p1,const char*Kslot,const bf16x8*qr,int r32,int hi){
  const char*kb=Kslot+hi*1024+r32*16;
  #pragma unroll
  for(int d0=0;d0<4;++d0){
    const bf16x8 b0=*reinterpret_cast<const bf16x8*>(kb+d0*2048);
    const bf16x8 b1=*reinterpret_cast<const bf16x8*>(kb+d0*2048+512);
    {p0=__builtin_amdgcn_mfma_f32_32x32x16_bf16(b0,qr[d0],p0,0,0,0);p1=__builtin_amdgcn_mfma_f32_32x32x16_bf16(b1,qr[d0],p1,0,0,0);}}
}
typedef __attribute__((address_space(3))) const char* lds_cptr;
typedef short v4i16_t __attribute__((ext_vector_type(4)));
__device__ __forceinline__ void kload8(bf16x8*kf,lds_cptr kp){
  kf[0]=*(const __attribute__((address_space(3))) bf16x8*)(kp);      kf[1]=*(const __attribute__((address_space(3))) bf16x8*)(kp+512);
  kf[2]=*(const __attribute__((address_space(3))) bf16x8*)(kp+2048); kf[3]=*(const __attribute__((address_space(3))) bf16x8*)(kp+2560);
  kf[4]=*(const __attribute__((address_space(3))) bf16x8*)(kp+4096); kf[5]=*(const __attribute__((address_space(3))) bf16x8*)(kp+4608);
  kf[6]=*(const __attribute__((address_space(3))) bf16x8*)(kp+6144); kf[7]=*(const __attribute__((address_space(3))) bf16x8*)(kp+6656);
}
__device__ __forceinline__ void kload2(bf16x8*kf,lds_cptr kp,int j){ kf[2*j]=*(const __attribute__((address_space(3))) bf16x8*)(kp+j*2048); kf[2*j+1]=*(const __attribute__((address_space(3))) bf16x8*)(kp+j*2048+512); }
__device__ __forceinline__ s16x4 vtr(lds_cptr p){ return __builtin_bit_cast(s16x4,__builtin_amdgcn_ds_read_tr16_b64_v4i16((__attribute__((address_space(3))) v4i16_t*)p)); }
__device__ __forceinline__ float rowmax(const f32x16&p0,const f32x16&p1){
  float a=max3f(p0[0],p0[1],p1[0]),b=max3f(p0[2],p0[3],p1[1]);a=max3f(a,p1[2],p1[3]);
  #pragma unroll
  for(int r=4;r<16;r+=4){a=max3f(a,p0[r],p0[r+1]);b=max3f(b,p0[r+2],p0[r+3]);a=max3f(a,p1[r],p1[r+1]);b=max3f(b,p1[r+2],p1[r+3]);}
  const float m=max2f(a,b);
  auto rr=__builtin_amdgcn_permlane32_swap(__float_as_uint(m),__float_as_uint(m),false,false);
  return max2f(__uint_as_float(rr[0]),__uint_as_float(rr[1]));
}
__device__ __forceinline__ void pv(f32x16*o,int vb,bf16x8 pa0,bf16x8 pa1,bf16x8 pa2,bf16x8 pa3){
  #pragma unroll
  for(int d0=0;d0<2;++d0){s16x4 lo[4],hi[4];
    #pragma unroll
    for(int ks=0;ks<4;++ks){
      asm volatile("ds_read_b64_tr_b16 %0,%1 offset:%c2":"=&v"(lo[ks]):"v"(vb),"i"(d0*4096+ks*1024):"memory");
      asm volatile("ds_read_b64_tr_b16 %0,%1 offset:%c2":"=&v"(hi[ks]):"v"(vb),"i"(d0*4096+ks*1024+512):"memory");}
    asm volatile("s_waitcnt lgkmcnt(0)":::"memory");SBAR();
    #define PK(k) (bf16x8){lo[k][0],lo[k][1],lo[k][2],lo[k][3],hi[k][0],hi[k][1],hi[k][2],hi[k][3]}
    o[d0]=__builtin_amdgcn_mfma_f32_32x32x16_bf16(pa0,PK(0),o[d0],0,0,0);
    o[d0]=__builtin_amdgcn_mfma_f32_32x32x16_bf16(pa1,PK(1),o[d0],0,0,0);
    o[d0]=__builtin_amdgcn_mfma_f32_32x32x16_bf16(pa2,PK(2),o[d0],0,0,0);
    o[d0]=__builtin_amdgcn_mfma_f32_32x32x16_bf16(pa3,PK(3),o[d0],0,0,0);
    #undef PK
  }
}

#ifndef ATTN_STORE16
#define ATTN_STORE16(p,v) (*(u32x4*)(p)=(v))
#endif
typedef float f32x4v __attribute__((ext_vector_type(4)));
template<int THRL> __device__ __forceinline__ void attn_unit(int b,int h,int qb,const bf16*Q,const bf16*__restrict__ K,const bf16*__restrict__ V,bf16*O,const float*FB,const bf16*Z,const float*GN,char*shm){
  const int tid=threadIdx.x,lane=tid&63,r32=lane&31,hi=lane>>5; const int wid=__builtin_amdgcn_readfirstlane(tid>>6);
  const long rowbase=(long)b*SEQ; const int q0=qb*QB;
  const bf16*Qw=Q+(rowbase+q0+wid*QBLK)*DM+h*D;
  const bf16*Kh=K+rowbase*DM+h*D,*Vh=V+rowbase*DM+h*D;
  const unsigned lds0=(unsigned)(uintptr_t)shm;
  float*wsf=(float*)(shm+LDS_WS)+wid*64;
  const bf16*ksrc=Kh+(long)lane*DM+wid*8;
  const bf16*vsrc=Vh+(long)(16*(wid&3)+(lane>>2))*DM+(wid>>2)*32+(lane&3)*8;
  const unsigned kdst=lds0+LDS_K+wid*1024, vdst=lds0+LDS_V+wid*1024;
  #define DMA_K(t,slot) glds16(ksrc+(long)(t)*KVBLK*DM,(unsigned)__builtin_amdgcn_readfirstlane(kdst+(slot)))
  #define DMA_V(t,slot) glds16(vsrc+(long)(t)*KVBLK*DM,(unsigned)__builtin_amdgcn_readfirstlane(vdst+(slot)))
  const int vb0=(int)(lds0+LDS_V)+((lane>>4)&1)*32+(lane&3)*8+(4*hi+((lane&15)>>2))*64;
  const char*Kbase=shm+LDS_K; bf16x8 kf[8];
  const lds_cptr shm3=(lds_cptr)shm; const lds_cptr kp0=shm3+LDS_K+hi*1024+r32*16; const lds_cptr vp0=shm3+LDS_V+((lane>>4)&1)*32+(lane&3)*8+(4*hi+((lane&15)>>2))*64;
  const int NT=(q0+QB)/KVBLK;
  { const float*fbh=FB+((long)b*NHEAD+h)*SEQ; __attribute__((address_space(3))) float*bl=(__attribute__((address_space(3))) float*)((__attribute__((address_space(3))) char*)shm+LDS_BIAS);
    for(int i=tid*4;i<NT*KVBLK;i+=NW*64*4) *(__attribute__((address_space(3))) f32x4v*)(bl+i)=*(const f32x4v*)(fbh+i); }
  const __attribute__((address_space(3))) float*biasL=(const __attribute__((address_space(3))) float*)(shm3+LDS_BIAS)+4*hi;
  DMA_K(0,0);DMA_V(0,0);DMA_K(1,SLOTB);
  bf16x8 qr[4];
  #pragma unroll
  for(int d0=0;d0<4;++d0)qr[d0]=*reinterpret_cast<const bf16x8*>(&Qw[(long)r32*DM+d0*16+hi*8]);
  float mhat=0.f,l_reg=0.f;f32x16 o[2];o[0]=f32x16{};o[1]=f32x16{};
  const int qrel=wid*QBLK+r32;
  #define CMASK(P0,P1,t) do{int jb_=(t)-(NT-4); if(jb_>=0)cmask(P0,P1,jb_,qrel,hi);}while(0)
  bool resc=false;
  #define START(P0,P1) do{ const float rm=rowmax(P0,P1); resc=false; \
    { const float dl=rm; mhat=fadd_s(mhat,dl); \
      _Pragma("unroll") for(int r=0;r<16;++r){P0[r]=fsub_s(P0[r],dl);P1[r]=fsub_s(P1[r],dl);} \
 } \
    _Pragma("unroll") for(int r=0;r<16;++r)P0[r]=__builtin_amdgcn_exp2f(P0[r]); }while(0)
  #define RESC() do{ if(resc){ asm volatile("s_waitcnt lgkmcnt(0)":::"memory"); \
      _Pragma("unroll") for(int d_=0;d_<2;++d_) _Pragma("unroll") for(int r=0;r<16;++r)o[d_][r]*=wsf[crow(r,hi)]; } }while(0)
  #define BIASINIT(C0,C1,t) do{ const __attribute__((address_space(3))) float*bp_=biasL+64*(t); \
    _Pragma("unroll") for(int g_=0;g_<4;++g_){ const f32x4v u0_=*(const __attribute__((address_space(3))) f32x4v*)(bp_+8*g_); const f32x4v u1_=*(const __attribute__((address_space(3))) f32x4v*)(bp_+32+8*g_); \
      _Pragma("unroll") for(int j_=0;j_<4;++j_){ C0[4*g_+j_]=u0_[j_]-mhat; C1[4*g_+j_]=u1_[j_]-mhat; } } }while(0)
  f32x16 pA0,pA1,pB0,pB1;
  int sl_prev=0,sl_cur=0,sl_next=SLOTB;
  #define ROT() do{sl_prev=sl_cur;sl_cur=sl_next;sl_next=(sl_next==(NSLOT-1)*SLOTB)?0:sl_next+SLOTB;}while(0)
  DMA_K(2,2*SLOTB);
  WAIT_BAR(3);
  BIASINIT(pA0,pA1,0); qkt(pA0,pA1,Kbase,qr,r32,hi);asm volatile("s_nop 15\n\ts_nop 7":"+v"(pA0),"+v"(pA1));CMASK(pA0,pA1,0);
  START(pA0,pA1);
  _Pragma("unroll") for(int r=0;r<16;++r)pA1[r]=__builtin_amdgcn_exp2f(pA1[r]);
  WAIT_BAR(0);
  DMA_K(3,0);DMA_V(1,SLOTB);
  ROT();
  kload8(kf,kp0+sl_cur);
  WAIT_BAR(2);
  s16x4 vlo[8],vhi[8]; u32x4 pw0,pw1,pw2,pw3;
  #define PKW(P,B) cvtpk_s(P[B],P[B+1])
  #define PAF(k) __builtin_bit_cast(bf16x8,pw##k)
  #define VFR(i) (bf16x8){vlo[i][0],vlo[i][1],vlo[i][2],vlo[i][3],vhi[i][0],vhi[i][1],vhi[i][2],vhi[i][3]}
  #define PIN(x) asm volatile("":"+v"(x))
  #define MX3(a,b,c) __builtin_fmaxf(__builtin_fmaxf((a),(b)),(c))
  #define GAPA(MF,A0,A1,A2,A3,W0,W1,PW) do{ MF; sacc+=A0; sacc+=A1; sacc+=A2; sacc+=A3; PIN(sacc); W0; W1; PIN(PW); SBAR(); }while(0)
  #define EX(v) __builtin_amdgcn_exp2f(v)
  #define GAPB(MF,X,B) do{ MF; X[B]=EX(X[B]); X[B+1]=EX(X[B+1]); X[B+2]=EX(X[B+2]); X[B+3]=EX(X[B+3]); PIN(X); SBAR(); }while(0)
  #define VRD(i) do{ vlo[i]=vtr(vp_+(((i)>>2)*4096+((i)&3)*1024)); vhi[i]=vtr(vp_+(((i)>>2)*4096+((i)&3)*1024+512)); }while(0)
  #define KRD(G,j) do{ if(G){ kload2(kf,kp0+sl_next,j); SBAR(); } }while(0)
  #define STEP(C0,C1,P0,P1,t,GK,GV,GL) do{ SBAR(); BIASINIT(C0,C1,t); SBAR(); \
    const lds_cptr vp_=vp0+sl_prev; \
    VRD(0); SBAR(); float sacc=(P0[0]+P0[1]); \
    GAPA(C0=__builtin_amdgcn_mfma_f32_32x32x16_bf16(kf[0],qr[0],C0,0,0,0), P0[2],P0[3],P0[4],P0[5],     pw0[0]=PKW(P0,0), pw0[1]=PKW(P0,2), pw0); \
    VRD(4); SBAR(); GAPA(C1=__builtin_amdgcn_mfma_f32_32x32x16_bf16(kf[1],qr[0],C1,0,0,0), P0[6],P0[7],P0[8],P0[9],     pw0[2]=PKW(P0,4), pw0[3]=PKW(P0,6), pw0); \
    VRD(1); SBAR(); GAPA(C0=__builtin_amdgcn_mfma_f32_32x32x16_bf16(kf[2],qr[1],C0,0,0,0),   P0[10],P0[11],P0[12],P0[13], pw1[0]=PKW(P0,8), pw1[1]=PKW(P0,10), pw1); \
    VRD(5); SBAR(); GAPA(C1=__builtin_amdgcn_mfma_f32_32x32x16_bf16(kf[3],qr[1],C1,0,0,0),   P0[14],P0[15],P1[0],P1[1],   pw1[2]=PKW(P0,12),pw1[3]=PKW(P0,14), pw1); \
    VRD(2); SBAR(); GAPA(C0=__builtin_amdgcn_mfma_f32_32x32x16_bf16(kf[4],qr[2],C0,0,0,0),   P1[2],P1[3],P1[4],P1[5],     pw2[0]=PKW(P1,0), pw2[1]=PKW(P1,2), pw2); \
    VRD(6); SBAR(); GAPA(C1=__builtin_amdgcn_mfma_f32_32x32x16_bf16(kf[5],qr[2],C1,0,0,0),   P1[6],P1[7],P1[8],P1[9],     pw2[2]=PKW(P1,4), pw2[3]=PKW(P1,6), pw2); \
    VRD(3); SBAR(); GAPA(C0=__builtin_amdgcn_mfma_f32_32x32x16_bf16(kf[6],qr[3],C0,0,0,0),   P1[10],P1[11],P1[12],P1[13], pw3[0]=PKW(P1,8), pw3[1]=PKW(P1,10), pw3); \
    VRD(7); SBAR(); GAPA(C1=__builtin_amdgcn_mfma_f32_32x32x16_bf16(kf[7],qr[3],C1,0,0,0),   P1[14],P1[15],0.f,0.f,       pw3[2]=PKW(P1,12),pw3[3]=PKW(P1,14), pw3); \
    l_reg+=sacc; \
    if(GK){DMA_K((t)+3,sl_cur);} if(GV){DMA_V((t)+1,sl_next);} \
    CMASK(C0,C1,t); \
    { float a=MX3(C0[0],C0[1],C1[0]),b=MX3(C0[2],C0[3],C1[1]); a=MX3(a,C1[2],C1[3]); \
      _Pragma("unroll") for(int r=4;r<16;r+=4){a=MX3(a,C0[r],C0[r+1]);b=MX3(b,C0[r+2],C0[r+3]);a=MX3(a,C1[r],C1[r+1]);b=MX3(b,C1[r+2],C1[r+3]);} \
      float rm=__builtin_fmaxf(a,b); { auto rr=__builtin_amdgcn_permlane32_swap(__float_as_uint(rm),__float_as_uint(rm),false,false); rm=__builtin_fmaxf(__uint_as_float(rr[0]),__uint_as_float(rr[1])); } \
      resc=false; \
      if(__builtin_expect(__any(rm>(float)THRL),0)){ const float dl=__builtin_fmaxf(rm,0.f); mhat+=dl; \
        _Pragma("unroll") for(int r=0;r<16;++r){C0[r]-=dl;C1[r]-=dl;} \
        const float f=__builtin_amdgcn_exp2f(-dl); l_reg*=f; if(hi==0)wsf[r32]=f; resc=true; } } \
    SBAR(); \
    GAPB(o[0]=__builtin_amdgcn_mfma_f32_32x32x16_bf16(PAF(0),VFR(0),o[0],0,0,0), C0,0); \
    GAPB(o[1]=__builtin_amdgcn_mfma_f32_32x32x16_bf16(PAF(0),VFR(4),o[1],0,0,0), C0,4); \
    KRD(GL,0); GAPB(o[0]=__builtin_amdgcn_mfma_f32_32x32x16_bf16(PAF(1),VFR(1),o[0],0,0,0), C0,8); \
    KRD(GL,1); GAPB(o[1]=__builtin_amdgcn_mfma_f32_32x32x16_bf16(PAF(1),VFR(5),o[1],0,0,0), C0,12); \
    KRD(GL,2); GAPB(o[0]=__builtin_amdgcn_mfma_f32_32x32x16_bf16(PAF(2),VFR(2),o[0],0,0,0), C1,0); \
    KRD(GL,3); GAPB(o[1]=__builtin_amdgcn_mfma_f32_32x32x16_bf16(PAF(2),VFR(6),o[1],0,0,0), C1,4); \
    GAPB(o[0]=__builtin_amdgcn_mfma_f32_32x32x16_bf16(PAF(3),VFR(3),o[0],0,0,0), C1,8); \
    GAPB(o[1]=__builtin_amdgcn_mfma_f32_32x32x16_bf16(PAF(3),VFR(7),o[1],0,0,0), C1,12); \
    }while(0)
  int t=1;
  #undef CMASK
  #define CMASK(P0,P1,t) do{}while(0)
  for(;t+5<NT;t+=2){
    STEP(pB0,pB1,pA0,pA1,t,true,true,true);     WAIT_BAR(2); RESC(); ROT();
    STEP(pA0,pA1,pB0,pB1,t+1,true,true,true);   WAIT_BAR(2); RESC(); ROT();
  }
  #undef CMASK
  #define CMASK(P0,P1,t) do{int jb_=(t)-(NT-4); if(jb_>=0)cmask(P0,P1,jb_,qrel,hi);}while(0)
  #define ENDW(tt) do{ if((tt)+3<NT){WAIT_BAR(2);} else if((tt)+2<NT){WAIT_BAR(1);} else {WAIT_BAR(0);} }while(0)
  for(;t+1<NT;t+=2){
    STEP(pB0,pB1,pA0,pA1,t,(t+3<NT),(t+1<NT),(t+1<NT));       ENDW(t);   RESC(); ROT();
    STEP(pA0,pA1,pB0,pB1,t+1,(t+4<NT),(t+2<NT),(t+2<NT));     ENDW(t+1); RESC(); ROT();
  }
  STEP(pB0,pB1,pA0,pA1,NT-1,false,false,false); RESC();
  { float sacc=pB0[0]+pB0[1]; _Pragma("unroll") for(int r=2;r<16;++r)sacc+=pB0[r]; _Pragma("unroll") for(int r=0;r<16;++r)sacc+=pB1[r]; l_reg+=sacc;
    pw0=(u32x4){PKW(pB0,0),PKW(pB0,2),PKW(pB0,4),PKW(pB0,6)};pw1=(u32x4){PKW(pB0,8),PKW(pB0,10),PKW(pB0,12),PKW(pB0,14)};pw2=(u32x4){PKW(pB1,0),PKW(pB1,2),PKW(pB1,4),PKW(pB1,6)};pw3=(u32x4){PKW(pB1,8),PKW(pB1,10),PKW(pB1,12),PKW(pB1,14)};
    SBAR(); pv(o,vb0+sl_cur,PAF(0),PAF(1),PAF(2),PAF(3)); }
  #undef PKW
  #undef PAF
  #undef VFR
  #undef PIN
  #undef MX3
  #undef GAPA
  #undef GAPB
  #undef EX
  #undef VRD
  #undef KRD
  #undef STEP
  #undef ENDW
  {auto rr=__builtin_amdgcn_permlane32_swap(__float_as_uint(l_reg),__float_as_uint(l_reg),false,false);l_reg=__uint_as_float(rr[0])+__uint_as_float(rr[1]);}
  if(hi==0)wsf[32+r32]=l_reg;asm volatile("s_waitcnt lgkmcnt(0)":::"memory");
  float rli[16];
  #pragma unroll
  for(int r=0;r<16;++r)rli[r]=__builtin_amdgcn_rcpf(wsf[32+crow(r,hi)]);
  bf16*Ow=O+(rowbase+q0+wid*QBLK)*DM+h*D; const bf16*Zw=Z+(rowbase+q0+wid*QBLK)*DM+h*D;
  { bf16*stg=(bf16*)(shm+LDS_OST)+wid*2048;
    #pragma unroll
    for(int r=0;r<16;++r){const int orow=crow(r,hi);
      #pragma unroll
      for(int d0=0;d0<2;++d0)stg[orow*64+d0*32+r32]=__float2bfloat16(o[d0][r]*rli[r]);}
    asm volatile("s_waitcnt lgkmcnt(0)":::"memory");
    #pragma unroll
    for(int i=0;i<4;++i){const int row=i*8+(lane>>3),ch=lane&7; const u32x4 v=*(const u32x4*)(stg+row*64+ch*8); const u32x4 zz=*(const u32x4*)(Zw+(long)row*DM+ch*8);
      float a[8]; float ss=0.f;
      _Pragma("unroll") for(int j=0;j<4;++j){a[2*j]=__uint_as_float(v[j]<<16);a[2*j+1]=__uint_as_float(v[j]&0xffff0000u);ss+=a[2*j]*a[2*j]+a[2*j+1]*a[2*j+1];}
      ss+=__shfl_xor(ss,1);ss+=__shfl_xor(ss,2);ss+=__shfl_xor(ss,4);
      const float rs=rsqrtf(ss*(1.f/64.f)+1e-6f); u32x4 w;
      _Pragma("unroll") for(int j=0;j<4;++j){const float z0=__uint_as_float(zz[j]<<16),z1=__uint_as_float(zz[j]&0xffff0000u);
        const float y0=a[2*j]*rs*GN[ch*8+2*j]*(z0/(1.f+__expf(-z0))), y1=a[2*j+1]*rs*GN[ch*8+2*j+1]*(z1/(1.f+__expf(-z1))); w[j]=cvtpk_s(y0,y1);}
      ATTN_STORE16(Ow+(long)row*DM+ch*8,w);} }
  asm volatile("s_waitcnt lgkmcnt(0)\n\ts_barrier":::"memory");
  #undef BIASINIT
  #undef DMA_K
  #undef DMA_V
  #undef CMASK
  #undef START
  #undef RESC
  #undef ROT
}
constexpr int ATTN_LDS_BYTES=LDS_BYTES;
struct AttnTensors { const bf16* Q; const bf16* K; const bf16* V; bf16* O; const float* FB; const bf16* Z; const float* GN; };
struct AttnUnit { int bh; int qb; };
struct StaticOrder {
  int vcu;
  __device__ __forceinline__ explicit StaticOrder(int grid,int block):vcu((block%8)*(grid/8)+block/8){}
  __device__ __forceinline__ bool next(int i,AttnUnit&u)const{ if(i>=4)return false; const int s=vcu&7; u.bh=vcu>>3; u.qb=(i==0)?s:(i==1)?15-s:(i==2)?16+s:31-s; return true; }
  __device__ __forceinline__ void a_ready(const AttnUnit&)const{}
  __device__ __forceinline__ void done(const AttnUnit&)const{}
};
template<class Sched,int THRL=8> __device__ __forceinline__ void attn_phase(char*lds,const AttnTensors&T,const Sched&S){
  AttnUnit u;
  for(int i=0;S.next(i,u);++i){ S.a_ready(u); attn_unit<THRL>(u.bh/NHEAD,u.bh%NHEAD,u.qb,T.Q,T.K,T.V,T.O,T.FB,T.Z,T.GN,lds); S.done(u); }
}
#undef SBAR
#undef WAIT_BAR
}
namespace pg8 {
typedef unsigned u32x2 __attribute__((ext_vector_type(2)));
__device__ __forceinline__ float bf_lo(unsigned w) { return __uint_as_float(w << 16); }
__device__ __forceinline__ float bf_hi(unsigned w) { return __uint_as_float(w & 0xffff0000u); }
struct EpiIn {
    static constexpr bool PERM = true, AFTER_DRAIN = false;
    bf16_t *ZS, *XBC, *ZA, *Q, *K, *V; float* DTF; float qscale;
    __device__ __forceinline__ void operator()(const f32x4 (&acc)[2][2][4][2], const Unit& u, int wr, int wc, int fr, int fq) const {
        const int pn = u.pn; const int row0 = u.pm * BM + wr * 64 + fr;
        if (pn == 26) {
            if (wc == 0) {
#pragma unroll
                for (int ai = 0; ai < 2; ++ai)
#pragma unroll
                    for (int m = 0; m < 4; ++m) { float* rowp = DTF + (size_t)(row0 + ai * HALF + m * 16) * 32 + 8 * fq;
                        *(f32x4*)(rowp) = acc[ai][0][m][0]; *(f32x4*)(rowp + 4) = acc[ai][0][m][1]; }
            }
            return;
        }
        bf16_t* base; int ldc, colt; float sc = 1.f;
        if (pn < 4) { base = ZS; ldc = 1024; colt = pn * 256; }
        else if (pn < 10) { base = XBC; ldc = 1536; colt = (pn - 4) * 256; }
        else if (pn < 14) { base = ZA; ldc = 1024; colt = (pn - 10) * 256; }
        else if (pn < 18) { base = Q; ldc = 1024; colt = (pn - 14) * 256; sc = qscale; }
        else if (pn < 22) { base = K; ldc = 1024; colt = (pn - 18) * 256; }
        else { base = V; ldc = 1024; colt = (pn - 22) * 256; }
        const int col0 = colt + wc * 32 + 8 * fq;
#pragma unroll
        for (int ai = 0; ai < 2; ++ai)
#pragma unroll
            for (int m = 0; m < 4; ++m) { bf16_t* rowp = base + (size_t)(row0 + ai * HALF + m * 16) * ldc + col0;
#pragma unroll
                for (int bj = 0; bj < 2; ++bj) { const f32x4 v0 = acc[ai][bj][m][0] * sc, v1 = acc[ai][bj][m][1] * sc;
                    u32x4 w; w.x = cvt_pk_bf16(v0[0], v0[1]); w.y = cvt_pk_bf16(v0[2], v0[3]); w.z = cvt_pk_bf16(v1[0], v1[1]); w.w = cvt_pk_bf16(v1[2], v1[3]);
                    *(u32x4*)(rowp + bj * HALF) = w; } }
    }
};
struct EpiRes {
    static constexpr bool PERM = false, AFTER_DRAIN = false;
    const float* base; float* out; int ldc;
    __device__ __forceinline__ void operator()(const f32x4 (&acc)[2][2][4][2], const Unit& u, int wr, int wc, int fr, int fq) const {
        const int col0 = u.pn * BM + wc * 32 + 4 * fq;
#pragma unroll
        for (int ai = 0; ai < 2; ++ai)
#pragma unroll
            for (int m = 0; m < 4; ++m) { const size_t off = (size_t)(u.pm * BM + ai * HALF + wr * 64 + m * 16 + fr) * ldc + col0;
#pragma unroll
                for (int bj = 0; bj < 2; ++bj)
#pragma unroll
                    for (int n = 0; n < 2; ++n) { const size_t o = off + bj * HALF + n * 16; *(f32x4*)(out + o) = *(const f32x4*)(base + o) + acc[ai][bj][m][n]; } }
    }
};
struct EpiGate {
    static constexpr bool PERM = false, AFTER_DRAIN = false;
    float* io; const bf16_t* PP; int ldc;
    __device__ __forceinline__ void operator()(const f32x4 (&acc)[2][2][4][2], const Unit& u, int wr, int wc, int fr, int fq) const {
        const int col0 = u.pn * BM + wc * 32 + 4 * fq;
#pragma unroll
        for (int ai = 0; ai < 2; ++ai)
#pragma unroll
            for (int m = 0; m < 4; ++m) { const size_t off = (size_t)(u.pm * BM + ai * HALF + wr * 64 + m * 16 + fr) * ldc + col0;
#pragma unroll
                for (int bj = 0; bj < 2; ++bj)
#pragma unroll
                    for (int n = 0; n < 2; ++n) { const size_t o = off + bj * HALF + n * 16; const f32x4 h = *(const f32x4*)(io + o); const u32x2 pw = *(const u32x2*)(PP + o);
                        const f32x4 a = acc[ai][bj][m][n]; f32x4 r;
                        r[0] = h[0] + bf_lo(pw.x) / (1.f + __expf(-a[0])); r[1] = h[1] + bf_hi(pw.x) / (1.f + __expf(-a[1]));
                        r[2] = h[2] + bf_lo(pw.y) / (1.f + __expf(-a[2])); r[3] = h[3] + bf_hi(pw.y) / (1.f + __expf(-a[3]));
                        *(f32x4*)(io + o) = r; } }
    }
};
}

namespace ssd {
#define LAS3 __attribute__((address_space(3)))
typedef unsigned short bf16_t;
typedef short bf16x8 __attribute__((ext_vector_type(8)));
typedef float f32x2 __attribute__((ext_vector_type(2)));
typedef float f32x4 __attribute__((ext_vector_type(4)));
typedef float f32x16 __attribute__((ext_vector_type(16)));
typedef unsigned u32x2 __attribute__((ext_vector_type(2)));
typedef unsigned u32x4 __attribute__((ext_vector_type(4)));
typedef __bf16 bf16x2_t __attribute__((ext_vector_type(2)));
__device__ __forceinline__ unsigned pk(float lo, float hi) { f32x2 v = {lo, hi}; bf16x2_t b = __builtin_convertvector(v, bf16x2_t); return __builtin_bit_cast(unsigned, b); }
__device__ __forceinline__ float bf1(bf16_t b) { return __uint_as_float((unsigned)b << 16); }
__device__ __forceinline__ float lo(unsigned w) { return __uint_as_float(w << 16); }
__device__ __forceinline__ float hi16(unsigned w) { return __uint_as_float(w & 0xffff0000u); }
__device__ __forceinline__ bf16_t tobf(float f) { return (bf16_t)(pk(f, 0.f) & 0xffffu); }
__device__ __forceinline__ int crow(int r, int hi) { return (r & 3) + 8 * (r >> 2) + 4 * hi; }
__device__ __forceinline__ bf16x8 pack8(const float* m) { u32x4 w; w.x = pk(m[0], m[1]); w.y = pk(m[2], m[3]); w.z = pk(m[4], m[5]); w.w = pk(m[6], m[7]); return __builtin_bit_cast(bf16x8, w); }
constexpr float LOG2E = 1.4426950408889634f;

__device__ __forceinline__ void pre_item(int item, const bf16_t* __restrict__ XBC, const float* __restrict__ DTF, const float* __restrict__ conv_w, const float* __restrict__ conv_b,
                                         const float* __restrict__ dt_bias, const float* __restrict__ a_log, bf16_t* __restrict__ XDTT, bf16_t* __restrict__ Bn, bf16_t* __restrict__ BT,
                                         bf16_t* __restrict__ Cn, float* __restrict__ ACS, float* __restrict__ DT, LAS3 unsigned char* lds) {
    const int tid = threadIdx.x, lane = tid & 63, wid = tid >> 6;
    const int chunk = item / 6, j = item - chunk * 6, c = chunk & 63;
    const size_t m0 = (size_t)chunk * 128;
    LAS3 float* s_dt = (LAS3 float*)lds;
    LAS3 float* s_tot = s_dt + 512;
    __syncthreads();
    if (j < 4) {
        const int hl = tid >> 7, l = tid & 127, h = 4 * j + hl;
        const float raw = DTF[(m0 + l) * 32 + h] + dt_bias[h];
        const float dtv = fmaxf(raw, 0.f) + log1pf(expf(-fabsf(raw)));
        const float adt = -expf(a_log[h]) * dtv;
        float s = adt;
#pragma unroll
        for (int o = 1; o < 64; o <<= 1) { const float t = __shfl_up(s, o); if (lane >= o) s += t; }
        if (lane == 63) s_tot[wid] = s;
        s_dt[hl * 128 + l] = dtv;
        __syncthreads();
        if (wid & 1) s += s_tot[wid - 1];
        ACS[((size_t)chunk * 16 + h) * 128 + l] = s;
        DT[((size_t)chunk * 16 + h) * 128 + l] = dtv;
    }
    const int ch = tid & 255, half = tid >> 8, cx = 256 * j + ch, l0 = half * 64;
    const float w0 = conv_w[cx], w1 = conv_w[1536 + cx], w2 = conv_w[2 * 1536 + cx], w3 = conv_w[3 * 1536 + cx], cb = conv_b[cx];
    const bf16_t* src = XBC + (m0 + l0) * 1536 + cx;
    float xm3 = 0.f, xm2 = 0.f, xm1 = 0.f;
    if (!(c == 0 && half == 0)) { xm3 = bf1(src[-3 * 1536]); xm2 = bf1(src[-2 * 1536]); xm1 = bf1(src[-1536]); }
    const int hl = ch >> 6;
    for (int g8 = 0; g8 < 8; ++g8) {
        float v[8];
#pragma unroll
        for (int i = 0; i < 8; ++i) {
            const float xin = bf1(src[(size_t)(g8 * 8 + i) * 1536]);
            const float cv = cb + w0 * xm3 + w1 * xm2 + w2 * xm1 + w3 * xin;
            xm3 = xm2; xm2 = xm1; xm1 = xin;
            v[i] = cv / (1.f + __expf(-cv));
        }
        const int l = l0 + g8 * 8;
        if (j < 4) {
#pragma unroll
            for (int i = 0; i < 8; ++i) v[i] *= s_dt[hl * 128 + l + i];
            *(bf16x8*)(XDTT + ((size_t)chunk * 1024 + cx) * 128 + l) = pack8(v);
        } else if (j == 4) {
#pragma unroll
            for (int i = 0; i < 8; ++i) Bn[(m0 + l + i) * 256 + ch] = tobf(v[i]);
            *(bf16x8*)(BT + ((size_t)chunk * 256 + ch) * 128 + l) = pack8(v);
        } else {
#pragma unroll
            for (int i = 0; i < 8; ++i) Cn[(m0 + l + i) * 256 + ch] = tobf(v[i]);
        }
    }
}
__device__ __forceinline__ void fb_item(int bh, const float* __restrict__ DTF, const float* __restrict__ fg_bias, float* __restrict__ FB, LAS3 unsigned char* lds) {
    const int tid = threadIdx.x, lane = tid & 63, wid = tid >> 6, b = bh >> 4, h = bh & 15;
    LAS3 float* s_tot = (LAS3 float*)lds + 1024;
    __syncthreads();
    const float fb = fg_bias[h];
    float v[16]; float run = 0.f;
#pragma unroll
    for (int i = 0; i < 16; ++i) { const float x = DTF[((size_t)b * 8192 + tid * 16 + i) * 32 + 16 + h] + fb; run += fminf(x, 0.f) - log1pf(expf(-fabsf(x))); v[i] = run; }
    float s = run;
#pragma unroll
    for (int o = 1; o < 64; o <<= 1) { const float t = __shfl_up(s, o); if (lane >= o) s += t; }
    if (lane == 63) s_tot[wid] = s;
    __syncthreads();
    float off = s - run;
    for (int w = 0; w < wid; ++w) off += s_tot[w];
#pragma unroll
    for (int i = 0; i < 16; i += 4) { f32x4 o4; o4[0] = -(off + v[i]) * LOG2E; o4[1] = -(off + v[i + 1]) * LOG2E; o4[2] = -(off + v[i + 2]) * LOG2E; o4[3] = -(off + v[i + 3]) * LOG2E;
        *(f32x4*)(FB + (size_t)bh * 8192 + tid * 16 + i) = o4; }
}
__device__ __forceinline__ void state_item(int item, const bf16_t* __restrict__ XDTT, const bf16_t* __restrict__ BT, const float* __restrict__ ACS, float* __restrict__ S) {
    const int tid = threadIdx.x, lane = tid & 63, wid = tid >> 6, r32 = lane & 31, hi = lane >> 5;
    const int chunk = item >> 1, g = item & 1, h = g * 8 + wid;
    const float* acs = ACS + ((size_t)chunk * 16 + h) * 128;
    const float aend = acs[127];
    f32x16 acc[2][4];
#pragma unroll
    for (int a = 0; a < 2; ++a)
#pragma unroll
        for (int b = 0; b < 4; ++b) acc[a][b] = f32x16{};
    const bf16_t* xa = XDTT + ((size_t)chunk * 1024 + h * 64 + r32) * 128 + 8 * hi;
    const bf16_t* bb = BT + ((size_t)chunk * 256 + g * 128 + r32) * 128 + 8 * hi;
    for (int ks = 0; ks < 8; ++ks) {
        const f32x4 a0 = *(const f32x4*)(acs + 16 * ks + 8 * hi), a1 = *(const f32x4*)(acs + 16 * ks + 8 * hi + 4);
        float wv[8];
#pragma unroll
        for (int i = 0; i < 4; ++i) { wv[i] = __expf(aend - a0[i]); wv[4 + i] = __expf(aend - a1[i]); }
        bf16x8 A[2], B[4];
#pragma unroll
        for (int pt = 0; pt < 2; ++pt) { const u32x4 xr = *(const u32x4*)(xa + (size_t)pt * 32 * 128 + 16 * ks); float m[8];
#pragma unroll
            for (int i = 0; i < 4; ++i) { m[2 * i] = lo(xr[i]) * wv[2 * i]; m[2 * i + 1] = hi16(xr[i]) * wv[2 * i + 1]; }
            A[pt] = pack8(m); }
#pragma unroll
        for (int nt = 0; nt < 4; ++nt) B[nt] = *(const bf16x8*)(bb + (size_t)nt * 32 * 128 + 16 * ks);
#pragma unroll
        for (int pt = 0; pt < 2; ++pt)
#pragma unroll
            for (int nt = 0; nt < 4; ++nt) acc[pt][nt] = __builtin_amdgcn_mfma_f32_32x32x16_bf16(A[pt], B[nt], acc[pt][nt], 0, 0, 0);
    }
    float* sp = S + ((size_t)chunk * 16 + h) * 8192 + r32;
#pragma unroll
    for (int pt = 0; pt < 2; ++pt)
#pragma unroll
        for (int nt = 0; nt < 4; ++nt)
#pragma unroll
            for (int r = 0; r < 16; ++r) sp[(32 * pt + crow(r, hi)) * 128 + 32 * nt] = acc[pt][nt][r];
}
__device__ __forceinline__ void scan_pair(int gt, float* __restrict__ S, const float* __restrict__ ACS) {
    const int b = gt >> 16, h = (gt >> 12) & 15, idx = (gt & 4095) * 2;
    f32x2 hs = {0.f, 0.f};
    for (int c0 = 0; c0 < 64; c0 += 8) {
        f32x2 sv[8]; float cd[8];
#pragma unroll
        for (int i = 0; i < 8; ++i) { const size_t ch = (size_t)(b * 64 + c0 + i) * 16 + h; sv[i] = *(const f32x2*)(S + ch * 8192 + idx); cd[i] = ACS[ch * 128 + 127]; }
#pragma unroll
        for (int i = 0; i < 8; ++i) { const size_t ch = (size_t)(b * 64 + c0 + i) * 16 + h; *(f32x2*)(S + ch * 8192 + idx) = hs; hs = hs * __expf(cd[i]) + sv[i]; }
    }
}
constexpr int CBP = 132;
constexpr int OUT_LDS_CB = 0, OUT_LDS_ACS = 128 * CBP * 4, OUT_LDS_DT = OUT_LDS_ACS + 4096, OUT_LDS_SSQ = OUT_LDS_DT + 4096, OUT_LDS_RSTD = OUT_LDS_SSQ + 4096, OUT_LDS_END = OUT_LDS_RSTD + 512;
__device__ __forceinline__ void out_item(int item, const bf16_t* __restrict__ XDTT, const bf16_t* __restrict__ Bn, const bf16_t* __restrict__ Cn, const float* __restrict__ ACS,
                                         const float* __restrict__ DT, const float* __restrict__ PREV, const bf16_t* ZS, bf16_t* YS, const float* __restrict__ d_skip,
                                         const float* __restrict__ gnorm, LAS3 unsigned char* lds) {
    const int tid = threadIdx.x, lane = tid & 63, wid = tid >> 6, r32 = lane & 31, hi = lane >> 5;
    const int chunk = item >> 1, g = item & 1, h = g * 8 + wid;
    const size_t m0 = (size_t)chunk * 128;
    LAS3 float* CB = (LAS3 float*)(lds + OUT_LDS_CB);
    LAS3 float* s_acs = (LAS3 float*)(lds + OUT_LDS_ACS) + wid * 128;
    LAS3 float* s_dt = (LAS3 float*)(lds + OUT_LDS_DT) + wid * 128;
    LAS3 float* s_ssq = (LAS3 float*)(lds + OUT_LDS_SSQ);
    LAS3 float* s_rstd = (LAS3 float*)(lds + OUT_LDS_RSTD);
    __syncthreads();
    { const float* ap = ACS + ((size_t)chunk * 16 + h) * 128; const float* dp = DT + ((size_t)chunk * 16 + h) * 128;
      s_acs[lane] = ap[lane]; s_acs[lane + 64] = ap[lane + 64]; s_dt[lane] = dp[lane]; s_dt[lane + 64] = dp[lane + 64]; }
#pragma unroll
    for (int bi = 0; bi < 2; ++bi) {
        const int blk = wid * 2 + bi, lb = blk >> 2, sb = blk & 3;
        if (sb <= lb) {
            f32x16 acc = f32x16{};
            const bf16_t* ca = Cn + (m0 + 32 * lb + r32) * 256 + g * 128 + 8 * hi; const bf16_t* ba = Bn + (m0 + 32 * sb + r32) * 256 + g * 128 + 8 * hi;
#pragma unroll
            for (int ks = 0; ks < 8; ++ks) acc = __builtin_amdgcn_mfma_f32_32x32x16_bf16(*(const bf16x8*)(ca + 16 * ks), *(const bf16x8*)(ba + 16 * ks), acc, 0, 0, 0);
#pragma unroll
            for (int r = 0; r < 16; ++r) CB[(32 * lb + crow(r, hi)) * CBP + 32 * sb + r32] = acc[r];
        }
    }
    __syncthreads();
    const bf16_t* xt = XDTT + ((size_t)chunk * 1024 + h * 64 + r32) * 128;
    const float* pv = PREV + ((size_t)chunk * 16 + h) * 8192 + r32 * 128 + 8 * hi;
    const float dsk = d_skip[h];
    const bf16_t* zp = ZS + m0 * 1024 + h * 64 + r32; bf16_t* yp = YS + m0 * 1024 + h * 64 + r32;
#pragma unroll 1
    for (int lb = 0; lb < 4; ++lb) {
        f32x16 yd[2], yo[2]; yd[0] = f32x16{}; yd[1] = f32x16{}; yo[0] = f32x16{}; yo[1] = f32x16{};
        const bf16_t* ca = Cn + (m0 + 32 * lb + r32) * 256 + g * 128 + 8 * hi;
#pragma unroll
        for (int ks = 0; ks < 8; ++ks) {
            const bf16x8 a = *(const bf16x8*)(ca + 16 * ks);
#pragma unroll
            for (int pt = 0; pt < 2; ++pt) { const f32x4 p0 = *(const f32x4*)(pv + pt * 4096 + 16 * ks), p1 = *(const f32x4*)(pv + pt * 4096 + 16 * ks + 4);
                float m[8] = {p0[0], p0[1], p0[2], p0[3], p1[0], p1[1], p1[2], p1[3]};
                yo[pt] = __builtin_amdgcn_mfma_f32_32x32x16_bf16(a, pack8(m), yo[pt], 0, 0, 0); }
            if (ks & 1) asm volatile("" ::: "memory");
        }
        const int lrow = 32 * lb + r32; const float al = s_acs[lrow];
#pragma unroll 1
        for (int sb = 0; sb <= lb; ++sb)
#pragma unroll
            for (int k2 = 0; k2 < 2; ++k2) {
                const int s0 = 32 * sb + 16 * k2 + 8 * hi;
                const f32x4 c0 = *(const LAS3 f32x4*)(CB + lrow * CBP + s0), c1 = *(const LAS3 f32x4*)(CB + lrow * CBP + s0 + 4);
                const f32x4 e0 = *(const LAS3 f32x4*)(s_acs + s0), e1 = *(const LAS3 f32x4*)(s_acs + s0 + 4);
                float m[8];
#pragma unroll
                for (int i = 0; i < 4; ++i) { m[i] = (s0 + i <= lrow) ? c0[i] * __expf(fminf(al - e0[i], 0.f)) : 0.f; m[4 + i] = (s0 + 4 + i <= lrow) ? c1[i] * __expf(fminf(al - e1[i], 0.f)) : 0.f; }
                const bf16x8 a = pack8(m);
#pragma unroll
                for (int pt = 0; pt < 2; ++pt) yd[pt] = __builtin_amdgcn_mfma_f32_32x32x16_bf16(a, *(const bf16x8*)(xt + pt * 4096 + s0), yd[pt], 0, 0, 0);
            }
        float ssq[16];
#pragma unroll
        for (int r = 0; r < 16; ++r) ssq[r] = 0.f;
#pragma unroll
        for (int g4 = 0; g4 < 4; ++g4) {
            const int lq = 32 * lb + 8 * g4 + 4 * hi;
            const f32x4 ea = *(const LAS3 f32x4*)(s_acs + lq), dq = *(const LAS3 f32x4*)(s_dt + lq);
#pragma unroll
            for (int pt = 0; pt < 2; ++pt) {
                const u32x2 xw = *(const u32x2*)(xt + pt * 4096 + lq);
                const float xv[4] = {lo(xw.x), hi16(xw.x), lo(xw.y), hi16(xw.y)};
                float yv[4];
#pragma unroll
                for (int jj = 0; jj < 4; ++jj) { const int r = 4 * g4 + jj;
                    float y = yd[pt][r] + __expf(ea[jj]) * yo[pt][r] + dsk * xv[jj] / dq[jj];
                    const float z = bf1(zp[(size_t)(lq + jj) * 1024 + 32 * pt]);
                    y *= z / (1.f + __expf(-z));
                    ssq[r] += y * y; yv[jj] = y; }
#pragma unroll
                for (int jj = 0; jj < 4; ++jj) yp[(size_t)(lq + jj) * 1024 + 32 * pt] = tobf(yv[jj]);
            }
            asm volatile("" ::: "memory");
        }
#pragma unroll
        for (int r = 0; r < 16; ++r) { float t = ssq[r]; t += __shfl_xor(t, 1); t += __shfl_xor(t, 2); t += __shfl_xor(t, 4); t += __shfl_xor(t, 8); t += __shfl_xor(t, 16); ssq[r] = t; }
        if (r32 == 0) {
#pragma unroll
            for (int r = 0; r < 16; ++r) s_ssq[wid * 128 + 32 * lb + crow(r, hi)] = ssq[r];
        }
    }
    __syncthreads();
    if (tid < 128) { float t = 0.f;
#pragma unroll
        for (int w = 0; w < 8; ++w) t += s_ssq[w * 128 + tid];
        s_rstd[tid] = rsqrtf(t * (1.f / 512.f) + 1e-6f); }
    __syncthreads();
    const float gn0 = gnorm[h * 64 + r32], gn1 = gnorm[h * 64 + 32 + r32];
#pragma unroll 1
    for (int lb = 0; lb < 4; ++lb)
#pragma unroll
        for (int g4 = 0; g4 < 4; ++g4) {
            const int lq = 32 * lb + 8 * g4 + 4 * hi;
            const f32x4 rs = *(const LAS3 f32x4*)(s_rstd + lq);
#pragma unroll
            for (int pt = 0; pt < 2; ++pt) { const float gn = pt ? gn1 : gn0;
#pragma unroll
                for (int jj = 0; jj < 4; ++jj) { bf16_t* q = yp + (size_t)(lq + jj) * 1024 + 32 * pt; *q = tobf(bf1(*q) * rs[jj] * gn); } }
        }
}
}
#include <hip/hip_cooperative_groups.h>
namespace cg = cooperative_groups;
#define LAS __attribute__((address_space(3)))
#define GAS __attribute__((address_space(1)))
typedef unsigned short bf16;
typedef unsigned v4u __attribute__((ext_vector_type(4)));
typedef float f32x4 __attribute__((ext_vector_type(4)));
constexpr int NWAVES = 8;
constexpr int M = 16384, DM = 1024, NINP = 6912, NINR = 6688, DIN = 2048, PLE = 256;
constexpr size_t MiB = 1u << 20;
constexpr size_t WS_WOUT = 1 * MiB, WS_WGATE = 5 * MiB, WS_WPROJ = 7 * MiB, WS_ZS = 8 * MiB, WS_ZA = 40 * MiB, WS_Q = 72 * MiB, WS_K = 104 * MiB, WS_V = 136 * MiB,
                 WS_XBC = 168 * MiB, WS_DTF = 216 * MiB, WS_S = 168 * MiB, WS_PB = 232 * MiB, WS_PP = WS_Q, WS_HN = WS_K, WS_END = 240 * MiB;
constexpr size_t OS_U = 0, OS_WIN = 32 * MiB;
constexpr size_t OS_XDTT = 0, OS_BN = 32 * MiB, OS_BT = 40 * MiB, OS_CN = 48 * MiB, OS_ACS = 56 * MiB, OS_DT = 57 * MiB, OS_FB = 58 * MiB;
constexpr int LDS_BYTES = 147456;
static_assert(attn_body::LDS_BYTES <= 131072 && ssd::OUT_LDS_END <= 131072, "LDS");

__device__ __forceinline__ unsigned f2bf(float f) { unsigned u = __builtin_bit_cast(unsigned, f); return (u + 0x7fffu + ((u >> 16) & 1u)) >> 16; }
__device__ __forceinline__ unsigned pk2(float lo, float hi) { return f2bf(lo) | (f2bf(hi) << 16); }
__device__ __forceinline__ float wave_sum(float v) {
#pragma unroll
    for (int o = 1; o < 64; o <<= 1) v += __shfl_xor(v, o);
    return v;
}
__device__ __forceinline__ int map_in_row(int n) { return n < 2560 ? n : (n < 2576 ? n + 4096 : (n < 6672 ? n - 16 : n)); }
template <bool MAP> __device__ __forceinline__ void p0_transpose_item(const float* W, int K, int N, bf16* WT, LAS float* scr, int item, int lane) {
    const int nblk = N / 32, kb = item / nblk, nb = item % nblk, k0 = 64 * kb, n0 = 32 * nb;
#pragma unroll 8
    for (int i = 0; i < 32; ++i) { const int kk = 2 * i + (lane >> 5); scr[kk * 33 + (lane & 31)] = W[(size_t)(k0 + kk) * N + n0 + (lane & 31)]; }
    asm volatile("s_waitcnt lgkmcnt(0)" ::: "memory");
    const int c = lane & 7;
#pragma unroll
    for (int j = 0; j < 4; ++j) { const int n = (lane >> 3) + 8 * j; const LAS float* s = scr + (8 * c) * 33 + n;
        v4u o; o.x = pk2(s[0 * 33], s[1 * 33]); o.y = pk2(s[2 * 33], s[3 * 33]); o.z = pk2(s[4 * 33], s[5 * 33]); o.w = pk2(s[6 * 33], s[7 * 33]);
        const int row = MAP ? map_in_row(n0 + n) : (n0 + n);
        *(v4u*)(WT + (size_t)row * K + k0 + 8 * c) = o; }
    asm volatile("s_waitcnt lgkmcnt(0)" ::: "memory");
}
__device__ __forceinline__ void rms_row_to_bf16(const float* xrow, const float* gain, bf16* orow, int lane) {
    const f32x4* xr = (const f32x4*)xrow + lane; const f32x4* gr = (const f32x4*)gain + lane;
    f32x4 v[4]; float s = 0.f;
#pragma unroll
    for (int j = 0; j < 4; ++j) { v[j] = xr[64 * j]; s += (v[j].x * v[j].x + v[j].y * v[j].y) + (v[j].z * v[j].z + v[j].w * v[j].w); }
    const float rstd = rsqrtf(wave_sum(s) * (1.f / 1024.f) + 1e-6f);
    unsigned long long* o8 = (unsigned long long*)orow + lane;
#pragma unroll
    for (int j = 0; j < 4; ++j) { const f32x4 gg = gr[64 * j];
        o8[64 * j] = (unsigned long long)pk2(v[j].x * rstd * gg.x, v[j].y * rstd * gg.y) | ((unsigned long long)pk2(v[j].z * rstd * gg.z, v[j].w * rstd * gg.w) << 32); }
}
__device__ __forceinline__ void rms_row_inplace(float* xrow, const float* gain, int lane) {
    f32x4* xr = (f32x4*)xrow + lane; const f32x4* gr = (const f32x4*)gain + lane;
    f32x4 v[4]; float s = 0.f;
#pragma unroll
    for (int j = 0; j < 4; ++j) { v[j] = xr[64 * j]; s += (v[j].x * v[j].x + v[j].y * v[j].y) + (v[j].z * v[j].z + v[j].w * v[j].w); }
    const float rstd = rsqrtf(wave_sum(s) * (1.f / 1024.f) + 1e-6f);
#pragma unroll
    for (int j = 0; j < 4; ++j) xr[64 * j] = v[j] * rstd * gr[64 * j];
}

struct Args { const float* in[17]; float* out; unsigned char* ws; int ph_lo, ph_hi; };
__global__ void __launch_bounds__(NWAVES * 64, 2) mega_fwd(Args args) {
    extern __shared__ __attribute__((aligned(16))) unsigned char lds[];
    cg::grid_group grid = cg::this_grid();
    LAS unsigned char* L = (LAS unsigned char*)lds;
#define tid ((int)threadIdx.x)
#define lane ((int)(threadIdx.x & 63))
#define wave (__builtin_amdgcn_readfirstlane((int)(threadIdx.x >> 6)))
#define G ((int)gridDim.x)
#define bx ((int)blockIdx.x)
#define gw (bx * NWAVES + wave)
#define NGW (G * NWAVES)
    unsigned char* ws = args.ws; unsigned char* os = (unsigned char*)args.out;
    const float* x = args.in[0]; const float* p = args.in[1];
    bf16* Wout_t = (bf16*)(ws + WS_WOUT); bf16* Wgate_t = (bf16*)(ws + WS_WGATE); bf16* Wproj_t = (bf16*)(ws + WS_WPROJ);
    bf16* ZS = (bf16*)(ws + WS_ZS); bf16* ZA = (bf16*)(ws + WS_ZA); bf16* Qb = (bf16*)(ws + WS_Q); bf16* Kb = (bf16*)(ws + WS_K); bf16* Vb = (bf16*)(ws + WS_V);
    bf16* XBC = (bf16*)(ws + WS_XBC); float* DTF = (float*)(ws + WS_DTF); float* Sst = (float*)(ws + WS_S); bf16* PB = (bf16*)(ws + WS_PB); bf16* PP = (bf16*)(ws + WS_PP); bf16* HN = (bf16*)(ws + WS_HN);
    bf16* U = (bf16*)(os + OS_U); bf16* Win_t = (bf16*)(os + OS_WIN);
    bf16* XDTT = (bf16*)(os + OS_XDTT); bf16* Bn = (bf16*)(os + OS_BN); bf16* BT = (bf16*)(os + OS_BT); bf16* Cn = (bf16*)(os + OS_CN);
    float* ACS = (float*)(os + OS_ACS); float* DTb = (float*)(os + OS_DT); float* FB = (float*)(os + OS_FB);
    const int lo = args.ph_lo, hi = args.ph_hi;
#ifdef DBG_ONLY
#define IN(k) ((k) == DBG_ONLY)
#else
#define IN(k) (lo <= (k) && (k) < hi)
#endif
#define SEAM(k) do { if (IN(k) && IN((k) + 1)) grid.sync(); } while (0)

    if (IN(0)) {
        LAS float* scr = (LAS float*)(L + wave * 16384);
        constexpr int I_IN = 16 * 209, I_OUT = 32 * 32, I_GATE = 16 * 32, I_PROJ = 4 * 32, NITEMS = I_IN + I_OUT + I_GATE + I_PROJ;
        for (int it = gw; it < NITEMS; it += NGW) {
            int r = it;
            if (r < I_IN) { p0_transpose_item<true>(args.in[3], 1024, NINR, Win_t, scr, r, lane); continue; } r -= I_IN;
            if (r < I_OUT) { p0_transpose_item<false>(args.in[12], 2048, 1024, Wout_t, scr, r, lane); continue; } r -= I_OUT;
            if (r < I_GATE) { p0_transpose_item<false>(args.in[14], 1024, 1024, Wgate_t, scr, r, lane); continue; } r -= I_GATE;
            p0_transpose_item<false>(args.in[15], 256, 1024, Wproj_t, scr, r, lane);
        }
        { v4u* z = (v4u*)(Win_t + (size_t)NINR * 1024); const int nz = (NINP - NINR) * 1024 * 2 / 16;
          for (int i = bx * 512 + tid; i < nz; i += G * 512) z[i] = (v4u){0u, 0u, 0u, 0u}; }
        for (int m = gw; m < M; m += NGW) rms_row_to_bf16(x + (size_t)m * DM, args.in[2], U + (size_t)m * DM, lane);
    }
    SEAM(0);
    if (IN(1)) {
        pg8::Gemm g{U, Win_t, M, NINP, 1024, 1024, 1 << 30, 0}; pg8::StaticOrder S; S.init(M, NINP, G, bx);
        pg8::EpiIn E{ZS, XBC, ZA, Qb, Kb, Vb, DTF, attn_body::C2};
        pg8::gemm_phase<pg8::EpiIn, pg8::StaticOrder, true, true>(L, g, S, E);
    }
    SEAM(1);
    if (IN(2)) {
        for (int it = bx; it < 800; it += G) {
            if (it < 768) ssd::pre_item(it, XBC, DTF, args.in[4], args.in[5], args.in[6], args.in[7], XDTT, Bn, BT, Cn, ACS, DTb, L);
            else ssd::fb_item(it - 768, DTF, args.in[10], FB, L);
        }
    }
    SEAM(2);
    if (IN(3)) { for (int it = bx; it < 256; it += G) ssd::state_item(it, XDTT, BT, ACS, Sst); }
    SEAM(3);
    if (IN(4)) {
        for (int gt = bx * 512 + tid; gt < 131072; gt += G * 512) ssd::scan_pair(gt, Sst, ACS);
        __syncthreads();
        const attn_body::AttnTensors AT{(const attn_body::bf16*)Qb, (const attn_body::bf16*)Kb, (const attn_body::bf16*)Vb, (attn_body::bf16*)ZA, FB, (const attn_body::bf16*)ZA, args.in[11]};
        const attn_body::StaticOrder S(G, bx);
        attn_body::attn_phase<attn_body::StaticOrder>((char*)lds, AT, S);
    }
    SEAM(4);
    if (IN(5)) {
        for (int it = bx; it < 256; it += G) ssd::out_item(it, XDTT, Bn, Cn, ACS, DTb, Sst, ZS, ZS, args.in[8], args.in[9], L);
        { const f32x4* ps = (const f32x4*)p; unsigned long long* pd = (unsigned long long*)PB; const int n4 = M * PLE / 4;
          for (int i = bx * 512 + tid; i < n4; i += G * 512) { const f32x4 v = ps[i]; pd[i] = (unsigned long long)pk2(v.x, v.y) | ((unsigned long long)pk2(v.z, v.w) << 32); } }
    }
    SEAM(5);
    if (IN(6)) {
        { pg8::Gemm g{ZS, Wout_t, M, 1024, 2048, 1024, 16, (long)(WS_ZA - WS_ZS) - 2048}; pg8::StaticOrder S; S.init(M, 1024, G, bx);
          pg8::EpiRes E{x, args.out, 1024};
          pg8::gemm_phase<pg8::EpiRes, pg8::StaticOrder, true, true>(L, g, S, E); }
        { pg8::Gemm g{PB, Wproj_t, M, 1024, 256, 256, 1 << 30, 0}; pg8::StaticOrder S; S.init(M, 1024, G, bx);
          pg8::EpiBf16<0> E{PP, 1024, nullptr, 0, 0, 1.f};
          pg8::gemm_phase<pg8::EpiBf16<0>, pg8::StaticOrder, true, true>(L, g, S, E); }
    }
    SEAM(6);
    if (IN(7)) { for (int m = gw; m < M; m += NGW) rms_row_to_bf16(args.out + (size_t)m * DM, args.in[13], HN + (size_t)m * DM, lane); }
    SEAM(7);
    if (IN(8)) {
        pg8::Gemm g{HN, Wgate_t, M, 1024, 1024, 1024, 1 << 30, 0}; pg8::StaticOrder S; S.init(M, 1024, G, bx);
        pg8::EpiGate E{args.out, PP, 1024};
        pg8::gemm_phase<pg8::EpiGate, pg8::StaticOrder, true, true>(L, g, S, E);
    }
    SEAM(8);
    if (IN(9)) { for (int m = gw; m < M; m += NGW) rms_row_inplace(args.out + (size_t)m * DM, args.in[16], lane); }
#undef IN
#undef SEAM
#undef tid
#undef lane
#undef wave
#undef G
#undef bx
#undef gw
#undef NGW
}

#ifndef MK_SPLIT
#define MK_SPLIT 0
#endif
extern "C" void kernel_launch(void* const* d_in, const int* in_sizes, int n_in, void* d_out, int out_size, void* d_ws, size_t ws_size, hipStream_t stream) {
    static int grid = 0;
    if (grid == 0) {
        if (n_in != 17 || out_size != M * DM || ws_size < WS_END) { fprintf(stderr, "kernel_launch: unexpected shapes (n_in %d out %d ws %zu)\n", n_in, out_size, ws_size); grid = -1; return; }
        int dev = 0, cus = 0, per_cu = 0;
        hipGetDevice(&dev); hipDeviceGetAttribute(&cus, hipDeviceAttributeMultiprocessorCount, dev);
        if (hipFuncSetAttribute((const void*)mega_fwd, hipFuncAttributeMaxDynamicSharedMemorySize, LDS_BYTES) != hipSuccess) { fprintf(stderr, "kernel_launch: hipFuncSetAttribute failed\n"); grid = -1; return; }
        hipOccupancyMaxActiveBlocksPerMultiprocessor(&per_cu, (const void*)mega_fwd, NWAVES * 64, LDS_BYTES);
        (void)hipGetLastError();
        grid = 256;
        if (cus * per_cu < grid) { fprintf(stderr, "kernel_launch: device cannot hold 256 co-resident workgroups (cus %d per_cu %d)\n", cus, per_cu); grid = -1; return; }
    }
    if (grid < 0) return;
    Args a{};
    for (int i = 0; i < 17; ++i) a.in[i] = (const float*)d_in[i];
    a.out = (float*)d_out; a.ws = (unsigned char*)d_ws;
#if MK_SPLIT
    for (int ph = 0; ph < 10; ++ph) { a.ph_lo = ph; a.ph_hi = ph + 1; void* kargs[] = {&a};
        hipLaunchCooperativeKernel((const void*)mega_fwd, dim3(grid), dim3(NWAVES * 64), kargs, LDS_BYTES, stream); }
#else
    a.ph_lo = 0; a.ph_hi = 10; void* kargs[] = {&a};
    hipError_t e = hipLaunchCooperativeKernel((const void*)mega_fwd, dim3(grid), dim3(NWAVES * 64), kargs, LDS_BYTES, stream);
    if (e != hipSuccess) fprintf(stderr, "cooperative launch failed: %s\n", hipGetErrorString(e));
#endif
}
```

```cpp
#include <hip/hip_runtime.h>
#include <cstdio>
#include <cstdint>
namespace pg8 {
#define PG8_LAS __attribute__((address_space(3)))
typedef unsigned short bf16_t;
typedef short bf16x8 __attribute__((ext_vector_type(8)));
typedef float f32x4 __attribute__((ext_vector_type(4)));
typedef unsigned u32x4 __attribute__((ext_vector_type(4)));
constexpr int BM = 256, BK = 64, HALF = 128, HTB = HALF * BK * 2  , STAGE_BYTES = 8 * HTB, NXCD = 8, WGM = 8;

__host__ __device__ __forceinline__ int lds_byte(int r, int c) { const int st = (r >> 4) * 2 + (c >> 5), rr = r & 15, cc = c & 31, ob = rr * 64 + cc * 2; return st * 1024 + (ob ^ (((ob >> 9) & 1) << 5)); }
__host__ __device__ __forceinline__ void stage_rc(int b, int& R, int& C) { const int st = b / 1024, sb = b % 1024, swz = sb ^ (((sb >> 9) & 1) << 5); R = (st >> 1) * 16 + swz / 64; C = (st & 1) * 32 + (swz % 64) / 2; }
__host__ __device__ __forceinline__ int perm32(int rho) { const int n = rho >> 4, i = rho & 15; return 8 * (i >> 2) + 4 * n + (i & 3); }

struct Unit { int pm, pn; };
struct Gemm { const bf16_t* A; const bf16_t* Bt; int M, N, K; int lda; int ksplit; long asadj; };

struct StaticOrder {
    int nM, nN, nwg, G, c;
    __host__ __device__ void init(int M, int N, int G_, int c_) { nM = M / BM; nN = N / BM; nwg = nM * nN; G = G_; c = c_; }
    __host__ __device__ bool next(int i, Unit& u) const {
        const long L = (long)i * G + c; if (L >= nwg) return false;
        int wgid = (int)L; { const int q = nwg / NXCD, r = nwg % NXCD, xcd = wgid % NXCD, off = wgid / NXCD; wgid = (xcd < r ? xcd * (q + 1) : r * (q + 1) + (xcd - r) * q) + off; }
        const int nig = WGM * nN, gid = wgid / nig, fm = gid * WGM, gsz = (nM - fm) < WGM ? (nM - fm) : WGM;
        u.pm = fm + ((wgid % nig) % gsz); u.pn = (wgid % nig) / gsz; return true;
    }
    __device__ __forceinline__ void a_ready(const Unit&) const {}
    __device__ __forceinline__ void done(const Unit&) const {}
};

__device__ __forceinline__ unsigned cvt_pk_bf16(float lo, float hi) { unsigned r; asm volatile("v_cvt_pk_bf16_f32 %0, %1, %2" : "=v"(r) : "v"(lo), "v"(hi)); return r; }
typedef float f32x2 __attribute__((ext_vector_type(2)));
__device__ __forceinline__ f32x2 gelu_pk(f32x2 v) {
    const f32x2 av = __builtin_elementwise_abs(v), d = av * 0.2316418882f + 1.0f;
    f32x2 t; t.x = __builtin_amdgcn_rcpf(d.x); t.y = __builtin_amdgcn_rcpf(d.y);
    f32x2 q = t * 0.5307027145f + (-0.7265760135f); q = q * t + 0.7107068705f; q = q * t + (-0.142248368f); q = q * t + 0.127414796f; q = q * t;
    const f32x2 s = (v * v) * (-0.72134752044f);
    f32x2 e; e.x = __builtin_amdgcn_exp2f(s.x); e.y = __builtin_amdgcn_exp2f(s.y);
    const f32x2 m = v * (q * e), r = v - m;
    f32x2 o; o.x = v.x < 0.f ? m.x : r.x; o.y = v.y < 0.f ? m.y : r.y; return o;
}

template <int ACT  > struct EpiBf16 {
    static constexpr bool PERM = true, AFTER_DRAIN = false; static_assert(ACT == 0 || ACT == 1, "EpiBf16: ACT is 0 (none) or 1 (gelu_pk)");
    bf16_t* O; int ldc; const float* bias; int split_cols; size_t split_stride; float scale0;
    __device__ __forceinline__ void operator()(const f32x4 (&acc)[2][2][4][2], const Unit& u, int wr, int wc, int fr, int fq) const {
        const int row0 = u.pm * BM + wr * 64 + fr; int colt = u.pn * BM; bf16_t* base = O;
        float sc = 1.f; if (split_cols) { const int t = colt / split_cols; base += (size_t)t * split_stride; colt -= t * split_cols; if (t == 0) sc = scale0; }
        const int col0 = colt + wc * 32 + 8 * fq, bcol0 = u.pn * BM + wc * 32 + 8 * fq;
        f32x4 bv[2][2];
#pragma unroll
        for (int bj = 0; bj < 2; ++bj)
#pragma unroll
            for (int n = 0; n < 2; ++n) bv[bj][n] = bias ? *(const f32x4*)(bias + bcol0 + bj * HALF + 4 * n) : (f32x4){0.f, 0.f, 0.f, 0.f};
#pragma unroll
        for (int ai = 0; ai < 2; ++ai)
#pragma unroll
            for (int m = 0; m < 4; ++m) { bf16_t* rowp = base + (size_t)(row0 + ai * HALF + m * 16) * ldc + col0;
#pragma unroll
                for (int bj = 0; bj < 2; ++bj) { f32x4 v0 = acc[ai][bj][m][0] + bv[bj][0], v1 = acc[ai][bj][m][1] + bv[bj][1];
                    if (ACT == 1) { f32x2 a = gelu_pk((f32x2){v0[0], v0[1]}), b = gelu_pk((f32x2){v0[2], v0[3]}), c = gelu_pk((f32x2){v1[0], v1[1]}), d = gelu_pk((f32x2){v1[2], v1[3]});
                        v0 = (f32x4){a.x, a.y, b.x, b.y}; v1 = (f32x4){c.x, c.y, d.x, d.y}; }
                    v0 = v0 * sc; v1 = v1 * sc; u32x4 w; w.x = cvt_pk_bf16(v0[0], v0[1]); w.y = cvt_pk_bf16(v0[2], v0[3]); w.z = cvt_pk_bf16(v1[0], v1[1]); w.w = cvt_pk_bf16(v1[2], v1[3]);
                    *(u32x4*)(rowp + bj * HALF) = w; } }
    }
};

struct PanelStats {
    unsigned* xbuf;
    unsigned* cnt;
    unsigned* tmo;
    int ntn; float eps;
    unsigned code;
    __device__ __forceinline__ bool run(const f32x4 (&v)[2][2][4][2], const Unit& u, int wr, int wc, int fr, int fq, PG8_LAS unsigned char* lds, int wid, int lane) const {
        typedef float f32x2v __attribute__((ext_vector_type(2)));
        PG8_LAS f32x2v* P = (PG8_LAS f32x2v*)lds;
        PG8_LAS f32x2v* S = (PG8_LAS f32x2v*)(lds + 8192);
        PG8_LAS unsigned* flag = (PG8_LAS unsigned*)(lds + 8192 + 2048);
#pragma unroll
        for (int ai = 0; ai < 2; ++ai)
#pragma unroll
            for (int m = 0; m < 4; ++m) {
                float s = 0.f;
#pragma unroll
                for (int bj = 0; bj < 2; ++bj)
#pragma unroll
                    for (int n = 0; n < 2; ++n) { const f32x4 x = v[ai][bj][m][n]; s += (x[0] + x[1]) + (x[2] + x[3]); }
                s += __shfl_xor(s, 16); s += __shfl_xor(s, 32);
                const float mw = s * (1.0f / 64.0f); float q = 0.f;
#pragma unroll
                for (int bj = 0; bj < 2; ++bj)
#pragma unroll
                    for (int n = 0; n < 2; ++n) { const f32x4 d = v[ai][bj][m][n] - mw; q += (d[0] * d[0] + d[1] * d[1]) + (d[2] * d[2] + d[3] * d[3]); }
                q += __shfl_xor(q, 16); q += __shfl_xor(q, 32);
                if (fq == 0) P[(ai * HALF + wr * 64 + m * 16 + fr) * 4 + wc] = (f32x2v){mw, q};
            }
        asm volatile("s_waitcnt lgkmcnt(0)" ::: "memory"); __builtin_amdgcn_s_barrier(); asm volatile("" ::: "memory");
#if defined(BROKEN_EXCHANGE_NO_WAIT)
#warning BROKEN CONTROL BUILD: the row-statistics exchange does not wait; results are wrong by design
        if (blockIdx.x >= 64) { const long long t0_ = clock64(); while (clock64() - t0_ < 60000) __builtin_amdgcn_s_sleep(8); }
#endif
        const int row = wid * 32 + (lane & 31);
        if (lane < 32) {
            const f32x2v a = P[row * 4 + 0], b = P[row * 4 + 1], c = P[row * 4 + 2], d = P[row * 4 + 3];
            const float mt = (a.x + b.x + c.x + d.x) * 0.25f;
            const float da = a.x - mt, db = b.x - mt, dc = c.x - mt, dd = d.x - mt;
            const float m2 = (a.y + b.y) + (c.y + d.y) + 64.0f * ((da * da + db * db) + (dc * dc + dd * dd));
            unsigned long long* slot = (unsigned long long*)xbuf + ((size_t)(u.pm * BM + row) * 4 + u.pn);
            __hip_atomic_store(slot, ((unsigned long long)__float_as_uint(m2) << 32) | __float_as_uint(mt), __ATOMIC_RELAXED, __HIP_MEMORY_SCOPE_AGENT);
        }
        asm volatile("s_waitcnt vmcnt(0)" ::: "memory");
        if (lane == 0) __hip_atomic_fetch_add(cnt + 64 * u.pm, 1u, __ATOMIC_RELAXED, __HIP_MEMORY_SCOPE_AGENT);
        if (wid == 0) {
            bool dead = false; const unsigned long long t0 = __builtin_amdgcn_s_memrealtime(); const unsigned want = 8u * (unsigned)ntn;
            for (;;) {
#if defined(BROKEN_EXCHANGE_NO_WAIT)
                break;
#endif
                if ((unsigned)__builtin_amdgcn_readfirstlane(__hip_atomic_load(cnt + 64 * u.pm, __ATOMIC_RELAXED, __HIP_MEMORY_SCOPE_AGENT)) >= want) break;
                if (__builtin_amdgcn_s_memrealtime() - t0 > 2000000ull) {
                    if (lane == 0) { unsigned expect = 0u; __hip_atomic_compare_exchange_strong(tmo + 1, &expect, code | (unsigned)(u.pm & 0xff), __ATOMIC_RELAXED, __ATOMIC_RELAXED, __HIP_MEMORY_SCOPE_AGENT);
                                     __hip_atomic_store(tmo, 1u, __ATOMIC_RELAXED, __HIP_MEMORY_SCOPE_AGENT); }
                    dead = true; break; }
                __builtin_amdgcn_s_sleep(2);
            }
            __builtin_amdgcn_fence(__ATOMIC_ACQUIRE, "agent");
            if (lane == 0) flag[0] = dead ? 1u : 0u;
        }
        asm volatile("s_waitcnt vmcnt(0) lgkmcnt(0)" ::: "memory"); __builtin_amdgcn_s_barrier(); asm volatile("" ::: "memory");
        const bool bad = flag[0] != 0u;
        if (lane < 32) {
            const unsigned long long* slot = (const unsigned long long*)xbuf + (size_t)(u.pm * BM + row) * 4; float mt[4], m2[4]; float ms = 0.f;
#pragma unroll
            for (int t = 0; t < 4; ++t) { if (t < ntn) { const unsigned long long w = __hip_atomic_load(slot + t, __ATOMIC_RELAXED, __HIP_MEMORY_SCOPE_AGENT); mt[t] = __uint_as_float((unsigned)w); m2[t] = __uint_as_float((unsigned)(w >> 32)); } else { mt[t] = 0.f; m2[t] = 0.f; } ms += mt[t]; }
            const float mean = ms / (float)ntn; float q = 0.f;
#pragma unroll
            for (int t = 0; t < 4; ++t) if (t < ntn) { const float dm = mt[t] - mean; q += m2[t] + 256.0f * dm * dm; }
            S[row] = (f32x2v){mean, 1.0f / sqrtf(q / (256.0f * (float)ntn) + eps)};
        }
        asm volatile("s_waitcnt lgkmcnt(0)" ::: "memory"); __builtin_amdgcn_s_barrier(); asm volatile("" ::: "memory");
        return bad;
    }
};
struct EpiLnRes {
    static constexpr bool PERM = false, AFTER_DRAIN = true;
    const float* base; float* out; int ldc; const float* bias; PanelStats st; unsigned poison;
    __device__ __forceinline__ void fused(f32x4 (&acc)[2][2][4][2], const Unit& u, int wr, int wc, int fr, int fq, PG8_LAS unsigned char* lds, int wid, int lane) const {
        typedef float f32x2v __attribute__((ext_vector_type(2)));
        const PG8_LAS f32x2v* S = (const PG8_LAS f32x2v*)(lds + 8192);
        const int col0 = u.pn * BM + wc * 32 + 4 * fq;
#pragma unroll
        for (int bj = 0; bj < 2; ++bj)
#pragma unroll
            for (int n = 0; n < 2; ++n) { const f32x4 bv = bias ? *(const f32x4*)(bias + col0 + bj * HALF + n * 16) : (f32x4){0.f, 0.f, 0.f, 0.f};
#pragma unroll
                for (int ai = 0; ai < 2; ++ai)
#pragma unroll
                    for (int m = 0; m < 4; ++m) acc[ai][bj][m][n] += bv; }
        f32x4 pre[4][2][2];
#pragma unroll
        for (int m = 0; m < 4; ++m) { const size_t off = (size_t)(u.pm * BM + wr * 64 + m * 16 + fr) * ldc + col0;
#pragma unroll
            for (int bj = 0; bj < 2; ++bj)
#pragma unroll
                for (int n = 0; n < 2; ++n) pre[m][bj][n] = *(const f32x4*)(base + off + bj * HALF + n * 16); }
        const bool bad = st.run(acc, u, wr, wc, fr, fq, lds, wid, lane) || poison != 0u;
        const float qnan = __builtin_nanf("");
#pragma unroll
        for (int ai = 0; ai < 2; ++ai)
#pragma unroll
            for (int m = 0; m < 4; ++m) { const int r = ai * HALF + wr * 64 + m * 16 + fr; const f32x2v sr = S[r]; const size_t off = (size_t)(u.pm * BM + r) * ldc + col0;
#pragma unroll
                for (int bj = 0; bj < 2; ++bj)
#pragma unroll
                    for (int n = 0; n < 2; ++n) { const f32x4 bs = ai == 0 ? pre[m][bj][n] : *(const f32x4*)(base + off + bj * HALF + n * 16); f32x4 o = bs + (acc[ai][bj][m][n] - sr.x) * sr.y;
                        if (bad) o = (f32x4){qnan, qnan, qnan, qnan}; *(f32x4*)(out + off + bj * HALF + n * 16) = o; }
                if (m & 1) asm volatile("" ::: "memory"); }
    }
};
struct EpiLnResLn {
    static constexpr bool PERM = false, AFTER_DRAIN = true;
    const float* base; float* out; bf16_t* xn; int ldc; const float* bias; PanelStats st1, st2; unsigned poison;
    __device__ __forceinline__ void fused(f32x4 (&acc)[2][2][4][2], const Unit& u, int wr, int wc, int fr, int fq, PG8_LAS unsigned char* lds, int wid, int lane) const {
        typedef float f32x2v __attribute__((ext_vector_type(2))); typedef unsigned u32x2v __attribute__((ext_vector_type(2)));
        const PG8_LAS f32x2v* S = (const PG8_LAS f32x2v*)(lds + 8192);
        const int col0 = u.pn * BM + wc * 32 + 4 * fq;
#pragma unroll
        for (int bj = 0; bj < 2; ++bj)
#pragma unroll
            for (int n = 0; n < 2; ++n) { const f32x4 bv = bias ? *(const f32x4*)(bias + col0 + bj * HALF + n * 16) : (f32x4){0.f, 0.f, 0.f, 0.f};
#pragma unroll
                for (int ai = 0; ai < 2; ++ai)
#pragma unroll
                    for (int m = 0; m < 4; ++m) acc[ai][bj][m][n] += bv; }
        bool bad = st1.run(acc, u, wr, wc, fr, fq, lds, wid, lane) || poison != 0u;
        const float qnan = __builtin_nanf("");
#pragma unroll
        for (int ai = 0; ai < 2; ++ai)
#pragma unroll
            for (int m = 0; m < 4; ++m) { const int r = ai * HALF + wr * 64 + m * 16 + fr; const f32x2v sr = S[r]; const size_t off = (size_t)(u.pm * BM + r) * ldc + col0;
#pragma unroll
                for (int bj = 0; bj < 2; ++bj)
#pragma unroll
                    for (int n = 0; n < 2; ++n) { const f32x4 bs = *(const f32x4*)(base + off + bj * HALF + n * 16); acc[ai][bj][m][n] = bs + (acc[ai][bj][m][n] - sr.x) * sr.y; }
                asm volatile("" : "+v"(acc[ai][0][m][0]), "+v"(acc[ai][0][m][1]), "+v"(acc[ai][1][m][0]), "+v"(acc[ai][1][m][1]));
                if (m & 1) asm volatile("" ::: "memory"); }
        const bool bad1 = bad;
        bad = st2.run(acc, u, wr, wc, fr, fq, lds, wid, lane) || bad;
#pragma unroll
        for (int ai = 0; ai < 2; ++ai)
#pragma unroll
            for (int m = 0; m < 4; ++m) { const int r = ai * HALF + wr * 64 + m * 16 + fr; const f32x2v sr = S[r]; const size_t off = (size_t)(u.pm * BM + r) * ldc + col0;
#pragma unroll
                for (int bj = 0; bj < 2; ++bj)
#pragma unroll
                    for (int n = 0; n < 2; ++n) { const f32x4 x1 = acc[ai][bj][m][n]; *(f32x4*)(out + off + bj * HALF + n * 16) = bad1 ? (f32x4){qnan, qnan, qnan, qnan} : x1;
                        const f32x4 o = (x1 - sr.x) * sr.y; u32x2v w; w.x = cvt_pk_bf16(o[0], o[1]); w.y = cvt_pk_bf16(o[2], o[3]);
                        if (bad) { w.x = 0x7fc07fc0u; w.y = 0x7fc07fc0u; } *(u32x2v*)(xn + off + bj * HALF + n * 16) = w; }
                asm volatile("" ::: "memory"); }
    }
};

template <class Epi, class Sched, bool ALIGN_EPI = false, bool SP2 = false>
__device__ __forceinline__ void gemm_phase(PG8_LAS unsigned char* lds, const Gemm g, const Sched& S, const Epi& E) {
    static_assert(SP2, "only the SP2 loop carries the lda / split-A changes");
    const int tid = threadIdx.x, wid = __builtin_amdgcn_readfirstlane(tid >> 6), lane = tid & 63, wr = wid >> 2, wc = wid & 3, fr = lane & 15, fq = lane >> 4;
    const int K = g.K, nt = K / BK;
    unsigned voffA[2], voffB[2];
#pragma unroll
    for (int i = 0; i < 2; ++i) { int R, C; stage_rc(tid * 16 + i * 8192, R, C); const int Rb = Epi::PERM ? ((R & ~31) + perm32(R & 31)) : R;
        voffA[i] = (unsigned)(R * g.lda + C) * 2u; voffB[i] = (unsigned)(Rb * K + C) * 2u; }
    const size_t kstep = (size_t)(BK * 2);
    const size_t hstep = (size_t)HALF * K * 2, hstepA = (size_t)HALF * g.lda * 2;
    const size_t tstep = 2 * hstep, tstepA = 2 * hstepA; const int ksplit = g.ksplit; const long asadj = g.asadj;
    const unsigned ldsw = (unsigned)wid * 1024u;
    const int aoff = lds_byte(wr * 64 + fr, fq * 8), boff = lds_byte(wc * 32 + fr, fq * 8);
#define PG8_SA(b, h) (((b) * 2 + (h)) * HTB)
#define PG8_SB(b, h) ((4 + (b) * 2 + (h)) * HTB)
#define PG8_STAGE(bufoff, gbase, voff) do { _Pragma("unroll") for (int _i = 0; _i < 2; ++_i) \
        __builtin_amdgcn_global_load_lds((const unsigned*)((const char*)(gbase) + (voff)[_i]), (PG8_LAS unsigned*)(lds + (bufoff) + ldsw + _i * 8192), 16, 0, 0); } while (0)
#define PG8_LDA(dst, b, h) do { _Pragma("unroll") for (int m = 0; m < 4; ++m) _Pragma("unroll") for (int k = 0; k < 2; ++k) dst[m][k] = *(const PG8_LAS bf16x8*)(lds + PG8_SA(b, h) + aoff + m * 2048 + k * 1024); } while (0)
#define PG8_LDB(dst, b, h) do { _Pragma("unroll") for (int n = 0; n < 2; ++n) _Pragma("unroll") for (int k = 0; k < 2; ++k) dst[n][k] = *(const PG8_LAS bf16x8*)(lds + PG8_SB(b, h) + boff + n * 2048 + k * 1024); } while (0)
#define PG8_MMA(ai, bj, At, Bt) do { __builtin_amdgcn_s_setprio(1); _Pragma("unroll") for (int m = 0; m < 4; ++m) _Pragma("unroll") for (int n = 0; n < 2; ++n) _Pragma("unroll") for (int k = 0; k < 2; ++k) \
        acc[ai][bj][m][n] = __builtin_amdgcn_mfma_f32_16x16x32_bf16(Bt[n][k], At[m][k], acc[ai][bj][m][n], 0, 0, 0); __builtin_amdgcn_s_setprio(0); } while (0)
#define PG8_WAIT_V(n) asm volatile("s_waitcnt vmcnt(" #n ")" ::: "memory")
#define PG8_WAIT_L(n) asm volatile("s_waitcnt lgkmcnt(" #n ")" ::: "memory")
#define PG8_BAR __builtin_amdgcn_s_barrier()
#define PG8_SCHED __builtin_amdgcn_sched_barrier(0)
    Unit cur, nxt; int ui = 0;
    if (!S.next(0, cur)) return;
    f32x4 acc[2][2][4][2];
#pragma unroll
    for (int a = 0; a < 2; ++a)
#pragma unroll
        for (int b = 0; b < 2; ++b)
#pragma unroll
            for (int m = 0; m < 4; ++m)
#pragma unroll
                for (int n = 0; n < 2; ++n) acc[a][b][m][n] = (f32x4){0.f, 0.f, 0.f, 0.f};
    bf16x8 At[4][2], B0[2][2], B1[2][2];
    const char* cA = (const char*)g.A + (size_t)cur.pm * tstepA; const char* cB = (const char*)g.Bt + (size_t)cur.pn * tstep;
    S.a_ready(cur);
    if constexpr (SP2) {
        PG8_STAGE(PG8_SB(0, 0), cB, voffB); PG8_STAGE(PG8_SB(0, 1), cB + hstep, voffB); PG8_STAGE(PG8_SA(0, 0), cA, voffA); PG8_STAGE(PG8_SA(0, 1), cA + hstepA, voffA);
        if (wr == 1) PG8_BAR;
        PG8_WAIT_V(2); PG8_BAR;
        PG8_STAGE(PG8_SB(1, 0), cB + kstep, voffB); PG8_STAGE(PG8_SA(1, 0), cA + kstep, voffA); PG8_STAGE(PG8_SB(1, 1), cB + hstep + kstep, voffB);
        PG8_WAIT_V(6); PG8_BAR;
    } else {
        PG8_STAGE(PG8_SB(0, 0), cB, voffB); PG8_STAGE(PG8_SA(0, 0), cA, voffA); PG8_STAGE(PG8_SB(0, 1), cB + hstep, voffB); PG8_STAGE(PG8_SA(0, 1), cA + hstep, voffA);
        if (wr == 1) PG8_BAR;
        PG8_WAIT_V(4); PG8_BAR;
        PG8_STAGE(PG8_SB(1, 0), cB + kstep, voffB); PG8_STAGE(PG8_SA(1, 0), cA + kstep, voffA); PG8_STAGE(PG8_SB(1, 1), cB + hstep + kstep, voffB);
        PG8_WAIT_V(6); PG8_BAR;
    }
    for (;;) {
        const bool has_next = S.next(ui + 1, nxt);
        const char* nA = has_next ? (const char*)g.A + (size_t)nxt.pm * tstepA : cA; const char* nB = has_next ? (const char*)g.Bt + (size_t)nxt.pn * tstep : cB;
        for (int t = 0; t < nt; t += 2) {
            const bool last = (t == nt - 2);
            const char* a1 = cA + (size_t)(t + 1) * kstep + ((t + 1) >= ksplit ? asadj : 0);
            const char* a2 = last ? nA : cA + (size_t)(t + 2) * kstep + ((t + 2) >= ksplit ? asadj : 0); const char* b2 = last ? nB : cB + (size_t)(t + 2) * kstep;
            const char* a3 = a2 + kstep; const char* b3 = b2 + kstep;
            if (last && has_next) S.a_ready(nxt);
            if constexpr (SP2) {
            PG8_LDB(B0, 0, 0); PG8_LDB(B1, 0, 1); PG8_SCHED; PG8_LDA(At, 0, 0); PG8_STAGE(PG8_SA(1, 1), a1 + hstepA, voffA);
            PG8_WAIT_V(8); PG8_WAIT_L(0); PG8_BAR; PG8_MMA(0, 0, At, B0); PG8_MMA(0, 1, At, B1); PG8_BAR; PG8_SCHED;
            PG8_LDA(At, 0, 1); PG8_STAGE(PG8_SB(0, 0), b2, voffB); PG8_STAGE(PG8_SB(0, 1), b2 + hstep, voffB); PG8_STAGE(PG8_SA(0, 0), a2, voffA);
            PG8_WAIT_V(8); PG8_WAIT_L(0); PG8_BAR; PG8_MMA(1, 0, At, B0); PG8_MMA(1, 1, At, B1); PG8_BAR; PG8_SCHED;
            PG8_LDB(B0, 1, 0); PG8_LDB(B1, 1, 1); PG8_SCHED; PG8_LDA(At, 1, 0); PG8_STAGE(PG8_SA(0, 1), a2 + hstepA, voffA);
            PG8_WAIT_V(8); PG8_WAIT_L(0); PG8_BAR; PG8_MMA(0, 0, At, B0); PG8_MMA(0, 1, At, B1); PG8_BAR; PG8_SCHED;
            PG8_LDA(At, 1, 1); PG8_STAGE(PG8_SB(1, 0), b3, voffB); PG8_STAGE(PG8_SB(1, 1), b3 + hstep, voffB); PG8_STAGE(PG8_SA(1, 0), a3, voffA);
            PG8_WAIT_V(8); PG8_WAIT_L(0); PG8_BAR; PG8_MMA(1, 0, At, B0); PG8_MMA(1, 1, At, B1); PG8_BAR; PG8_SCHED;
            } else {
            PG8_LDB(B0, 0, 0); PG8_SCHED; PG8_LDA(At, 0, 0); PG8_STAGE(PG8_SA(1, 1), a1 + hstep, voffA);
            PG8_WAIT_L(8); PG8_BAR; PG8_WAIT_L(0); PG8_MMA(0, 0, At, B0); PG8_BAR; PG8_SCHED;
            PG8_LDB(B1, 0, 1); PG8_STAGE(PG8_SB(0, 0), b2, voffB);
            PG8_BAR; PG8_WAIT_L(0); PG8_MMA(0, 1, At, B1); PG8_BAR;
            PG8_LDA(At, 0, 1); PG8_STAGE(PG8_SA(0, 0), a2, voffA);
            PG8_BAR; PG8_WAIT_L(0); PG8_MMA(1, 0, At, B0); PG8_BAR; PG8_SCHED;
            PG8_STAGE(PG8_SB(0, 1), b2 + hstep, voffB);
            PG8_WAIT_V(6); PG8_BAR; PG8_MMA(1, 1, At, B1); PG8_BAR;
            PG8_LDB(B0, 1, 0); PG8_SCHED; PG8_LDA(At, 1, 0); PG8_STAGE(PG8_SA(0, 1), a2 + hstep, voffA);
            PG8_WAIT_L(8); PG8_BAR; PG8_WAIT_L(0); PG8_MMA(0, 0, At, B0); PG8_BAR; PG8_SCHED;
            PG8_LDB(B1, 1, 1); PG8_STAGE(PG8_SB(1, 0), b3, voffB);
            PG8_BAR; PG8_WAIT_L(0); PG8_MMA(0, 1, At, B1); PG8_BAR;
            PG8_LDA(At, 1, 1); PG8_STAGE(PG8_SA(1, 0), a3, voffA);
            PG8_BAR; PG8_WAIT_L(0); PG8_MMA(1, 0, At, B0); PG8_BAR; PG8_SCHED;
            PG8_STAGE(PG8_SB(1, 1), b3 + hstep, voffB);
            PG8_WAIT_V(6); PG8_BAR; PG8_MMA(1, 1, At, B1); PG8_BAR;
            }
        }
        if constexpr (ALIGN_EPI) { if (wr == 0) PG8_BAR; }
        if constexpr (!Epi::AFTER_DRAIN) { E(acc, cur, wr, wc, fr, fq); S.done(cur); }
        if (!has_next) break;
#pragma unroll
        for (int a = 0; a < 2; ++a)
#pragma unroll
            for (int b = 0; b < 2; ++b)
#pragma unroll
                for (int m = 0; m < 4; ++m)
#pragma unroll
                    for (int n = 0; n < 2; ++n) acc[a][b][m][n] = (f32x4){0.f, 0.f, 0.f, 0.f};
        cur = nxt; cA = nA; cB = nB; ++ui;
        if constexpr (ALIGN_EPI) { if (wr == 1) PG8_BAR; }
    }
    PG8_WAIT_V(0);
    if constexpr (!ALIGN_EPI) { if (wr == 0) PG8_BAR; }
    PG8_BAR;
    if constexpr (Epi::AFTER_DRAIN) { E.fused(acc, cur, wr, wc, fr, fq, lds, wid, lane); S.done(cur); }
#undef PG8_SA
#undef PG8_SB
#undef PG8_STAGE
#undef PG8_LDA
#undef PG8_LDB
#undef PG8_MMA
#undef PG8_WAIT_V
#undef PG8_WAIT_L
#undef PG8_BAR
#undef PG8_SCHED
}
}

#ifndef PG8_SP2
#define PG8_SP2 true
#endif
#ifndef PG8_ALIGN
#define PG8_ALIGN true
#endif
#include <hip/hip_bf16.h>
#include <cmath>
namespace attn_body {
using bf16=__hip_bfloat16;
using bf16x8=__attribute__((ext_vector_type(8)))short;
using s16x4=__attribute__((ext_vector_type(4)))short;
using f32x16=__attribute__((ext_vector_type(16)))float;
using u32x4=__attribute__((ext_vector_type(4)))unsigned;
constexpr int BATCH=2,NHEAD=16,SEQ=8192,D=64,DM=NHEAD*D;
constexpr int NW=8,QBLK=32,QB=QBLK*NW,KVBLK=64,NQB=SEQ/QB;
constexpr int ATTN_PITCH=DM, ATTN_UNIT_ROWS=QB;
__device__ __forceinline__ int crow(int r,int hi){return (r&3)+8*(r>>2)+4*hi;}
#define SBAR() __builtin_amdgcn_sched_barrier(0)
__device__ __forceinline__ void cmask(f32x16&p0,f32x16&p1,int jb,int qrel,int hi){
  const float NEG=-INFINITY; int kb=64*jb+4*hi;
  #pragma unroll
  for(int r=0;r<16;++r){int kv=kb+(r&3)+8*(r>>2); if(kv>qrel)p0[r]=NEG; if(kv+32>qrel)p1[r]=NEG;}
}

constexpr int NSLOT=3, SLOTB=8192;
constexpr int LDS_K=0, LDS_V=NSLOT*SLOTB, LDS_WS=2*NSLOT*SLOTB, LDS_OST=LDS_WS+NW*64*4, LDS_BIAS=LDS_OST+NW*4096, LDS_BYTES=LDS_BIAS+SEQ*4;
constexpr float C2=0.125f*1.4426950408889634f;
__device__ __forceinline__ void glds16(const void*sbase,unsigned voff,unsigned lds_dst){unsigned keep;
  asm volatile("s_mov_b32 %0, m0\n\ts_mov_b32 m0, %2\n\ts_nop 0\n\tglobal_load_lds_dwordx4 %1, %3\n\ts_mov_b32 m0, %0":"=&s"(keep):"v"(voff),"s"(lds_dst),"s"(sbase):"memory");}
__device__ __forceinline__ float max3f(float a,float b,float c){float r;asm("v_max3_f32 %0, %1, %2, %3":"=v"(r):"v"(a),"v"(b),"v"(c));return r;}
__device__ __forceinline__ float max2f(float a,float b){float r;asm("v_max_f32_e32 %0, %1, %2":"=v"(r):"v"(a),"v"(b));return r;}
__device__ __forceinline__ float fadd_s(float a,float b){float r;asm("v_add_f32_e32 %0, %1, %2":"=v"(r):"v"(a),"v"(b));return r;}
__device__ __forceinline__ float fsub_s(float a,float b){float r;asm("v_sub_f32_e32 %0, %1, %2":"=v"(r):"v"(a),"v"(b));return r;}
typedef float f32x2_t __attribute__((ext_vector_type(2))); typedef __bf16 bf16x2_t __attribute__((ext_vector_type(2)));
__device__ __forceinline__ unsigned cvtpk_s(float lo,float hi){f32x2_t v={lo,hi};bf16x2_t b=__builtin_convertvector(v,bf16x2_t);return __builtin_bit_cast(unsigned,b);}
#define WAIT_BAR(N) asm volatile("s_waitcnt vmcnt(" #N ") lgkmcnt(0)\n\ts_barrier":::"memory")

__device__ __forceinline__ void qkt(f32x16&p0,f32x16&p1,const char*Kslot,const bf16x8*qr,int r32,int hi){
  const char*kb=Kslot+hi*1024+r32*16;
  #pragma unroll
  for(int d0=0;d0<4;++d0){
    const bf16x8 b0=*reinterpret_cast<const bf16x8*>(kb+d0*2048);
    const bf16x8 b1=*reinterpret_cast<const bf16x8*>(kb+d0*2048+512);
    {p0=__builtin_amdgcn_mfma_f32_32x32x16_bf16(b0,qr[d0],p0,0,0,0);p1=__builtin_amdgcn_mfma_f32_32x32x16_bf16(b1,qr[d0],p1,0,0,0);}}
}
typedef __attribute__((address_space(3))) const char* lds_cptr;
typedef short v4i16_t __attribute__((ext_vector_type(4)));
__device__ __forceinline__ void kload8(bf16x8*kf,lds_cptr kp){
  kf[0]=*(const __attribute__((address_space(3))) bf16x8*)(kp);      kf[1]=*(const __attribute__((address_space(3))) bf16x8*)(kp+512);
  kf[2]=*(const __attribute__((address_space(3))) bf16x8*)(kp+2048); kf[3]=*(const __attribute__((address_space(3))) bf16x8*)(kp+2560);
  kf[4]=*(const __attribute__((address_space(3))) bf16x8*)(kp+4096); kf[5]=*(const __attribute__((address_space(3))) bf16x8*)(kp+4608);
  kf[6]=*(const __attribute__((address_space(3))) bf16x8*)(kp+6144); kf[7]=*(const __attribute__((address_space(3))) bf16x8*)(kp+6656);
}
__device__ __forceinline__ void kload2(bf16x8*kf,lds_cptr kp,int j){ kf[2*j]=*(const __attribute__((address_space(3))) bf16x8*)(kp+j*2048); kf[2*j+1]=*(const __attribute__((address_space(3))) bf16x8*)(kp+j*2048+512); }
__device__ __forceinline__ s16x4 vtr(lds_cptr p){ return __builtin_bit_cast(s16x4,__builtin_amdgcn_ds_read_tr16_b64_v4i16((__attribute__((address_space(3))) v4i16_t*)p)); }
__device__ __forceinline__ float rowmax(const f32x16&p0,const f32x16&p1){
  float a=max3f(p0[0],p0[1],p1[0]),b=max3f(p0[2],p0[3],p1[1]);a=max3f(a,p1[2],p1[3]);
  #pragma unroll
  for(int r=4;r<16;r+=4){a=max3f(a,p0[r],p0[r+1]);b=max3f(b,p0[r+2],p0[r+3]);a=max3f(a,p1[r],p1[r+1]);b=max3f(b,p1[r+2],p1[r+3]);}
  const float m=max2f(a,b);
  auto rr=__builtin_amdgcn_permlane32_swap(__float_as_uint(m),__float_as_uint(m),false,false);
  return max2f(__uint_as_float(rr[0]),__uint_as_float(rr[1]));
}
__device__ __forceinline__ void pv(f32x16*o,int vb,bf16x8 pa0,bf16x8 pa1,bf16x8 pa2,bf16x8 pa3){
  #pragma unroll
  for(int d0=0;d0<2;++d0){s16x4 lo[4],hi[4];
    #pragma unroll
    for(int ks=0;ks<4;++ks){
      asm volatile("ds_read_b64_tr_b16 %0,%1 offset:%c2":"=&v"(lo[ks]):"v"(vb),"i"(d0*4096+ks*1024):"memory");
      asm volatile("ds_read_b64_tr_b16 %0,%1 offset:%c2":"=&v"(hi[ks]):"v"(vb),"i"(d0*4096+ks*1024+512):"memory");}
    asm volatile("s_waitcnt lgkmcnt(0)":::"memory");SBAR();
    #define PK(k) (bf16x8){lo[k][0],lo[k][1],lo[k][2],lo[k][3],hi[k][0],hi[k][1],hi[k][2],hi[k][3]}
    o[d0]=__builtin_amdgcn_mfma_f32_32x32x16_bf16(pa0,PK(0),o[d0],0,0,0);
    o[d0]=__builtin_amdgcn_mfma_f32_32x32x16_bf16(pa1,PK(1),o[d0],0,0,0);
    o[d0]=__builtin_amdgcn_mfma_f32_32x32x16_bf16(pa2,PK(2),o[d0],0,0,0);
    o[d0]=__builtin_amdgcn_mfma_f32_32x32x16_bf16(pa3,PK(3),o[d0],0,0,0);
    #undef PK
  }
}

#ifndef ATTN_STORE16
#define ATTN_STORE16(p,v) (*(u32x4*)(p)=(v))
#endif
typedef float f32x4v __attribute__((ext_vector_type(4)));
template<int THRL> __device__ __forceinline__ void attn_unit(int b,int h,int qb,const bf16*Q,const bf16*__restrict__ K,const bf16*__restrict__ V,bf16*O,const float*FB,const bf16*Z,const float*GN,char*shm){
  const int tid=threadIdx.x,lane=tid&63,r32=lane&31,hi=lane>>5; const int wid=__builtin_amdgcn_readfirstlane(tid>>6);
  const long rowbase=(long)b*SEQ; const int q0=qb*QB;
  const bf16*Qw=Q+(rowbase+q0+wid*QBLK)*DM+h*D;
  const bf16*Kh=K+rowbase*DM+h*D,*Vh=V+rowbase*DM+h*D;
  const unsigned lds0=(unsigned)(uintptr_t)shm;
  float*wsf=(float*)(shm+LDS_WS)+wid*64;
  const unsigned ksrc=(unsigned)((lane*DM+wid*8)*2);
  const unsigned vsrc=(unsigned)(((16*(wid&3)+(lane>>2))*DM+(wid>>2)*32+(lane&3)*8)*2);
  const unsigned kdst=lds0+LDS_K+wid*1024, vdst=lds0+LDS_V+wid*1024;
  #define DMA_K(t,slot) glds16((const char*)Kh+(long)(NT-1-(t))*(KVBLK*DM*2),ksrc,(unsigned)__builtin_amdgcn_readfirstlane(kdst+(slot)))
  #define DMA_V(t,slot) glds16((const char*)Vh+(long)(NT-1-(t))*(KVBLK*DM*2),vsrc,(unsigned)__builtin_amdgcn_readfirstlane(vdst+(slot)))
  #define vb0 ((int)(lds0+LDS_V)+((lane>>4)&1)*32+(lane&3)*8+(4*hi+((lane&15)>>2))*64)
  const char*Kbase=shm+LDS_K; bf16x8 kf[8];
  const lds_cptr shm3=(lds_cptr)shm; const lds_cptr kp0=shm3+LDS_K+hi*1024+r32*16; const lds_cptr vp0=shm3+LDS_V+((lane>>4)&1)*32+(lane&3)*8+(4*hi+((lane&15)>>2))*64;
  const int NT=(q0+QB)/KVBLK;
  { const float*fbh=FB+((long)b*NHEAD+h)*SEQ; __attribute__((address_space(3))) float*bl=(__attribute__((address_space(3))) float*)((__attribute__((address_space(3))) char*)shm+LDS_BIAS);
    for(int i=tid*4;i<NT*KVBLK;i+=NW*64*4) *(__attribute__((address_space(3))) f32x4v*)(bl+i)=*(const f32x4v*)(fbh+i); }
  const __attribute__((address_space(3))) float*biasL=(const __attribute__((address_space(3))) float*)(shm3+LDS_BIAS)+4*hi;
  DMA_K(0,0);DMA_V(0,0);DMA_K(1,SLOTB);
  bf16x8 qr[4];
  #pragma unroll
  for(int d0=0;d0<4;++d0)qr[d0]=*reinterpret_cast<const bf16x8*>(&Qw[(long)r32*DM+d0*16+hi*8]);
  float mhat=0.f,l_reg=0.f;f32x16 o[2];o[0]=f32x16{};o[1]=f32x16{};
  #define qrel (wid*QBLK+r32)
  #define CMASK(P0,P1,t) do{int jb_=3-(t); if(jb_>=0)cmask(P0,P1,jb_,qrel,hi);}while(0)
  bool resc=false;
  #define START(P0,P1) do{ const float rm=rowmax(P0,P1); resc=false; \
    { const float dl=(rm>-1e30f)?rm:0.f; mhat=fadd_s(mhat,dl); \
      _Pragma("unroll") for(int r=0;r<16;++r){P0[r]=fsub_s(P0[r],dl);P1[r]=fsub_s(P1[r],dl);} \
 } \
    _Pragma("unroll") for(int r=0;r<16;++r)P0[r]=__builtin_amdgcn_exp2f(P0[r]); }while(0)
  #define RESC() do{ if(resc){ asm volatile("s_waitcnt lgkmcnt(0)":::"memory"); \
      _Pragma("unroll") for(int d_=0;d_<2;++d_) _Pragma("unroll") for(int r=0;r<16;++r)o[d_][r]*=wsf[crow(r,hi)]; } }while(0)
  #define BIASINIT(C0,C1,t) do{ const __attribute__((address_space(3))) float*bp_=biasL+64*(NT-1-(t)); \
    _Pragma("unroll") for(int g_=0;g_<4;++g_){ const f32x4v u0_=*(const __attribute__((address_space(3))) f32x4v*)(bp_+8*g_); const f32x4v u1_=*(const __attribute__((address_space(3))) f32x4v*)(bp_+32+8*g_); \
      _Pragma("unroll") for(int j_=0;j_<4;++j_){ C0[4*g_+j_]=u0_[j_]-mhat; C1[4*g_+j_]=u1_[j_]-mhat; } } }while(0)
  f32x16 pA0,pA1,pB0,pB1;
  int sl_prev=0,sl_cur=0,sl_next=SLOTB;
  #define ROT() do{sl_prev=sl_cur;sl_cur=sl_next;sl_next=(sl_next==(NSLOT-1)*SLOTB)?0:sl_next+SLOTB;}while(0)
  DMA_K(2,2*SLOTB);
  WAIT_BAR(3);
  mhat=(biasL-4*hi)[q0+qrel]; BIASINIT(pA0,pA1,0); qkt(pA0,pA1,Kbase,qr,r32,hi);asm volatile("s_nop 15\n\ts_nop 7":"+v"(pA0),"+v"(pA1));CMASK(pA0,pA1,0);
  START(pA0,pA1);
  _Pragma("unroll") for(int r=0;r<16;++r)pA1[r]=__builtin_amdgcn_exp2f(pA1[r]);
  WAIT_BAR(0);
  DMA_K(3,0);DMA_V(1,SLOTB);
  ROT();
  kload8(kf,kp0+sl_cur);
  WAIT_BAR(2);
  s16x4 vlo[8],vhi[8]; u32x4 pw0,pw1,pw2,pw3;
  #define PKW(P,B) cvtpk_s(P[B],P[B+1])
  #define PAF(k) __builtin_bit_cast(bf16x8,pw##k)
  #define VFR(i) (bf16x8){vlo[i][0],vlo[i][1],vlo[i][2],vlo[i][3],vhi[i][0],vhi[i][1],vhi[i][2],vhi[i][3]}
  #define PIN(x) asm volatile("":"+v"(x))
  #define MX3(a,b,c) __builtin_fmaxf(__builtin_fmaxf((a),(b)),(c))
  #define GAPA(MF,A0,A1,A2,A3,W0,W1,PW) do{ MF; sacc+=A0; sacc+=A1; sacc+=A2; sacc+=A3; PIN(sacc); W0; W1; PIN(PW); SBAR(); }while(0)
  #define EX(v) __builtin_amdgcn_exp2f(v)
  #define GAPB(MF,X,B) do{ MF; X[B]=EX(X[B]); X[B+1]=EX(X[B+1]); X[B+2]=EX(X[B+2]); X[B+3]=EX(X[B+3]); PIN(X); SBAR(); }while(0)
  #define VRD(i) do{ vlo[i]=vtr(vp_+(((i)>>2)*4096+((i)&3)*1024)); vhi[i]=vtr(vp_+(((i)>>2)*4096+((i)&3)*1024+512)); }while(0)
  #define KRD(G,j) do{ if(G){ kload2(kf,kp0+sl_next,j); SBAR(); } }while(0)
  #define STEP(C0,C1,P0,P1,t,GK,GV,GL) do{ SBAR(); BIASINIT(C0,C1,t); SBAR(); \
    const lds_cptr vp_=vp0+sl_prev; \
    VRD(0); SBAR(); float sacc=(P0[0]+P0[1]); \
    GAPA(C0=__builtin_amdgcn_mfma_f32_32x32x16_bf16(kf[0],qr[0],C0,0,0,0), P0[2],P0[3],P0[4],P0[5],     pw0[0]=PKW(P0,0), pw0[1]=PKW(P0,2), pw0); \
    VRD(4); SBAR(); GAPA(C1=__builtin_amdgcn_mfma_f32_32x32x16_bf16(kf[1],qr[0],C1,0,0,0), P0[6],P0[7],P0[8],P0[9],     pw0[2]=PKW(P0,4), pw0[3]=PKW(P0,6), pw0); \
    VRD(1); SBAR(); GAPA(C0=__builtin_amdgcn_mfma_f32_32x32x16_bf16(kf[2],qr[1],C0,0,0,0),   P0[10],P0[11],P0[12],P0[13], pw1[0]=PKW(P0,8), pw1[1]=PKW(P0,10), pw1); \
    VRD(5); SBAR(); GAPA(C1=__builtin_amdgcn_mfma_f32_32x32x16_bf16(kf[3],qr[1],C1,0,0,0),   P0[14],P0[15],P1[0],P1[1],   pw1[2]=PKW(P0,12),pw1[3]=PKW(P0,14), pw1); \
    VRD(2); SBAR(); GAPA(C0=__builtin_amdgcn_mfma_f32_32x32x16_bf16(kf[4],qr[2],C0,0,0,0),   P1[2],P1[3],P1[4],P1[5],     pw2[0]=PKW(P1,0), pw2[1]=PKW(P1,2), pw2); \
    VRD(6); SBAR(); GAPA(C1=__builtin_amdgcn_mfma_f32_32x32x16_bf16(kf[5],qr[2],C1,0,0,0),   P1[6],P1[7],P1[8],P1[9],     pw2[2]=PKW(P1,4), pw2[3]=PKW(P1,6), pw2); \
    VRD(3); SBAR(); GAPA(C0=__builtin_amdgcn_mfma_f32_32x32x16_bf16(kf[6],qr[3],C0,0,0,0),   P1[10],P1[11],P1[12],P1[13], pw3[0]=PKW(P1,8), pw3[1]=PKW(P1,10), pw3); \
    VRD(7); SBAR(); GAPA(C1=__builtin_amdgcn_mfma_f32_32x32x16_bf16(kf[7],qr[3],C1,0,0,0),   P1[14],P1[15],0.f,0.f,       pw3[2]=PKW(P1,12),pw3[3]=PKW(P1,14), pw3); \
    l_reg+=sacc; \
    if(GK){DMA_K((t)+3,sl_cur);} if(GV){DMA_V((t)+1,sl_next);} \
    CMASK(C0,C1,t); \
    { float a=MX3(C0[0],C0[1],C1[0]),b=MX3(C0[2],C0[3],C1[1]); a=MX3(a,C1[2],C1[3]); \
      _Pragma("unroll") for(int r=4;r<16;r+=4){a=MX3(a,C0[r],C0[r+1]);b=MX3(b,C0[r+2],C0[r+3]);a=MX3(a,C1[r],C1[r+1]);b=MX3(b,C1[r+2],C1[r+3]);} \
      float rm=__builtin_fmaxf(a,b); { auto rr=__builtin_amdgcn_permlane32_swap(__float_as_uint(rm),__float_as_uint(rm),false,false); rm=__builtin_fmaxf(__uint_as_float(rr[0]),__uint_as_float(rr[1])); } \
      resc=false; \
      if(__builtin_expect(__any(rm>(float)THRL),0)){ const float dl=__builtin_fmaxf(rm,0.f); mhat+=dl; \
        _Pragma("unroll") for(int r=0;r<16;++r){C0[r]-=dl;C1[r]-=dl;} \
        const float f=__builtin_amdgcn_exp2f(-dl); l_reg*=f; if(hi==0)wsf[r32]=f; resc=true; } } \
    SBAR(); \
    GAPB(o[0]=__builtin_amdgcn_mfma_f32_32x32x16_bf16(PAF(0),VFR(0),o[0],0,0,0), C0,0); \
    GAPB(o[1]=__builtin_amdgcn_mfma_f32_32x32x16_bf16(PAF(0),VFR(4),o[1],0,0,0), C0,4); \
    KRD(GL,0); GAPB(o[0]=__builtin_amdgcn_mfma_f32_32x32x16_bf16(PAF(1),VFR(1),o[0],0,0,0), C0,8); \
    KRD(GL,1); GAPB(o[1]=__builtin_amdgcn_mfma_f32_32x32x16_bf16(PAF(1),VFR(5),o[1],0,0,0), C0,12); \
    KRD(GL,2); GAPB(o[0]=__builtin_amdgcn_mfma_f32_32x32x16_bf16(PAF(2),VFR(2),o[0],0,0,0), C1,0); \
    KRD(GL,3); GAPB(o[1]=__builtin_amdgcn_mfma_f32_32x32x16_bf16(PAF(2),VFR(6),o[1],0,0,0), C1,4); \
    GAPB(o[0]=__builtin_amdgcn_mfma_f32_32x32x16_bf16(PAF(3),VFR(3),o[0],0,0,0), C1,8); \
    GAPB(o[1]=__builtin_amdgcn_mfma_f32_32x32x16_bf16(PAF(3),VFR(7),o[1],0,0,0), C1,12); \
    }while(0)
  int t=1;
  #define ENDW(tt) do{ if((tt)+3<NT){WAIT_BAR(2);} else if((tt)+2<NT){WAIT_BAR(1);} else {WAIT_BAR(0);} }while(0)
  for(;t+1<NT&&t<4;t+=2){
    STEP(pB0,pB1,pA0,pA1,t,(t+3<NT),(t+1<NT),(t+1<NT));       ENDW(t);   RESC(); ROT();
    STEP(pA0,pA1,pB0,pB1,t+1,(t+4<NT),(t+2<NT),(t+2<NT));     ENDW(t+1); RESC(); ROT();
  }
  #undef CMASK
  #define CMASK(P0,P1,t) do{}while(0)
  for(;t+5<NT;t+=2){
    STEP(pB0,pB1,pA0,pA1,t,true,true,true);     WAIT_BAR(2); RESC(); ROT();
    STEP(pA0,pA1,pB0,pB1,t+1,true,true,true);   WAIT_BAR(2); RESC(); ROT();
  }
  #undef CMASK
  #define CMASK(P0,P1,t) do{int jb_=3-(t); if(jb_>=0)cmask(P0,P1,jb_,qrel,hi);}while(0)
  for(;t+1<NT;t+=2){
    STEP(pB0,pB1,pA0,pA1,t,(t+3<NT),(t+1<NT),(t+1<NT));       ENDW(t);   RESC(); ROT();
    STEP(pA0,pA1,pB0,pB1,t+1,(t+4<NT),(t+2<NT),(t+2<NT));     ENDW(t+1); RESC(); ROT();
  }
  STEP(pB0,pB1,pA0,pA1,NT-1,false,false,false); RESC();
  { float sacc=pB0[0]+pB0[1]; _Pragma("unroll") for(int r=2;r<16;++r)sacc+=pB0[r]; _Pragma("unroll") for(int r=0;r<16;++r)sacc+=pB1[r]; l_reg+=sacc;
    pw0=(u32x4){PKW(pB0,0),PKW(pB0,2),PKW(pB0,4),PKW(pB0,6)};pw1=(u32x4){PKW(pB0,8),PKW(pB0,10),PKW(pB0,12),PKW(pB0,14)};pw2=(u32x4){PKW(pB1,0),PKW(pB1,2),PKW(pB1,4),PKW(pB1,6)};pw3=(u32x4){PKW(pB1,8),PKW(pB1,10),PKW(pB1,12),PKW(pB1,14)};
    SBAR(); pv(o,vb0+sl_cur,PAF(0),PAF(1),PAF(2),PAF(3)); }
  #undef PKW
  #undef PAF
  #undef VFR
  #undef PIN
  #undef MX3
  #undef GAPA
  #undef GAPB
  #undef EX
  #undef VRD
  #undef KRD
  #undef STEP
  #undef ENDW
  {auto rr=__builtin_amdgcn_permlane32_swap(__float_as_uint(l_reg),__float_as_uint(l_reg),false,false);l_reg=__uint_as_float(rr[0])+__uint_as_float(rr[1]);}
  if(hi==0)wsf[32+r32]=l_reg;asm volatile("s_waitcnt lgkmcnt(0)":::"memory");
  float rli[16];
  #pragma unroll
  for(int r=0;r<16;++r)rli[r]=__builtin_amdgcn_rcpf(wsf[32+crow(r,hi)]);
  bf16*Ow=O+(rowbase+q0+wid*QBLK)*DM+h*D; const bf16*Zw=Z+(rowbase+q0+wid*QBLK)*DM+h*D;
  { bf16*stg=(bf16*)(shm+LDS_OST)+wid*2048;
    #pragma unroll
    for(int r=0;r<16;++r){const int orow=crow(r,hi);
      #pragma unroll
      for(int d0=0;d0<2;++d0)stg[orow*64+d0*32+r32]=__float2bfloat16(o[d0][r]*rli[r]);}
    asm volatile("s_waitcnt lgkmcnt(0)":::"memory");
    #pragma unroll
    for(int i=0;i<4;++i){const int row=i*8+(lane>>3),ch=lane&7; const u32x4 v=*(const u32x4*)(stg+row*64+ch*8); const u32x4 zz=*(const u32x4*)(Zw+(long)row*DM+ch*8);
      float a[8]; float ss=0.f;
      _Pragma("unroll") for(int j=0;j<4;++j){a[2*j]=__uint_as_float(v[j]<<16);a[2*j+1]=__uint_as_float(v[j]&0xffff0000u);ss+=a[2*j]*a[2*j]+a[2*j+1]*a[2*j+1];}
      ss+=__shfl_xor(ss,1);ss+=__shfl_xor(ss,2);ss+=__shfl_xor(ss,4);
      const float rs=rsqrtf(ss*(1.f/64.f)+1e-6f); u32x4 w;
      _Pragma("unroll") for(int j=0;j<4;++j){const float z0=__uint_as_float(zz[j]<<16),z1=__uint_as_float(zz[j]&0xffff0000u);
        const float y0=a[2*j]*rs*GN[ch*8+2*j]*(z0/(1.f+__expf(-z0))), y1=a[2*j+1]*rs*GN[ch*8+2*j+1]*(z1/(1.f+__expf(-z1))); w[j]=cvtpk_s(y0,y1);}
      ATTN_STORE16(Ow+(long)row*DM+ch*8,w);} }
  asm volatile("s_waitcnt lgkmcnt(0)\n\ts_barrier":::"memory");
  #undef BIASINIT
  #undef qrel
  #undef vb0
  #undef DMA_K
  #undef DMA_V
  #undef CMASK
  #undef START
  #undef RESC
  #undef ROT
}
constexpr int ATTN_LDS_BYTES=LDS_BYTES;
struct AttnTensors { const bf16* Q; const bf16* K; const bf16* V; bf16* O; const float* FB; const bf16* Z; const float* GN; };
struct AttnUnit { int bh; int qb; };
struct StaticOrder {
  int vcu;
  __device__ __forceinline__ explicit StaticOrder(int grid,int block):vcu((block%8)*(grid/8)+block/8){}
  __device__ __forceinline__ bool next(int i,AttnUnit&u)const{ if(i>=4)return false; const int s=vcu&7; u.bh=vcu>>3; u.qb=(i==0)?s:(i==1)?15-s:(i==2)?16+s:31-s; return true; }
  __device__ __forceinline__ void a_ready(const AttnUnit&)const{}
  __device__ __forceinline__ void done(const AttnUnit&)const{}
};
template<class Sched,int THRL=8> __device__ __forceinline__ void attn_phase(char*lds,const AttnTensors&T,const Sched&S){
  AttnUnit u;
  for(int i=0;S.next(i,u);++i){ S.a_ready(u); attn_unit<THRL>(u.bh/NHEAD,u.bh%NHEAD,u.qb,T.Q,T.K,T.V,T.O,T.FB,T.Z,T.GN,lds); S.done(u); }
}
#undef SBAR
#undef WAIT_BAR
}
namespace pg8 {
typedef unsigned u32x2 __attribute__((ext_vector_type(2)));
__device__ __forceinline__ float bf_lo(unsigned w) { return __uint_as_float(w << 16); }
__device__ __forceinline__ float bf_hi(unsigned w) { return __uint_as_float(w & 0xffff0000u); }
struct EpiIn {
    static constexpr bool PERM = true, AFTER_DRAIN = false;
    bf16_t *ZS, *XBC, *ZA, *Q, *K, *V; float* DTF; float qscale;
    __device__ __forceinline__ void operator()(const f32x4 (&acc)[2][2][4][2], const Unit& u, int wr, int wc, int fr, int fq) const {
        const int pn = u.pn; const int row0 = u.pm * BM + wr * 64 + fr;
        if (pn == 26) {
            if (wc == 0) {
#pragma unroll
                for (int ai = 0; ai < 2; ++ai)
#pragma unroll
                    for (int m = 0; m < 4; ++m) { float* rowp = DTF + (size_t)(row0 + ai * HALF + m * 16) * 32 + 8 * fq;
                        *(f32x4*)(rowp) = acc[ai][0][m][0]; *(f32x4*)(rowp + 4) = acc[ai][0][m][1]; }
            }
            return;
        }
        bf16_t* base; int ldc, colt; float sc = 1.f;
        if (pn < 4) { base = ZS; ldc = 1024; colt = pn * 256; }
        else if (pn < 10) { base = XBC; ldc = 1536; colt = (pn - 4) * 256; }
        else if (pn < 14) { base = ZA; ldc = 1024; colt = (pn - 10) * 256; }
        else if (pn < 18) { base = Q; ldc = 1024; colt = (pn - 14) * 256; sc = qscale; }
        else if (pn < 22) { base = K; ldc = 1024; colt = (pn - 18) * 256; }
        else { base = V; ldc = 1024; colt = (pn - 22) * 256; }
        const int col0 = colt + wc * 32 + 8 * fq;
#pragma unroll
        for (int ai = 0; ai < 2; ++ai)
#pragma unroll
            for (int m = 0; m < 4; ++m) { bf16_t* rowp = base + (size_t)(row0 + ai * HALF + m * 16) * ldc + col0;
#pragma unroll
                for (int bj = 0; bj < 2; ++bj) { const f32x4 v0 = acc[ai][bj][m][0] * sc, v1 = acc[ai][bj][m][1] * sc;
                    u32x4 w; w.x = cvt_pk_bf16(v0[0], v0[1]); w.y = cvt_pk_bf16(v0[2], v0[3]); w.z = cvt_pk_bf16(v1[0], v1[1]); w.w = cvt_pk_bf16(v1[2], v1[3]);
                    *(u32x4*)(rowp + bj * HALF) = w; } }
    }
};
struct EpiRes {
    static constexpr bool PERM = false, AFTER_DRAIN = false;
    const float* base; float* out; int ldc;
    __device__ __forceinline__ void operator()(const f32x4 (&acc)[2][2][4][2], const Unit& u, int wr, int wc, int fr, int fq) const {
        const int col0 = u.pn * BM + wc * 32 + 4 * fq;
#pragma unroll
        for (int ai = 0; ai < 2; ++ai)
#pragma unroll
            for (int m = 0; m < 4; ++m) { const size_t off = (size_t)(u.pm * BM + ai * HALF + wr * 64 + m * 16 + fr) * ldc + col0;
#pragma unroll
                for (int bj = 0; bj < 2; ++bj)
#pragma unroll
                    for (int n = 0; n < 2; ++n) { const size_t o = off + bj * HALF + n * 16; *(f32x4*)(out + o) = *(const f32x4*)(base + o) + acc[ai][bj][m][n]; } }
    }
};
struct EpiGate {
    static constexpr bool PERM = false, AFTER_DRAIN = false;
    float* io; const bf16_t* PP; int ldc;
    __device__ __forceinline__ void operator()(const f32x4 (&acc)[2][2][4][2], const Unit& u, int wr, int wc, int fr, int fq) const {
        const int col0 = u.pn * BM + wc * 32 + 4 * fq;
#pragma unroll
        for (int ai = 0; ai < 2; ++ai)
#pragma unroll
            for (int m = 0; m < 4; ++m) { const size_t off = (size_t)(u.pm * BM + ai * HALF + wr * 64 + m * 16 + fr) * ldc + col0;
#pragma unroll
                for (int bj = 0; bj < 2; ++bj)
#pragma unroll
                    for (int n = 0; n < 2; ++n) { const size_t o = off + bj * HALF + n * 16; const f32x4 h = *(const f32x4*)(io + o); const u32x2 pw = *(const u32x2*)(PP + o);
                        const f32x4 a = acc[ai][bj][m][n]; f32x4 r;
                        r[0] = h[0] + bf_lo(pw.x) / (1.f + __expf(-a[0])); r[1] = h[1] + bf_hi(pw.x) / (1.f + __expf(-a[1]));
                        r[2] = h[2] + bf_lo(pw.y) / (1.f + __expf(-a[2])); r[3] = h[3] + bf_hi(pw.y) / (1.f + __expf(-a[3]));
                        *(f32x4*)(io + o) = r; } }
    }
};
}

namespace ssd {
#define LAS3 __attribute__((address_space(3)))
typedef unsigned short bf16_t;
typedef short bf16x8 __attribute__((ext_vector_type(8)));
typedef float f32x2 __attribute__((ext_vector_type(2)));
typedef float f32x4 __attribute__((ext_vector_type(4)));
typedef float f32x16 __attribute__((ext_vector_type(16)));
typedef unsigned u32x2 __attribute__((ext_vector_type(2)));
typedef unsigned u32x4 __attribute__((ext_vector_type(4)));
typedef __bf16 bf16x2_t __attribute__((ext_vector_type(2)));
__device__ __forceinline__ unsigned pk(float lo, float hi) { f32x2 v = {lo, hi}; bf16x2_t b = __builtin_convertvector(v, bf16x2_t); return __builtin_bit_cast(unsigned, b); }
__device__ __forceinline__ float bf1(bf16_t b) { return __uint_as_float((unsigned)b << 16); }
__device__ __forceinline__ float lo(unsigned w) { return __uint_as_float(w << 16); }
__device__ __forceinline__ float hi16(unsigned w) { return __uint_as_float(w & 0xffff0000u); }
__device__ __forceinline__ bf16_t tobf(float f) { return (bf16_t)(pk(f, 0.f) & 0xffffu); }
__device__ __forceinline__ int crow(int r, int hi) { return (r & 3) + 8 * (r >> 2) + 4 * hi; }
__device__ __forceinline__ bf16x8 pack8(const float* m) { u32x4 w; w.x = pk(m[0], m[1]); w.y = pk(m[2], m[3]); w.z = pk(m[4], m[5]); w.w = pk(m[6], m[7]); return __builtin_bit_cast(bf16x8, w); }
constexpr float LOG2E = 1.4426950408889634f;

__device__ __forceinline__ void pre_item(int item, const bf16_t* __restrict__ XBC, const float* __restrict__ DTF, const float* __restrict__ conv_w, const float* __restrict__ conv_b,
                                         const float* __restrict__ dt_bias, const float* __restrict__ a_log, bf16_t* __restrict__ XDTT, bf16_t* __restrict__ Bn, bf16_t* __restrict__ BT,
                                         bf16_t* __restrict__ Cn, float* __restrict__ ACS, float* __restrict__ DT, LAS3 unsigned char* lds) {
    const int tid = threadIdx.x, lane = tid & 63, wid = tid >> 6;
    const int chunk = item / 6, j = item - chunk * 6, c = chunk & 63;
    const size_t m0 = (size_t)chunk * 128;
    LAS3 float* s_dt = (LAS3 float*)lds;
    LAS3 float* s_tot = s_dt + 512;
    __syncthreads();
    if (j < 4) {
        const int hl = tid >> 7, l = tid & 127, h = 4 * j + hl;
        const float raw = DTF[(m0 + l) * 32 + h] + dt_bias[h];
        const float dtv = fmaxf(raw, 0.f) + log1pf(expf(-fabsf(raw)));
        const float adt = -expf(a_log[h]) * dtv;
        float s = adt;
#pragma unroll
        for (int o = 1; o < 64; o <<= 1) { const float t = __shfl_up(s, o); if (lane >= o) s += t; }
        if (lane == 63) s_tot[wid] = s;
        s_dt[hl * 128 + l] = dtv;
        __syncthreads();
        if (wid & 1) s += s_tot[wid - 1];
        ACS[((size_t)chunk * 16 + h) * 128 + l] = s;
        DT[((size_t)chunk * 16 + h) * 128 + l] = dtv;
    }
    const int ch = tid & 255, half = tid >> 8, cx = 256 * j + ch, l0 = half * 64;
    const float w0 = conv_w[cx], w1 = conv_w[1536 + cx], w2 = conv_w[2 * 1536 + cx], w3 = conv_w[3 * 1536 + cx], cb = conv_b[cx];
    const bf16_t* src = XBC + (m0 + l0) * 1536 + cx;
    float xm3 = 0.f, xm2 = 0.f, xm1 = 0.f;
    if (!(c == 0 && half == 0)) { xm3 = bf1(src[-3 * 1536]); xm2 = bf1(src[-2 * 1536]); xm1 = bf1(src[-1536]); }
    const int hl = ch >> 6;
    for (int g8 = 0; g8 < 8; ++g8) {
        float v[8];
#pragma unroll
        for (int i = 0; i < 8; ++i) {
            const float xin = bf1(src[(size_t)(g8 * 8 + i) * 1536]);
            const float cv = cb + w0 * xm3 + w1 * xm2 + w2 * xm1 + w3 * xin;
            xm3 = xm2; xm2 = xm1; xm1 = xin;
            v[i] = cv / (1.f + __expf(-cv));
        }
        const int l = l0 + g8 * 8;
        if (j < 4) {
#pragma unroll
            for (int i = 0; i < 8; ++i) v[i] *= s_dt[hl * 128 + l + i];
            *(bf16x8*)(XDTT + ((size_t)chunk * 1024 + cx) * 128 + l) = pack8(v);
        } else if (j == 4) {
#pragma unroll
            for (int i = 0; i < 8; ++i) Bn[(m0 + l + i) * 256 + ch] = tobf(v[i]);
            *(bf16x8*)(BT + ((size_t)chunk * 256 + ch) * 128 + l) = pack8(v);
        } else {
#pragma unroll
            for (int i = 0; i < 8; ++i) Cn[(m0 + l + i) * 256 + ch] = tobf(v[i]);
        }
    }
}
__device__ __forceinline__ void fb_item(int bh, const float* __restrict__ DTF, const float* __restrict__ fg_bias, float* __restrict__ FB, LAS3 unsigned char* lds) {
    const int tid = threadIdx.x, lane = tid & 63, wid = tid >> 6, b = bh >> 4, h = bh & 15;
    LAS3 float* s_tot = (LAS3 float*)lds + 1024;
    __syncthreads();
    const float fb = fg_bias[h];
    float v[16]; float run = 0.f;
#pragma unroll
    for (int i = 0; i < 16; ++i) { const float x = DTF[((size_t)b * 8192 + tid * 16 + i) * 32 + 16 + h] + fb; run += fminf(x, 0.f) - log1pf(expf(-fabsf(x))); v[i] = run; }
    float s = run;
#pragma unroll
    for (int o = 1; o < 64; o <<= 1) { const float t = __shfl_up(s, o); if (lane >= o) s += t; }
    if (lane == 63) s_tot[wid] = s;
    __syncthreads();
    float off = s - run;
    for (int w = 0; w < wid; ++w) off += s_tot[w];
#pragma unroll
    for (int i = 0; i < 16; i += 4) { f32x4 o4; o4[0] = -(off + v[i]) * LOG2E; o4[1] = -(off + v[i + 1]) * LOG2E; o4[2] = -(off + v[i + 2]) * LOG2E; o4[3] = -(off + v[i + 3]) * LOG2E;
        *(f32x4*)(FB + (size_t)bh * 8192 + tid * 16 + i) = o4; }
}
__device__ __forceinline__ void state_item(int item, const bf16_t* __restrict__ XDTT, const bf16_t* __restrict__ BT, const float* __restrict__ ACS, float* __restrict__ S) {
    const int tid = threadIdx.x, lane = tid & 63, wid = tid >> 6, r32 = lane & 31, hi = lane >> 5;
    const int chunk = item >> 1, g = item & 1, h = g * 8 + wid;
    const float* acs = ACS + ((size_t)chunk * 16 + h) * 128;
    const float aend = acs[127];
    f32x16 acc[2][4];
#pragma unroll
    for (int a = 0; a < 2; ++a)
#pragma unroll
        for (int b = 0; b < 4; ++b) acc[a][b] = f32x16{};
    const bf16_t* xa = XDTT + ((size_t)chunk * 1024 + h * 64 + r32) * 128 + 8 * hi;
    const bf16_t* bb = BT + ((size_t)chunk * 256 + g * 128 + r32) * 128 + 8 * hi;
    for (int ks = 0; ks < 8; ++ks) {
        const f32x4 a0 = *(const f32x4*)(acs + 16 * ks + 8 * hi), a1 = *(const f32x4*)(acs + 16 * ks + 8 * hi + 4);
        float wv[8];
#pragma unroll
        for (int i = 0; i < 4; ++i) { wv[i] = __expf(aend - a0[i]); wv[4 + i] = __expf(aend - a1[i]); }
        bf16x8 A[2], B[4];
#pragma unroll
        for (int pt = 0; pt < 2; ++pt) { const u32x4 xr = *(const u32x4*)(xa + (size_t)pt * 32 * 128 + 16 * ks); float m[8];
#pragma unroll
            for (int i = 0; i < 4; ++i) { m[2 * i] = lo(xr[i]) * wv[2 * i]; m[2 * i + 1] = hi16(xr[i]) * wv[2 * i + 1]; }
            A[pt] = pack8(m); }
#pragma unroll
        for (int nt = 0; nt < 4; ++nt) B[nt] = *(const bf16x8*)(bb + (size_t)nt * 32 * 128 + 16 * ks);
#pragma unroll
        for (int pt = 0; pt < 2; ++pt)
#pragma unroll
            for (int nt = 0; nt < 4; ++nt) acc[pt][nt] = __builtin_amdgcn_mfma_f32_32x32x16_bf16(A[pt], B[nt], acc[pt][nt], 0, 0, 0);
    }
    float* sp = S + ((size_t)chunk * 16 + h) * 8192 + r32;
#pragma unroll
    for (int pt = 0; pt < 2; ++pt)
#pragma unroll
        for (int nt = 0; nt < 4; ++nt)
#pragma unroll
            for (int r = 0; r < 16; ++r) sp[(32 * pt + crow(r, hi)) * 128 + 32 * nt] = acc[pt][nt][r];
}
__device__ __forceinline__ void scan_pair(int gt, float* __restrict__ S, const float* __restrict__ ACS) {
    const int b = gt >> 16, h = (gt >> 12) & 15, idx = (gt & 4095) * 2;
    f32x2 hs = {0.f, 0.f};
    for (int c0 = 0; c0 < 64; c0 += 8) {
        f32x2 sv[8]; float cd[8];
#pragma unroll
        for (int i = 0; i < 8; ++i) { const size_t ch = (size_t)(b * 64 + c0 + i) * 16 + h; sv[i] = *(const f32x2*)(S + ch * 8192 + idx); cd[i] = ACS[ch * 128 + 127]; }
#pragma unroll
        for (int i = 0; i < 8; ++i) { const size_t ch = (size_t)(b * 64 + c0 + i) * 16 + h; *(f32x2*)(S + ch * 8192 + idx) = hs; hs = hs * __expf(cd[i]) + sv[i]; }
    }
}
constexpr int CBP = 132;
constexpr int OUT_LDS_CB = 0, OUT_LDS_ACS = 128 * CBP * 4, OUT_LDS_DT = OUT_LDS_ACS + 4096, OUT_LDS_SSQ = OUT_LDS_DT + 4096, OUT_LDS_RSTD = OUT_LDS_SSQ + 4096, OUT_LDS_END = OUT_LDS_RSTD + 512;
__device__ __forceinline__ void out_item(int item, const bf16_t* __restrict__ XDTT, const bf16_t* __restrict__ Bn, const bf16_t* __restrict__ Cn, const float* __restrict__ ACS,
                                         const float* __restrict__ DT, const float* __restrict__ PREV, const bf16_t* ZS, bf16_t* YS, const float* __restrict__ d_skip,
                                         const float* __restrict__ gnorm, LAS3 unsigned char* lds) {
    const int tid = threadIdx.x, lane = tid & 63, wid = tid >> 6, r32 = lane & 31, hi = lane >> 5;
    const int chunk = item >> 1, g = item & 1, h = g * 8 + wid;
    const size_t m0 = (size_t)chunk * 128;
    LAS3 float* CB = (LAS3 float*)(lds + OUT_LDS_CB);
    LAS3 float* s_acs = (LAS3 float*)(lds + OUT_LDS_ACS) + wid * 128;
    LAS3 float* s_dt = (LAS3 float*)(lds + OUT_LDS_DT) + wid * 128;
    LAS3 float* s_ssq = (LAS3 float*)(lds + OUT_LDS_SSQ);
    LAS3 float* s_rstd = (LAS3 float*)(lds + OUT_LDS_RSTD);
    __syncthreads();
    { const float* ap = ACS + ((size_t)chunk * 16 + h) * 128; const float* dp = DT + ((size_t)chunk * 16 + h) * 128;
      s_acs[lane] = ap[lane]; s_acs[lane + 64] = ap[lane + 64]; s_dt[lane] = dp[lane]; s_dt[lane + 64] = dp[lane + 64]; }
#pragma unroll
    for (int bi = 0; bi < 2; ++bi) {
        const int blk = wid * 2 + bi, lb = blk >> 2, sb = blk & 3;
        if (sb <= lb) {
            f32x16 acc = f32x16{};
            const bf16_t* ca = Cn + (m0 + 32 * lb + r32) * 256 + g * 128 + 8 * hi; const bf16_t* ba = Bn + (m0 + 32 * sb + r32) * 256 + g * 128 + 8 * hi;
#pragma unroll
            for (int ks = 0; ks < 8; ++ks) acc = __builtin_amdgcn_mfma_f32_32x32x16_bf16(*(const bf16x8*)(ca + 16 * ks), *(const bf16x8*)(ba + 16 * ks), acc, 0, 0, 0);
#pragma unroll
            for (int r = 0; r < 16; ++r) CB[(32 * lb + crow(r, hi)) * CBP + 32 * sb + r32] = acc[r];
        }
    }
    __syncthreads();
    const bf16_t* xt = XDTT + ((size_t)chunk * 1024 + h * 64 + r32) * 128;
    const float* pv = PREV + ((size_t)chunk * 16 + h) * 8192 + r32 * 128 + 8 * hi;
    const float dsk = d_skip[h];
    const bf16_t* zp = ZS + m0 * 1024 + h * 64 + r32; bf16_t* yp = YS + m0 * 1024 + h * 64 + r32;
#pragma unroll 1
    for (int lb = 0; lb < 4; ++lb) {
        f32x16 yd[2], yo[2]; yd[0] = f32x16{}; yd[1] = f32x16{}; yo[0] = f32x16{}; yo[1] = f32x16{};
        const bf16_t* ca = Cn + (m0 + 32 * lb + r32) * 256 + g * 128 + 8 * hi;
#pragma unroll
        for (int ks = 0; ks < 8; ++ks) {
            const bf16x8 a = *(const bf16x8*)(ca + 16 * ks);
#pragma unroll
            for (int pt = 0; pt < 2; ++pt) { const f32x4 p0 = *(const f32x4*)(pv + pt * 4096 + 16 * ks), p1 = *(const f32x4*)(pv + pt * 4096 + 16 * ks + 4);
                float m[8] = {p0[0], p0[1], p0[2], p0[3], p1[0], p1[1], p1[2], p1[3]};
                yo[pt] = __builtin_amdgcn_mfma_f32_32x32x16_bf16(a, pack8(m), yo[pt], 0, 0, 0); }
            if (ks & 1) asm volatile("" ::: "memory");
        }
        const int lrow = 32 * lb + r32; const float al = s_acs[lrow];
#pragma unroll 1
        for (int sb = 0; sb <= lb; ++sb)
#pragma unroll
            for (int k2 = 0; k2 < 2; ++k2) {
                const int s0 = 32 * sb + 16 * k2 + 8 * hi;
                const f32x4 c0 = *(const LAS3 f32x4*)(CB + lrow * CBP + s0), c1 = *(const LAS3 f32x4*)(CB + lrow * CBP + s0 + 4);
                const f32x4 e0 = *(const LAS3 f32x4*)(s_acs + s0), e1 = *(const LAS3 f32x4*)(s_acs + s0 + 4);
                float m[8];
#pragma unroll
                for (int i = 0; i < 4; ++i) { m[i] = (s0 + i <= lrow) ? c0[i] * __expf(fminf(al - e0[i], 0.f)) : 0.f; m[4 + i] = (s0 + 4 + i <= lrow) ? c1[i] * __expf(fminf(al - e1[i], 0.f)) : 0.f; }
                const bf16x8 a = pack8(m);
#pragma unroll
                for (int pt = 0; pt < 2; ++pt) yd[pt] = __builtin_amdgcn_mfma_f32_32x32x16_bf16(a, *(const bf16x8*)(xt + pt * 4096 + s0), yd[pt], 0, 0, 0);
            }
        float ssq[16];
#pragma unroll
        for (int r = 0; r < 16; ++r) ssq[r] = 0.f;
#pragma unroll
        for (int g4 = 0; g4 < 4; ++g4) {
            const int lq = 32 * lb + 8 * g4 + 4 * hi;
            const f32x4 ea = *(const LAS3 f32x4*)(s_acs + lq), dq = *(const LAS3 f32x4*)(s_dt + lq);
#pragma unroll
            for (int pt = 0; pt < 2; ++pt) {
                const u32x2 xw = *(const u32x2*)(xt + pt * 4096 + lq);
                const float xv[4] = {lo(xw.x), hi16(xw.x), lo(xw.y), hi16(xw.y)};
                float yv[4];
#pragma unroll
                for (int jj = 0; jj < 4; ++jj) { const int r = 4 * g4 + jj;
                    float y = yd[pt][r] + __expf(ea[jj]) * yo[pt][r] + dsk * xv[jj] / dq[jj];
                    const float z = bf1(zp[(size_t)(lq + jj) * 1024 + 32 * pt]);
                    y *= z / (1.f + __expf(-z));
                    ssq[r] += y * y; yv[jj] = y; }
#pragma unroll
                for (int jj = 0; jj < 4; ++jj) yp[(size_t)(lq + jj) * 1024 + 32 * pt] = tobf(yv[jj]);
            }
            asm volatile("" ::: "memory");
        }
#pragma unroll
        for (int r = 0; r < 16; ++r) { float t = ssq[r]; t += __shfl_xor(t, 1); t += __shfl_xor(t, 2); t += __shfl_xor(t, 4); t += __shfl_xor(t, 8); t += __shfl_xor(t, 16); ssq[r] = t; }
        if (r32 == 0) {
#pragma unroll
            for (int r = 0; r < 16; ++r) s_ssq[wid * 128 + 32 * lb + crow(r, hi)] = ssq[r];
        }
    }
    __syncthreads();
    if (tid < 128) { float t = 0.f;
#pragma unroll
        for (int w = 0; w < 8; ++w) t += s_ssq[w * 128 + tid];
        s_rstd[tid] = rsqrtf(t * (1.f / 512.f) + 1e-6f); }
    __syncthreads();
    const float gn0 = gnorm[h * 64 + r32], gn1 = gnorm[h * 64 + 32 + r32];
#pragma unroll 1
    for (int lb = 0; lb < 4; ++lb)
#pragma unroll
        for (int g4 = 0; g4 < 4; ++g4) {
            const int lq = 32 * lb + 8 * g4 + 4 * hi;
            const f32x4 rs = *(const LAS3 f32x4*)(s_rstd + lq);
#pragma unroll
            for (int pt = 0; pt < 2; ++pt) { const float gn = pt ? gn1 : gn0;
#pragma unroll
                for (int jj = 0; jj < 4; ++jj) { bf16_t* q = yp + (size_t)(lq + jj) * 1024 + 32 * pt; *q = tobf(bf1(*q) * rs[jj] * gn); } }
        }
}
}
#include <hip/hip_cooperative_groups.h>
namespace cg = cooperative_groups;
#define LAS __attribute__((address_space(3)))
#define GAS __attribute__((address_space(1)))
typedef unsigned short bf16;
typedef unsigned v4u __attribute__((ext_vector_type(4)));
typedef float f32x4 __attribute__((ext_vector_type(4)));
constexpr int NWAVES = 8;
constexpr int M = 16384, DM = 1024, NINP = 6912, NINR = 6688, DIN = 2048, PLE = 256;
constexpr size_t MiB = 1u << 20;
constexpr size_t WS_WOUT = 1 * MiB, WS_WGATE = 5 * MiB, WS_WPROJ = 7 * MiB, WS_ZS = 8 * MiB, WS_ZA = 40 * MiB, WS_Q = 72 * MiB, WS_K = 104 * MiB, WS_V = 136 * MiB,
                 WS_XBC = 168 * MiB, WS_DTF = 216 * MiB, WS_S = 168 * MiB, WS_PB = 232 * MiB, WS_PP = WS_Q, WS_HN = WS_K, WS_END = 240 * MiB;
constexpr size_t OS_U = 0, OS_WIN = 32 * MiB;
constexpr size_t OS_XDTT = 0, OS_BN = 32 * MiB, OS_BT = 40 * MiB, OS_CN = 48 * MiB, OS_ACS = 56 * MiB, OS_DT = 57 * MiB, OS_FB = 58 * MiB;
constexpr int LDS_BYTES = 147456;
static_assert(attn_body::LDS_BYTES <= 131072 && ssd::OUT_LDS_END <= 131072, "LDS");

__device__ __forceinline__ unsigned f2bf(float f) { unsigned u = __builtin_bit_cast(unsigned, f); return (u + 0x7fffu + ((u >> 16) & 1u)) >> 16; }
__device__ __forceinline__ unsigned pk2(float lo, float hi) { return f2bf(lo) | (f2bf(hi) << 16); }
__device__ __forceinline__ float wave_sum(float v) {
#pragma unroll
    for (int o = 1; o < 64; o <<= 1) v += __shfl_xor(v, o);
    return v;
}
__device__ __forceinline__ int map_in_row(int n) { return n < 2560 ? n : (n < 2576 ? n + 4096 : (n < 6672 ? n - 16 : n)); }
template <bool MAP> __device__ __forceinline__ void p0_transpose_item(const float* W, int K, int N, bf16* WT, LAS float* scr, int item, int lane) {
    const int nblk = N / 32, kb = item / nblk, nb = item % nblk, k0 = 64 * kb, n0 = 32 * nb;
    { f32x4 v[8];
#pragma unroll
      for (int i = 0; i < 8; ++i) v[i] = *(const f32x4*)(W + (size_t)(k0 + 8 * i + (lane >> 3)) * N + n0 + 4 * (lane & 7));
#pragma unroll
      for (int i = 0; i < 8; ++i) { LAS float* d = scr + (8 * i + (lane >> 3)) * 33 + 4 * (lane & 7); d[0] = v[i].x; d[1] = v[i].y; d[2] = v[i].z; d[3] = v[i].w; } }
    asm volatile("s_waitcnt lgkmcnt(0)" ::: "memory");
    const int c = lane & 7;
#pragma unroll
    for (int j = 0; j < 4; ++j) { const int n = (lane >> 3) + 8 * j; const LAS float* s = scr + (8 * c) * 33 + n;
        v4u o; o.x = pk2(s[0 * 33], s[1 * 33]); o.y = pk2(s[2 * 33], s[3 * 33]); o.z = pk2(s[4 * 33], s[5 * 33]); o.w = pk2(s[6 * 33], s[7 * 33]);
        const int row = MAP ? map_in_row(n0 + n) : (n0 + n);
        *(v4u*)(WT + (size_t)row * K + k0 + 8 * c) = o; }
    asm volatile("s_waitcnt lgkmcnt(0)" ::: "memory");
}
__device__ __forceinline__ void rms_row_to_bf16(const float* xrow, const float* gain, bf16* orow, int lane) {
    const f32x4* xr = (const f32x4*)xrow + lane; const f32x4* gr = (const f32x4*)gain + lane;
    f32x4 v[4]; float s = 0.f;
#pragma unroll
    for (int j = 0; j < 4; ++j) { v[j] = xr[64 * j]; s += (v[j].x * v[j].x + v[j].y * v[j].y) + (v[j].z * v[j].z + v[j].w * v[j].w); }
    const float rstd = rsqrtf(wave_sum(s) * (1.f / 1024.f) + 1e-6f);
    unsigned long long* o8 = (unsigned long long*)orow + lane;
#pragma unroll
    for (int j = 0; j < 4; ++j) { const f32x4 gg = gr[64 * j];
        o8[64 * j] = (unsigned long long)pk2(v[j].x * rstd * gg.x, v[j].y * rstd * gg.y) | ((unsigned long long)pk2(v[j].z * rstd * gg.z, v[j].w * rstd * gg.w) << 32); }
}
template <int NR> __device__ __forceinline__ void rms_rows_to_bf16(const float* x, const float* gain, bf16* o, size_t m0, size_t rstride, int lane) {
    f32x4 v[NR][4]; float s[NR];
#pragma unroll
    for (int r = 0; r < NR; ++r) { const f32x4* xr = (const f32x4*)(x + (m0 + r * rstride) * 1024) + lane;
#pragma unroll
        for (int j = 0; j < 4; ++j) v[r][j] = xr[64 * j]; }
    const f32x4* gr = (const f32x4*)gain + lane; f32x4 gg[4];
#pragma unroll
    for (int j = 0; j < 4; ++j) gg[j] = gr[64 * j];
#pragma unroll
    for (int r = 0; r < NR; ++r) { float t = 0.f;
#pragma unroll
        for (int j = 0; j < 4; ++j) t += (v[r][j].x * v[r][j].x + v[r][j].y * v[r][j].y) + (v[r][j].z * v[r][j].z + v[r][j].w * v[r][j].w);
        s[r] = rsqrtf(wave_sum(t) * (1.f / 1024.f) + 1e-6f); }
#pragma unroll
    for (int r = 0; r < NR; ++r) { unsigned long long* o8 = (unsigned long long*)(o + (m0 + r * rstride) * 1024) + lane;
#pragma unroll
        for (int j = 0; j < 4; ++j) o8[64 * j] = (unsigned long long)pk2(v[r][j].x * s[r] * gg[j].x, v[r][j].y * s[r] * gg[j].y) | ((unsigned long long)pk2(v[r][j].z * s[r] * gg[j].z, v[r][j].w * s[r] * gg[j].w) << 32); }
}
template <int NR> __device__ __forceinline__ void rms_rows_inplace(float* x, const float* gain, size_t m0, size_t rstride, int lane) {
    f32x4 v[NR][4]; float s[NR];
#pragma unroll
    for (int r = 0; r < NR; ++r) { const f32x4* xr = (const f32x4*)(x + (m0 + r * rstride) * 1024) + lane;
#pragma unroll
        for (int j = 0; j < 4; ++j) v[r][j] = xr[64 * j]; }
    const f32x4* gr = (const f32x4*)gain + lane; f32x4 gg[4];
#pragma unroll
    for (int j = 0; j < 4; ++j) gg[j] = gr[64 * j];
#pragma unroll
    for (int r = 0; r < NR; ++r) { float t = 0.f;
#pragma unroll
        for (int j = 0; j < 4; ++j) t += (v[r][j].x * v[r][j].x + v[r][j].y * v[r][j].y) + (v[r][j].z * v[r][j].z + v[r][j].w * v[r][j].w);
        s[r] = rsqrtf(wave_sum(t) * (1.f / 1024.f) + 1e-6f); }
#pragma unroll
    for (int r = 0; r < NR; ++r) { f32x4* xr = (f32x4*)(x + (m0 + r * rstride) * 1024) + lane;
#pragma unroll
        for (int j = 0; j < 4; ++j) xr[64 * j] = v[r][j] * s[r] * gg[j]; }
}
__device__ __forceinline__ void rms_row_inplace(float* xrow, const float* gain, int lane) {
    f32x4* xr = (f32x4*)xrow + lane; const f32x4* gr = (const f32x4*)gain + lane;
    f32x4 v[4]; float s = 0.f;
#pragma unroll
    for (int j = 0; j < 4; ++j) { v[j] = xr[64 * j]; s += (v[j].x * v[j].x + v[j].y * v[j].y) + (v[j].z * v[j].z + v[j].w * v[j].w); }
    const float rstd = rsqrtf(wave_sum(s) * (1.f / 1024.f) + 1e-6f);
#pragma unroll
    for (int j = 0; j < 4; ++j) xr[64 * j] = v[j] * rstd * gr[64 * j];
}

#ifndef MK_SPLIT
#define MK_SPLIT 0
#endif
struct Args { const float* in[17]; float* out; unsigned char* ws; int ph_lo, ph_hi; };
__global__ void __launch_bounds__(NWAVES * 64, 2) mega_fwd(Args args) {
    extern __shared__ __attribute__((aligned(16))) unsigned char lds[];
    cg::grid_group grid = cg::this_grid();
    LAS unsigned char* L = (LAS unsigned char*)lds;
#define tid ((int)threadIdx.x)
#define lane ((int)(threadIdx.x & 63))
#define wave (__builtin_amdgcn_readfirstlane((int)(threadIdx.x >> 6)))
#define G ((int)gridDim.x)
#define bx ((int)blockIdx.x)
#define gw (bx * NWAVES + wave)
#define NGW (G * NWAVES)
    typedef const __attribute__((address_space(4))) Args* cargs_t;
#define ARGP(A) cargs_t A = (cargs_t)__builtin_amdgcn_kernarg_segment_ptr(); asm volatile("" : "+s"(A)); unsigned char* ws = A->ws; unsigned char* os = (unsigned char*)A->out; (void)ws; (void)os
#define Wout_t ((bf16*)(ws + WS_WOUT))
#define Wgate_t ((bf16*)(ws + WS_WGATE))
#define Wproj_t ((bf16*)(ws + WS_WPROJ))
#define ZS ((bf16*)(ws + WS_ZS))
#define ZA ((bf16*)(ws + WS_ZA))
#define Qb ((bf16*)(ws + WS_Q))
#define Kb ((bf16*)(ws + WS_K))
#define Vb ((bf16*)(ws + WS_V))
#define XBC ((bf16*)(ws + WS_XBC))
#define DTF ((float*)(ws + WS_DTF))
#define Sst ((float*)(ws + WS_S))
#define PB ((bf16*)(ws + WS_PB))
#define PP ((bf16*)(ws + WS_PP))
#define HN ((bf16*)(ws + WS_HN))
#define U ((bf16*)(os + OS_U))
#define Win_t ((bf16*)(os + OS_WIN))
#define XDTT ((bf16*)(os + OS_XDTT))
#define Bn ((bf16*)(os + OS_BN))
#define BT ((bf16*)(os + OS_BT))
#define Cn ((bf16*)(os + OS_CN))
#define ACS ((float*)(os + OS_ACS))
#define DTb ((float*)(os + OS_DT))
#define FB ((float*)(os + OS_FB))
    int lo, hi; { ARGP(A0); lo = A0->ph_lo; hi = A0->ph_hi; }
#ifdef DBG_ONLY
#define IN(k) ((k) == DBG_ONLY)
#else
#define IN(k) (lo <= (k) && (k) < hi)
#endif
#ifndef PROBE_MASK
#define PROBE_MASK 0
#endif
#if PROBE_MASK
    unsigned long long pr_prev = __builtin_amdgcn_s_memrealtime(), pr_acc = 0ull;
#define SEAM(k) do { if (IN(k) && IN((k) + 1)) grid.sync(); { const unsigned long long t_ = __builtin_amdgcn_s_memrealtime(); if ((PROBE_MASK >> (k)) & 1) pr_acc += t_ - pr_prev; pr_prev = t_; } } while (0)
#else
#define SEAM(k) do { if (IN(k) && IN((k) + 1)) grid.sync(); } while (0)
#endif

    if (IN(0)) { ARGP(A);
        LAS float* scr = (LAS float*)(L + wave * 16384);
        constexpr int I_IN = 16 * 209, I_OUT = 32 * 32, I_GATE = 16 * 32, I_PROJ = 4 * 32, NITEMS = I_IN + I_OUT + I_GATE + I_PROJ;
        for (int it = gw; it < NITEMS; it += NGW) {
            int r = it;
            if (r < I_IN) { p0_transpose_item<true>(A->in[3], 1024, NINR, Win_t, scr, r, lane); continue; } r -= I_IN;
            if (r < I_OUT) { p0_transpose_item<false>(A->in[12], 2048, 1024, Wout_t, scr, r, lane); continue; } r -= I_OUT;
            if (r < I_GATE) { p0_transpose_item<false>(A->in[14], 1024, 1024, Wgate_t, scr, r, lane); continue; } r -= I_GATE;
            p0_transpose_item<false>(A->in[15], 256, 1024, Wproj_t, scr, r, lane);
        }
        { v4u* z = (v4u*)(Win_t + (size_t)NINR * 1024); const int nz = (NINP - NINR) * 1024 * 2 / 16;
          for (int i = bx * 512 + tid; i < nz; i += G * 512) z[i] = (v4u){0u, 0u, 0u, 0u}; }
        for (int m = gw; m + 3 * NGW < M; m += 4 * NGW) rms_rows_to_bf16<4>(A->in[0], A->in[2], U, (size_t)m, (size_t)NGW, lane);
    }
    SEAM(0);
    if (IN(1)) { ARGP(A);
        pg8::Gemm g{U, Win_t, M, NINP, 1024, 1024, 1 << 30, 0}; pg8::StaticOrder S; S.init(M, NINP, G, bx);
        pg8::EpiIn E{ZS, XBC, ZA, Qb, Kb, Vb, DTF, attn_body::C2};
        pg8::gemm_phase<pg8::EpiIn, pg8::StaticOrder, true, true>(L, g, S, E);
    }
    SEAM(1);
    if (IN(2)) { ARGP(A);
        for (int it = bx; it < 800; it += G) {
            if (it < 768) ssd::pre_item(it, XBC, DTF, A->in[4], A->in[5], A->in[6], A->in[7], XDTT, Bn, BT, Cn, ACS, DTb, L);
            else ssd::fb_item(it - 768, DTF, A->in[10], FB, L);
        }
    }
    SEAM(2);
    if (IN(3)) { ARGP(A); for (int it = bx; it < 256; it += G) ssd::state_item(it, XDTT, BT, ACS, Sst); }
    SEAM(3);
    if (IN(4)) { ARGP(A);
        for (int gt = bx * 512 + tid; gt < 131072; gt += G * 512) ssd::scan_pair(gt, Sst, ACS);
        __syncthreads();
        const attn_body::AttnTensors AT{(const attn_body::bf16*)Qb, (const attn_body::bf16*)Kb, (const attn_body::bf16*)Vb, (attn_body::bf16*)ZA, FB, (const attn_body::bf16*)ZA, A->in[11]};
        const attn_body::StaticOrder S(G, bx);
        attn_body::attn_phase<attn_body::StaticOrder>((char*)lds, AT, S);
    }
    SEAM(4);
    if (IN(5)) { ARGP(A);
        for (int it = bx; it < 256; it += G) ssd::out_item(it, XDTT, Bn, Cn, ACS, DTb, Sst, ZS, ZS, A->in[8], A->in[9], L);
        { const f32x4* ps = (const f32x4*)A->in[1]; unsigned long long* pd = (unsigned long long*)PB; const int n4 = M * PLE / 4;
          for (int i = bx * 512 + tid; i < n4; i += G * 512) { const f32x4 v = ps[i]; pd[i] = (unsigned long long)pk2(v.x, v.y) | ((unsigned long long)pk2(v.z, v.w) << 32); } }
    }
    SEAM(5);
    if (IN(6)) { ARGP(A);
        { pg8::Gemm g{ZS, Wout_t, M, 1024, 2048, 1024, 16, (long)(WS_ZA - WS_ZS) - 2048}; pg8::StaticOrder S; S.init(M, 1024, G, bx);
          pg8::EpiRes E{A->in[0], ((float*)os), 1024};
          pg8::gemm_phase<pg8::EpiRes, pg8::StaticOrder, true, true>(L, g, S, E); }
        { pg8::Gemm g{PB, Wproj_t, M, 1024, 256, 256, 1 << 30, 0}; pg8::StaticOrder S; S.init(M, 1024, G, bx);
          pg8::EpiBf16<0> E{PP, 1024, nullptr, 0, 0, 1.f};
          pg8::gemm_phase<pg8::EpiBf16<0>, pg8::StaticOrder, true, true>(L, g, S, E); }
    }
    SEAM(6);
    if (IN(7)) { ARGP(A); for (int m = gw; m + 3 * NGW < M; m += 4 * NGW) rms_rows_to_bf16<4>(((float*)os), A->in[13], HN, (size_t)m, (size_t)NGW, lane); }
    SEAM(7);
    if (IN(8)) { ARGP(A);
        pg8::Gemm g{HN, Wgate_t, M, 1024, 1024, 1024, 1 << 30, 0}; pg8::StaticOrder S; S.init(M, 1024, G, bx);
        pg8::EpiGate E{((float*)os), PP, 1024};
        pg8::gemm_phase<pg8::EpiGate, pg8::StaticOrder, true, true>(L, g, S, E);
    }
    SEAM(8);
    if (IN(9)) { ARGP(A); for (int m = gw; m + 3 * NGW < M; m += 4 * NGW) rms_rows_inplace<4>(((float*)os), A->in[16], (size_t)m, (size_t)NGW, lane); }
#if PROBE_MASK
    { __syncthreads(); const unsigned long long t_ = __builtin_amdgcn_s_memrealtime(); if ((PROBE_MASK >> 9) & 1) pr_acc += t_ - pr_prev;
      if (bx == 0) { while (__builtin_amdgcn_s_memrealtime() - t_ < pr_acc) __builtin_amdgcn_s_sleep(8); } }
#endif
#undef IN
#undef SEAM
#undef tid
#undef lane
#undef wave
#undef G
#undef bx
#undef gw
#undef NGW
}

extern "C" void kernel_launch(void* const* d_in, const int* in_sizes, int n_in, void* d_out, int out_size, void* d_ws, size_t ws_size, hipStream_t stream) {
    static int grid = 0;
    if (grid == 0) {
        if (n_in != 17 || out_size != M * DM || ws_size < WS_END) { fprintf(stderr, "kernel_launch: unexpected shapes (n_in %d out %d ws %zu)\n", n_in, out_size, ws_size); grid = -1; return; }
        int dev = 0, cus = 0, per_cu = 0;
        hipGetDevice(&dev); hipDeviceGetAttribute(&cus, hipDeviceAttributeMultiprocessorCount, dev);
        if (hipFuncSetAttribute((const void*)mega_fwd, hipFuncAttributeMaxDynamicSharedMemorySize, LDS_BYTES) != hipSuccess) { fprintf(stderr, "kernel_launch: hipFuncSetAttribute failed\n"); grid = -1; return; }
        hipOccupancyMaxActiveBlocksPerMultiprocessor(&per_cu, (const void*)mega_fwd, NWAVES * 64, LDS_BYTES);
        (void)hipGetLastError();
        grid = 256;
        if (cus * per_cu < grid) { fprintf(stderr, "kernel_launch: device cannot hold 256 co-resident workgroups (cus %d per_cu %d)\n", cus, per_cu); grid = -1; return; }
    }
    if (grid < 0) return;
    Args a{};
    for (int i = 0; i < 17; ++i) a.in[i] = (const float*)d_in[i];
    a.out = (float*)d_out; a.ws = (unsigned char*)d_ws;
#if MK_SPLIT
    for (int ph = 0; ph < 10; ++ph) { a.ph_lo = ph; a.ph_hi = ph + 1; void* kargs[] = {&a};
        hipLaunchCooperativeKernel((const void*)mega_fwd, dim3(grid), dim3(NWAVES * 64), kargs, LDS_BYTES, stream); }
#else
    a.ph_lo = 0; a.ph_hi = 10; void* kargs[] = {&a};
    hipError_t e = hipLaunchCooperativeKernel((const void*)mega_fwd, dim3(grid), dim3(NWAVES * 64), kargs, LDS_BYTES, stream);
    if (e != hipSuccess) fprintf(stderr, "cooperative launch failed: %s\n", hipGetErrorString(e));
#endif
}
```

```cpp
#include <hip/hip_runtime.h>
#include <cstdio>
#include <cstdint>
namespace pg8 {
#define PG8_LAS __attribute__((address_space(3)))
typedef unsigned short bf16_t;
typedef short bf16x8 __attribute__((ext_vector_type(8)));
typedef float f32x4 __attribute__((ext_vector_type(4)));
typedef unsigned u32x4 __attribute__((ext_vector_type(4)));
constexpr int BM = 256, BK = 64, HALF = 128, HTB = HALF * BK * 2  , STAGE_BYTES = 8 * HTB, NXCD = 8, WGM = 8;

__host__ __device__ __forceinline__ int lds_byte(int r, int c) { const int st = (r >> 4) * 2 + (c >> 5), rr = r & 15, cc = c & 31, ob = rr * 64 + cc * 2; return st * 1024 + (ob ^ (((ob >> 9) & 1) << 5)); }
__host__ __device__ __forceinline__ void stage_rc(int b, int& R, int& C) { const int st = b / 1024, sb = b % 1024, swz = sb ^ (((sb >> 9) & 1) << 5); R = (st >> 1) * 16 + swz / 64; C = (st & 1) * 32 + (swz % 64) / 2; }
__host__ __device__ __forceinline__ int perm32(int rho) { const int n = rho >> 4, i = rho & 15; return 8 * (i >> 2) + 4 * n + (i & 3); }

struct Unit { int pm, pn; };
struct Gemm { const bf16_t* A; const bf16_t* Bt; int M, N, K; int lda; int ksplit; long asadj; };

struct StaticOrder {
    int nM, nN, nwg, G, c;
    __host__ __device__ void init(int M, int N, int G_, int c_) { nM = M / BM; nN = N / BM; nwg = nM * nN; G = G_; c = c_; }
    __host__ __device__ bool next(int i, Unit& u) const {
        const long L = (long)i * G + c; if (L >= nwg) return false;
        int wgid = (int)L; { const int q = nwg / NXCD, r = nwg % NXCD, xcd = wgid % NXCD, off = wgid / NXCD; wgid = (xcd < r ? xcd * (q + 1) : r * (q + 1) + (xcd - r) * q) + off; }
        const int nig = WGM * nN, gid = wgid / nig, fm = gid * WGM, gsz = (nM - fm) < WGM ? (nM - fm) : WGM;
        u.pm = fm + ((wgid % nig) % gsz); u.pn = (wgid % nig) / gsz; return true;
    }
    __device__ __forceinline__ void a_ready(const Unit&) const {}
    __device__ __forceinline__ void done(const Unit&) const {}
};

__device__ __forceinline__ unsigned cvt_pk_bf16(float lo, float hi) { unsigned r; asm volatile("v_cvt_pk_bf16_f32 %0, %1, %2" : "=v"(r) : "v"(lo), "v"(hi)); return r; }
typedef float f32x2 __attribute__((ext_vector_type(2)));
__device__ __forceinline__ f32x2 gelu_pk(f32x2 v) {
    const f32x2 av = __builtin_elementwise_abs(v), d = av * 0.2316418882f + 1.0f;
    f32x2 t; t.x = __builtin_amdgcn_rcpf(d.x); t.y = __builtin_amdgcn_rcpf(d.y);
    f32x2 q = t * 0.5307027145f + (-0.7265760135f); q = q * t + 0.7107068705f; q = q * t + (-0.142248368f); q = q * t + 0.127414796f; q = q * t;
    const f32x2 s = (v * v) * (-0.72134752044f);
    f32x2 e; e.x = __builtin_amdgcn_exp2f(s.x); e.y = __builtin_amdgcn_exp2f(s.y);
    const f32x2 m = v * (q * e), r = v - m;
    f32x2 o; o.x = v.x < 0.f ? m.x : r.x; o.y = v.y < 0.f ? m.y : r.y; return o;
}

template <int ACT  > struct EpiBf16 {
    static constexpr bool PERM = true, AFTER_DRAIN = false; static_assert(ACT == 0 || ACT == 1, "EpiBf16: ACT is 0 (none) or 1 (gelu_pk)");
    bf16_t* O; int ldc; const float* bias; int split_cols; size_t split_stride; float scale0;
    __device__ __forceinline__ void operator()(const f32x4 (&acc)[2][2][4][2], const Unit& u, int wr, int wc, int fr, int fq) const {
        const int row0 = u.pm * BM + wr * 64 + fr; int colt = u.pn * BM; bf16_t* base = O;
        float sc = 1.f; if (split_cols) { const int t = colt / split_cols; base += (size_t)t * split_stride; colt -= t * split_cols; if (t == 0) sc = scale0; }
        const int col0 = colt + wc * 32 + 8 * fq, bcol0 = u.pn * BM + wc * 32 + 8 * fq;
        f32x4 bv[2][2];
#pragma unroll
        for (int bj = 0; bj < 2; ++bj)
#pragma unroll
            for (int n = 0; n < 2; ++n) bv[bj][n] = bias ? *(const f32x4*)(bias + bcol0 + bj * HALF + 4 * n) : (f32x4){0.f, 0.f, 0.f, 0.f};
#pragma unroll
        for (int ai = 0; ai < 2; ++ai)
#pragma unroll
            for (int m = 0; m < 4; ++m) { bf16_t* rowp = base + (size_t)(row0 + ai * HALF + m * 16) * ldc + col0;
#pragma unroll
                for (int bj = 0; bj < 2; ++bj) { f32x4 v0 = acc[ai][bj][m][0] + bv[bj][0], v1 = acc[ai][bj][m][1] + bv[bj][1];
                    if (ACT == 1) { f32x2 a = gelu_pk((f32x2){v0[0], v0[1]}), b = gelu_pk((f32x2){v0[2], v0[3]}), c = gelu_pk((f32x2){v1[0], v1[1]}), d = gelu_pk((f32x2){v1[2], v1[3]});
                        v0 = (f32x4){a.x, a.y, b.x, b.y}; v1 = (f32x4){c.x, c.y, d.x, d.y}; }
                    v0 = v0 * sc; v1 = v1 * sc; u32x4 w; w.x = cvt_pk_bf16(v0[0], v0[1]); w.y = cvt_pk_bf16(v0[2], v0[3]); w.z = cvt_pk_bf16(v1[0], v1[1]); w.w = cvt_pk_bf16(v1[2], v1[3]);
                    *(u32x4*)(rowp + bj * HALF) = w; } }
    }
};

struct PanelStats {
    unsigned* xbuf;
    unsigned* cnt;
    unsigned* tmo;
    int ntn; float eps;
    unsigned code;
    __device__ __forceinline__ bool run(const f32x4 (&v)[2][2][4][2], const Unit& u, int wr, int wc, int fr, int fq, PG8_LAS unsigned char* lds, int wid, int lane) const {
        typedef float f32x2v __attribute__((ext_vector_type(2)));
        PG8_LAS f32x2v* P = (PG8_LAS f32x2v*)lds;
        PG8_LAS f32x2v* S = (PG8_LAS f32x2v*)(lds + 8192);
        PG8_LAS unsigned* flag = (PG8_LAS unsigned*)(lds + 8192 + 2048);
#pragma unroll
        for (int ai = 0; ai < 2; ++ai)
#pragma unroll
            for (int m = 0; m < 4; ++m) {
                float s = 0.f;
#pragma unroll
                for (int bj = 0; bj < 2; ++bj)
#pragma unroll
                    for (int n = 0; n < 2; ++n) { const f32x4 x = v[ai][bj][m][n]; s += (x[0] + x[1]) + (x[2] + x[3]); }
                s += __shfl_xor(s, 16); s += __shfl_xor(s, 32);
                const float mw = s * (1.0f / 64.0f); float q = 0.f;
#pragma unroll
                for (int bj = 0; bj < 2; ++bj)
#pragma unroll
                    for (int n = 0; n < 2; ++n) { const f32x4 d = v[ai][bj][m][n] - mw; q += (d[0] * d[0] + d[1] * d[1]) + (d[2] * d[2] + d[3] * d[3]); }
                q += __shfl_xor(q, 16); q += __shfl_xor(q, 32);
                if (fq == 0) P[(ai * HALF + wr * 64 + m * 16 + fr) * 4 + wc] = (f32x2v){mw, q};
            }
        asm volatile("s_waitcnt lgkmcnt(0)" ::: "memory"); __builtin_amdgcn_s_barrier(); asm volatile("" ::: "memory");
#if defined(BROKEN_EXCHANGE_NO_WAIT)
#warning BROKEN CONTROL BUILD: the row-statistics exchange does not wait; results are wrong by design
        if (blockIdx.x >= 64) { const long long t0_ = clock64(); while (clock64() - t0_ < 60000) __builtin_amdgcn_s_sleep(8); }
#endif
        const int row = wid * 32 + (lane & 31);
        if (lane < 32) {
            const f32x2v a = P[row * 4 + 0], b = P[row * 4 + 1], c = P[row * 4 + 2], d = P[row * 4 + 3];
            const float mt = (a.x + b.x + c.x + d.x) * 0.25f;
            const float da = a.x - mt, db = b.x - mt, dc = c.x - mt, dd = d.x - mt;
            const float m2 = (a.y + b.y) + (c.y + d.y) + 64.0f * ((da * da + db * db) + (dc * dc + dd * dd));
            unsigned long long* slot = (unsigned long long*)xbuf + ((size_t)(u.pm * BM + row) * 4 + u.pn);
            __hip_atomic_store(slot, ((unsigned long long)__float_as_uint(m2) << 32) | __float_as_uint(mt), __ATOMIC_RELAXED, __HIP_MEMORY_SCOPE_AGENT);
        }
        asm volatile("s_waitcnt vmcnt(0)" ::: "memory");
        if (lane == 0) __hip_atomic_fetch_add(cnt + 64 * u.pm, 1u, __ATOMIC_RELAXED, __HIP_MEMORY_SCOPE_AGENT);
        if (wid == 0) {
            bool dead = false; const unsigned long long t0 = __builtin_amdgcn_s_memrealtime(); const unsigned want = 8u * (unsigned)ntn;
            for (;;) {
#if defined(BROKEN_EXCHANGE_NO_WAIT)
                break;
#endif
                if ((unsigned)__builtin_amdgcn_readfirstlane(__hip_atomic_load(cnt + 64 * u.pm, __ATOMIC_RELAXED, __HIP_MEMORY_SCOPE_AGENT)) >= want) break;
                if (__builtin_amdgcn_s_memrealtime() - t0 > 2000000ull) {
                    if (lane == 0) { unsigned expect = 0u; __hip_atomic_compare_exchange_strong(tmo + 1, &expect, code | (unsigned)(u.pm & 0xff), __ATOMIC_RELAXED, __ATOMIC_RELAXED, __HIP_MEMORY_SCOPE_AGENT);
                                     __hip_atomic_store(tmo, 1u, __ATOMIC_RELAXED, __HIP_MEMORY_SCOPE_AGENT); }
                    dead = true; break; }
                __builtin_amdgcn_s_sleep(2);
            }
            __builtin_amdgcn_fence(__ATOMIC_ACQUIRE, "agent");
            if (lane == 0) flag[0] = dead ? 1u : 0u;
        }
        asm volatile("s_waitcnt vmcnt(0) lgkmcnt(0)" ::: "memory"); __builtin_amdgcn_s_barrier(); asm volatile("" ::: "memory");
        const bool bad = flag[0] != 0u;
        if (lane < 32) {
            const unsigned long long* slot = (const unsigned long long*)xbuf + (size_t)(u.pm * BM + row) * 4; float mt[4], m2[4]; float ms = 0.f;
#pragma unroll
            for (int t = 0; t < 4; ++t) { if (t < ntn) { const unsigned long long w = __hip_atomic_load(slot + t, __ATOMIC_RELAXED, __HIP_MEMORY_SCOPE_AGENT); mt[t] = __uint_as_float((unsigned)w); m2[t] = __uint_as_float((unsigned)(w >> 32)); } else { mt[t] = 0.f; m2[t] = 0.f; } ms += mt[t]; }
            const float mean = ms / (float)ntn; float q = 0.f;
#pragma unroll
            for (int t = 0; t < 4; ++t) if (t < ntn) { const float dm = mt[t] - mean; q += m2[t] + 256.0f * dm * dm; }
            S[row] = (f32x2v){mean, 1.0f / sqrtf(q / (256.0f * (float)ntn) + eps)};
        }
        asm volatile("s_waitcnt lgkmcnt(0)" ::: "memory"); __builtin_amdgcn_s_barrier(); asm volatile("" ::: "memory");
        return bad;
    }
};
struct EpiLnRes {
    static constexpr bool PERM = false, AFTER_DRAIN = true;
    const float* base; float* out; int ldc; const float* bias; PanelStats st; unsigned poison;
    __device__ __forceinline__ void fused(f32x4 (&acc)[2][2][4][2], const Unit& u, int wr, int wc, int fr, int fq, PG8_LAS unsigned char* lds, int wid, int lane) const {
        typedef float f32x2v __attribute__((ext_vector_type(2)));
        const PG8_LAS f32x2v* S = (const PG8_LAS f32x2v*)(lds + 8192);
        const int col0 = u.pn * BM + wc * 32 + 4 * fq;
#pragma unroll
        for (int bj = 0; bj < 2; ++bj)
#pragma unroll
            for (int n = 0; n < 2; ++n) { const f32x4 bv = bias ? *(const f32x4*)(bias + col0 + bj * HALF + n * 16) : (f32x4){0.f, 0.f, 0.f, 0.f};
#pragma unroll
                for (int ai = 0; ai < 2; ++ai)
#pragma unroll
                    for (int m = 0; m < 4; ++m) acc[ai][bj][m][n] += bv; }
        f32x4 pre[4][2][2];
#pragma unroll
        for (int m = 0; m < 4; ++m) { const size_t off = (size_t)(u.pm * BM + wr * 64 + m * 16 + fr) * ldc + col0;
#pragma unroll
            for (int bj = 0; bj < 2; ++bj)
#pragma unroll
                for (int n = 0; n < 2; ++n) pre[m][bj][n] = *(const f32x4*)(base + off + bj * HALF + n * 16); }
        const bool bad = st.run(acc, u, wr, wc, fr, fq, lds, wid, lane) || poison != 0u;
        const float qnan = __builtin_nanf("");
#pragma unroll
        for (int ai = 0; ai < 2; ++ai)
#pragma unroll
            for (int m = 0; m < 4; ++m) { const int r = ai * HALF + wr * 64 + m * 16 + fr; const f32x2v sr = S[r]; const size_t off = (size_t)(u.pm * BM + r) * ldc + col0;
#pragma unroll
                for (int bj = 0; bj < 2; ++bj)
#pragma unroll
                    for (int n = 0; n < 2; ++n) { const f32x4 bs = ai == 0 ? pre[m][bj][n] : *(const f32x4*)(base + off + bj * HALF + n * 16); f32x4 o = bs + (acc[ai][bj][m][n] - sr.x) * sr.y;
                        if (bad) o = (f32x4){qnan, qnan, qnan, qnan}; *(f32x4*)(out + off + bj * HALF + n * 16) = o; }
                if (m & 1) asm volatile("" ::: "memory"); }
    }
};
struct EpiLnResLn {
    static constexpr bool PERM = false, AFTER_DRAIN = true;
    const float* base; float* out; bf16_t* xn; int ldc; const float* bias; PanelStats st1, st2; unsigned poison;
    __device__ __forceinline__ void fused(f32x4 (&acc)[2][2][4][2], const Unit& u, int wr, int wc, int fr, int fq, PG8_LAS unsigned char* lds, int wid, int lane) const {
        typedef float f32x2v __attribute__((ext_vector_type(2))); typedef unsigned u32x2v __attribute__((ext_vector_type(2)));
        const PG8_LAS f32x2v* S = (const PG8_LAS f32x2v*)(lds + 8192);
        const int col0 = u.pn * BM + wc * 32 + 4 * fq;
#pragma unroll
        for (int bj = 0; bj < 2; ++bj)
#pragma unroll
            for (int n = 0; n < 2; ++n) { const f32x4 bv = bias ? *(const f32x4*)(bias + col0 + bj * HALF + n * 16) : (f32x4){0.f, 0.f, 0.f, 0.f};
#pragma unroll
                for (int ai = 0; ai < 2; ++ai)
#pragma unroll
                    for (int m = 0; m < 4; ++m) acc[ai][bj][m][n] += bv; }
        bool bad = st1.run(acc, u, wr, wc, fr, fq, lds, wid, lane) || poison != 0u;
        const float qnan = __builtin_nanf("");
#pragma unroll
        for (int ai = 0; ai < 2; ++ai)
#pragma unroll
            for (int m = 0; m < 4; ++m) { const int r = ai * HALF + wr * 64 + m * 16 + fr; const f32x2v sr = S[r]; const size_t off = (size_t)(u.pm * BM + r) * ldc + col0;
#pragma unroll
                for (int bj = 0; bj < 2; ++bj)
#pragma unroll
                    for (int n = 0; n < 2; ++n) { const f32x4 bs = *(const f32x4*)(base + off + bj * HALF + n * 16); acc[ai][bj][m][n] = bs + (acc[ai][bj][m][n] - sr.x) * sr.y; }
                asm volatile("" : "+v"(acc[ai][0][m][0]), "+v"(acc[ai][0][m][1]), "+v"(acc[ai][1][m][0]), "+v"(acc[ai][1][m][1]));
                if (m & 1) asm volatile("" ::: "memory"); }
        const bool bad1 = bad;
        bad = st2.run(acc, u, wr, wc, fr, fq, lds, wid, lane) || bad;
#pragma unroll
        for (int ai = 0; ai < 2; ++ai)
#pragma unroll
            for (int m = 0; m < 4; ++m) { const int r = ai * HALF + wr * 64 + m * 16 + fr; const f32x2v sr = S[r]; const size_t off = (size_t)(u.pm * BM + r) * ldc + col0;
#pragma unroll
                for (int bj = 0; bj < 2; ++bj)
#pragma unroll
                    for (int n = 0; n < 2; ++n) { const f32x4 x1 = acc[ai][bj][m][n]; *(f32x4*)(out + off + bj * HALF + n * 16) = bad1 ? (f32x4){qnan, qnan, qnan, qnan} : x1;
                        const f32x4 o = (x1 - sr.x) * sr.y; u32x2v w; w.x = cvt_pk_bf16(o[0], o[1]); w.y = cvt_pk_bf16(o[2], o[3]);
                        if (bad) { w.x = 0x7fc07fc0u; w.y = 0x7fc07fc0u; } *(u32x2v*)(xn + off + bj * HALF + n * 16) = w; }
                asm volatile("" ::: "memory"); }
    }
};

template <class Epi, class Sched, bool ALIGN_EPI = false, bool SP2 = false>
__device__ __forceinline__ void gemm_phase(PG8_LAS unsigned char* lds, const Gemm g, const Sched& S, const Epi& E, const int tidx) {
    static_assert(SP2, "only the SP2 loop carries the lda / split-A changes");
    const int tid = tidx, wid = __builtin_amdgcn_readfirstlane(tid >> 6), lane = tid & 63, wr = wid >> 2, wc = wid & 3, fr = lane & 15, fq = lane >> 4;
    const int K = g.K, nt = K / BK;
    unsigned voffA[2], voffB[2];
#pragma unroll
    for (int i = 0; i < 2; ++i) { int R, C; stage_rc(tid * 16 + i * 8192, R, C); const int Rb = Epi::PERM ? ((R & ~31) + perm32(R & 31)) : R;
        voffA[i] = (unsigned)(R * g.lda + C) * 2u; voffB[i] = (unsigned)(Rb * K + C) * 2u; }
    const size_t kstep = (size_t)(BK * 2);
    const size_t hstep = (size_t)HALF * K * 2, hstepA = (size_t)HALF * g.lda * 2;
    const size_t tstep = 2 * hstep, tstepA = 2 * hstepA; const int ksplit = g.ksplit; const long asadj = g.asadj;
    const unsigned ldsw = (unsigned)wid * 1024u;
    const int aoff = lds_byte(wr * 64 + fr, fq * 8), boff = lds_byte(wc * 32 + fr, fq * 8);
#define PG8_SA(b, h) (((b) * 2 + (h)) * HTB)
#define PG8_SB(b, h) ((4 + (b) * 2 + (h)) * HTB)
#define PG8_STAGE(bufoff, gbase, voff) do { _Pragma("unroll") for (int _i = 0; _i < 2; ++_i) \
        __builtin_amdgcn_global_load_lds((const unsigned*)((const char*)(gbase) + (voff)[_i]), (PG8_LAS unsigned*)(lds + (bufoff) + ldsw + _i * 8192), 16, 0, 0); } while (0)
#define PG8_LDA(dst, b, h) do { _Pragma("unroll") for (int m = 0; m < 4; ++m) _Pragma("unroll") for (int k = 0; k < 2; ++k) dst[m][k] = *(const PG8_LAS bf16x8*)(lds + PG8_SA(b, h) + aoff + m * 2048 + k * 1024); } while (0)
#define PG8_LDB(dst, b, h) do { _Pragma("unroll") for (int n = 0; n < 2; ++n) _Pragma("unroll") for (int k = 0; k < 2; ++k) dst[n][k] = *(const PG8_LAS bf16x8*)(lds + PG8_SB(b, h) + boff + n * 2048 + k * 1024); } while (0)
#define PG8_MMA(ai, bj, At, Bt) do { __builtin_amdgcn_s_setprio(1); _Pragma("unroll") for (int m = 0; m < 4; ++m) _Pragma("unroll") for (int n = 0; n < 2; ++n) _Pragma("unroll") for (int k = 0; k < 2; ++k) \
        acc[ai][bj][m][n] = __builtin_amdgcn_mfma_f32_16x16x32_bf16(Bt[n][k], At[m][k], acc[ai][bj][m][n], 0, 0, 0); __builtin_amdgcn_s_setprio(0); } while (0)
#define PG8_WAIT_V(n) asm volatile("s_waitcnt vmcnt(" #n ")" ::: "memory")
#define PG8_WAIT_L(n) asm volatile("s_waitcnt lgkmcnt(" #n ")" ::: "memory")
#define PG8_BAR __builtin_amdgcn_s_barrier()
#define PG8_SCHED __builtin_amdgcn_sched_barrier(0)
    Unit cur, nxt; int ui = 0;
    if (!S.next(0, cur)) return;
    f32x4 acc[2][2][4][2];
#pragma unroll
    for (int a = 0; a < 2; ++a)
#pragma unroll
        for (int b = 0; b < 2; ++b)
#pragma unroll
            for (int m = 0; m < 4; ++m)
#pragma unroll
                for (int n = 0; n < 2; ++n) acc[a][b][m][n] = (f32x4){0.f, 0.f, 0.f, 0.f};
    bf16x8 At[4][2], B0[2][2], B1[2][2];
    const char* cA = (const char*)g.A + (size_t)cur.pm * tstepA; const char* cB = (const char*)g.Bt + (size_t)cur.pn * tstep;
    S.a_ready(cur);
    if constexpr (SP2) {
        PG8_STAGE(PG8_SB(0, 0), cB, voffB); PG8_STAGE(PG8_SB(0, 1), cB + hstep, voffB); PG8_STAGE(PG8_SA(0, 0), cA, voffA); PG8_STAGE(PG8_SA(0, 1), cA + hstepA, voffA);
        if (wr == 1) PG8_BAR;
        PG8_WAIT_V(2); PG8_BAR;
        PG8_STAGE(PG8_SB(1, 0), cB + kstep, voffB); PG8_STAGE(PG8_SA(1, 0), cA + kstep, voffA); PG8_STAGE(PG8_SB(1, 1), cB + hstep + kstep, voffB);
        PG8_WAIT_V(6); PG8_BAR;
    } else {
        PG8_STAGE(PG8_SB(0, 0), cB, voffB); PG8_STAGE(PG8_SA(0, 0), cA, voffA); PG8_STAGE(PG8_SB(0, 1), cB + hstep, voffB); PG8_STAGE(PG8_SA(0, 1), cA + hstep, voffA);
        if (wr == 1) PG8_BAR;
        PG8_WAIT_V(4); PG8_BAR;
        PG8_STAGE(PG8_SB(1, 0), cB + kstep, voffB); PG8_STAGE(PG8_SA(1, 0), cA + kstep, voffA); PG8_STAGE(PG8_SB(1, 1), cB + hstep + kstep, voffB);
        PG8_WAIT_V(6); PG8_BAR;
    }
    for (;;) {
        const bool has_next = S.next(ui + 1, nxt);
        const char* nA = has_next ? (const char*)g.A + (size_t)nxt.pm * tstepA : cA; const char* nB = has_next ? (const char*)g.Bt + (size_t)nxt.pn * tstep : cB;
        for (int t = 0; t < nt; t += 2) {
            const bool last = (t == nt - 2);
            const char* a1 = cA + (size_t)(t + 1) * kstep + ((t + 1) >= ksplit ? asadj : 0);
            const char* a2 = last ? nA : cA + (size_t)(t + 2) * kstep + ((t + 2) >= ksplit ? asadj : 0); const char* b2 = last ? nB : cB + (size_t)(t + 2) * kstep;
            const char* a3 = a2 + kstep; const char* b3 = b2 + kstep;
            if (last && has_next) S.a_ready(nxt);
            if constexpr (SP2) {
            PG8_LDB(B0, 0, 0); PG8_LDB(B1, 0, 1); PG8_SCHED; PG8_LDA(At, 0, 0); PG8_STAGE(PG8_SA(1, 1), a1 + hstepA, voffA);
            PG8_WAIT_V(8); PG8_WAIT_L(0); PG8_BAR; PG8_MMA(0, 0, At, B0); PG8_MMA(0, 1, At, B1); PG8_BAR; PG8_SCHED;
            PG8_LDA(At, 0, 1); PG8_STAGE(PG8_SB(0, 0), b2, voffB); PG8_STAGE(PG8_SB(0, 1), b2 + hstep, voffB); PG8_STAGE(PG8_SA(0, 0), a2, voffA);
            PG8_WAIT_V(8); PG8_WAIT_L(0); PG8_BAR; PG8_MMA(1, 0, At, B0); PG8_MMA(1, 1, At, B1); PG8_BAR; PG8_SCHED;
            PG8_LDB(B0, 1, 0); PG8_LDB(B1, 1, 1); PG8_SCHED; PG8_LDA(At, 1, 0); PG8_STAGE(PG8_SA(0, 1), a2 + hstepA, voffA);
            PG8_WAIT_V(8); PG8_WAIT_L(0); PG8_BAR; PG8_MMA(0, 0, At, B0); PG8_MMA(0, 1, At, B1); PG8_BAR; PG8_SCHED;
            PG8_LDA(At, 1, 1); PG8_STAGE(PG8_SB(1, 0), b3, voffB); PG8_STAGE(PG8_SB(1, 1), b3 + hstep, voffB); PG8_STAGE(PG8_SA(1, 0), a3, voffA);
            PG8_WAIT_V(8); PG8_WAIT_L(0); PG8_BAR; PG8_MMA(1, 0, At, B0); PG8_MMA(1, 1, At, B1); PG8_BAR; PG8_SCHED;
            } else {
            PG8_LDB(B0, 0, 0); PG8_SCHED; PG8_LDA(At, 0, 0); PG8_STAGE(PG8_SA(1, 1), a1 + hstep, voffA);
            PG8_WAIT_L(8); PG8_BAR; PG8_WAIT_L(0); PG8_MMA(0, 0, At, B0); PG8_BAR; PG8_SCHED;
            PG8_LDB(B1, 0, 1); PG8_STAGE(PG8_SB(0, 0), b2, voffB);
            PG8_BAR; PG8_WAIT_L(0); PG8_MMA(0, 1, At, B1); PG8_BAR;
            PG8_LDA(At, 0, 1); PG8_STAGE(PG8_SA(0, 0), a2, voffA);
            PG8_BAR; PG8_WAIT_L(0); PG8_MMA(1, 0, At, B0); PG8_BAR; PG8_SCHED;
            PG8_STAGE(PG8_SB(0, 1), b2 + hstep, voffB);
            PG8_WAIT_V(6); PG8_BAR; PG8_MMA(1, 1, At, B1); PG8_BAR;
            PG8_LDB(B0, 1, 0); PG8_SCHED; PG8_LDA(At, 1, 0); PG8_STAGE(PG8_SA(0, 1), a2 + hstep, voffA);
            PG8_WAIT_L(8); PG8_BAR; PG8_WAIT_L(0); PG8_MMA(0, 0, At, B0); PG8_BAR; PG8_SCHED;
            PG8_LDB(B1, 1, 1); PG8_STAGE(PG8_SB(1, 0), b3, voffB);
            PG8_BAR; PG8_WAIT_L(0); PG8_MMA(0, 1, At, B1); PG8_BAR;
            PG8_LDA(At, 1, 1); PG8_STAGE(PG8_SA(1, 0), a3, voffA);
            PG8_BAR; PG8_WAIT_L(0); PG8_MMA(1, 0, At, B0); PG8_BAR; PG8_SCHED;
            PG8_STAGE(PG8_SB(1, 1), b3 + hstep, voffB);
            PG8_WAIT_V(6); PG8_BAR; PG8_MMA(1, 1, At, B1); PG8_BAR;
            }
        }
        if constexpr (ALIGN_EPI) { if (wr == 0) PG8_BAR; }
        if constexpr (!Epi::AFTER_DRAIN) { E(acc, cur, wr, wc, fr, fq); S.done(cur); }
        if (!has_next) break;
#pragma unroll
        for (int a = 0; a < 2; ++a)
#pragma unroll
            for (int b = 0; b < 2; ++b)
#pragma unroll
                for (int m = 0; m < 4; ++m)
#pragma unroll
                    for (int n = 0; n < 2; ++n) acc[a][b][m][n] = (f32x4){0.f, 0.f, 0.f, 0.f};
        cur = nxt; cA = nA; cB = nB; ++ui;
        if constexpr (ALIGN_EPI) { if (wr == 1) PG8_BAR; }
    }
    PG8_WAIT_V(0);
    if constexpr (!ALIGN_EPI) { if (wr == 0) PG8_BAR; }
    PG8_BAR;
    if constexpr (Epi::AFTER_DRAIN) { E.fused(acc, cur, wr, wc, fr, fq, lds, wid, lane); S.done(cur); }
#undef PG8_SA
#undef PG8_SB
#undef PG8_STAGE
#undef PG8_LDA
#undef PG8_LDB
#undef PG8_MMA
#undef PG8_WAIT_V
#undef PG8_WAIT_L
#undef PG8_BAR
#undef PG8_SCHED
}
}

#ifndef PG8_SP2
#define PG8_SP2 true
#endif
#ifndef PG8_ALIGN
#define PG8_ALIGN true
#endif
#include <hip/hip_bf16.h>
#include <cmath>
namespace attn_body {
using bf16=__hip_bfloat16;
using bf16x8=__attribute__((ext_vector_type(8)))short;
using s16x4=__attribute__((ext_vector_type(4)))short;
using f32x16=__attribute__((ext_vector_type(16)))float;
using u32x4=__attribute__((ext_vector_type(4)))unsigned;
constexpr int BATCH=2,NHEAD=16,SEQ=8192,D=64,DM=NHEAD*D;
constexpr int NW=8,QBLK=32,QB=QBLK*NW,KVBLK=64,NQB=SEQ/QB;
constexpr int ATTN_PITCH=DM, ATTN_UNIT_ROWS=QB;
__device__ __forceinline__ int crow(int r,int hi){return (r&3)+8*(r>>2)+4*hi;}
#define SBAR() __builtin_amdgcn_sched_barrier(0)
__device__ __forceinline__ void cmask(f32x16&p0,f32x16&p1,int jb,int qrel,int hi){
  const float NEG=-INFINITY; int kb=64*jb+4*hi;
  #pragma unroll
  for(int r=0;r<16;++r){int kv=kb+(r&3)+8*(r>>2); if(kv>qrel)p0[r]=NEG; if(kv+32>qrel)p1[r]=NEG;}
}

constexpr int NSLOT=3, SLOTB=8192;
constexpr int LDS_K=0, LDS_V=NSLOT*SLOTB, LDS_WS=2*NSLOT*SLOTB, LDS_OST=LDS_WS+NW*64*4, LDS_BIAS=LDS_OST+NW*4096, LDS_BYTES=LDS_BIAS+SEQ*4;
constexpr float C2=0.125f*1.4426950408889634f;
__device__ __forceinline__ void glds16(const void*sbase,unsigned voff,unsigned lds_dst){unsigned keep;
  asm volatile("s_mov_b32 %0, m0\n\ts_mov_b32 m0, %2\n\ts_nop 0\n\tglobal_load_lds_dwordx4 %1, %3\n\ts_mov_b32 m0, %0":"=&s"(keep):"v"(voff),"s"(lds_dst),"s"(sbase):"memory");}
__device__ __forceinline__ float max3f(float a,float b,float c){float r;asm("v_max3_f32 %0, %1, %2, %3":"=v"(r):"v"(a),"v"(b),"v"(c));return r;}
__device__ __forceinline__ float max2f(float a,float b){float r;asm("v_max_f32_e32 %0, %1, %2":"=v"(r):"v"(a),"v"(b));return r;}
__device__ __forceinline__ float fadd_s(float a,float b){float r;asm("v_add_f32_e32 %0, %1, %2":"=v"(r):"v"(a),"v"(b));return r;}
__device__ __forceinline__ float fsub_s(float a,float b){float r;asm("v_sub_f32_e32 %0, %1, %2":"=v"(r):"v"(a),"v"(b));return r;}
typedef float f32x2_t __attribute__((ext_vector_type(2))); typedef __bf16 bf16x2_t __attribute__((ext_vector_type(2)));
__device__ __forceinline__ unsigned cvtpk_s(float lo,float hi){f32x2_t v={lo,hi};bf16x2_t b=__builtin_convertvector(v,bf16x2_t);return __builtin_bit_cast(unsigned,b);}
#define WAIT_BAR(N) asm volatile("s_waitcnt vmcnt(" #N ") lgkmcnt(0)\n\ts_barrier":::"memory")

__device__ __forceinline__ void qkt(f32x16&p0,f32x16&p1,const char*Kslot,const bf16x8*qr,int r32,int hi){
  const char*kb=Kslot+hi*1024+r32*16;
  #pragma unroll
  for(int d0=0;d0<4;++d0){
    const bf16x8 b0=*reinterpret_cast<const bf16x8*>(kb+d0*2048);
    const bf16x8 b1=*reinterpret_cast<const bf16x8*>(kb+d0*2048+512);
    {p0=__builtin_amdgcn_mfma_f32_32x32x16_bf16(b0,qr[d0],p0,0,0,0);p1=__builtin_amdgcn_mfma_f32_32x32x16_bf16(b1,qr[d0],p1,0,0,0);}}
}
typedef __attribute__((address_space(3))) const char* lds_cptr;
typedef short v4i16_t __attribute__((ext_vector_type(4)));
__device__ __forceinline__ void kload8(bf16x8*kf,lds_cptr kp){
  kf[0]=*(const __attribute__((address_space(3))) bf16x8*)(kp);      kf[1]=*(const __attribute__((address_space(3))) bf16x8*)(kp+512);
  kf[2]=*(const __attribute__((address_space(3))) bf16x8*)(kp+2048); kf[3]=*(const __attribute__((address_space(3))) bf16x8*)(kp+2560);
  kf[4]=*(const __attribute__((address_space(3))) bf16x8*)(kp+4096); kf[5]=*(const __attribute__((address_space(3))) bf16x8*)(kp+4608);
  kf[6]=*(const __attribute__((address_space(3))) bf16x8*)(kp+6144); kf[7]=*(const __attribute__((address_space(3))) bf16x8*)(kp+6656);
}
__device__ __forceinline__ void kload2(bf16x8*kf,lds_cptr kp,int j){ kf[2*j]=*(const __attribute__((address_space(3))) bf16x8*)(kp+j*2048); kf[2*j+1]=*(const __attribute__((address_space(3))) bf16x8*)(kp+j*2048+512); }
__device__ __forceinline__ s16x4 vtr(lds_cptr p){ return __builtin_bit_cast(s16x4,__builtin_amdgcn_ds_read_tr16_b64_v4i16((__attribute__((address_space(3))) v4i16_t*)p)); }
__device__ __forceinline__ float rowmax(const f32x16&p0,const f32x16&p1){
  float a=max3f(p0[0],p0[1],p1[0]),b=max3f(p0[2],p0[3],p1[1]);a=max3f(a,p1[2],p1[3]);
  #pragma unroll
  for(int r=4;r<16;r+=4){a=max3f(a,p0[r],p0[r+1]);b=max3f(b,p0[r+2],p0[r+3]);a=max3f(a,p1[r],p1[r+1]);b=max3f(b,p1[r+2],p1[r+3]);}
  const float m=max2f(a,b);
  auto rr=__builtin_amdgcn_permlane32_swap(__float_as_uint(m),__float_as_uint(m),false,false);
  return max2f(__uint_as_float(rr[0]),__uint_as_float(rr[1]));
}
__device__ __forceinline__ void pv(f32x16*o,int vb,bf16x8 pa0,bf16x8 pa1,bf16x8 pa2,bf16x8 pa3){
  #pragma unroll
  for(int d0=0;d0<2;++d0){s16x4 lo[4],hi[4];
    #pragma unroll
    for(int ks=0;ks<4;++ks){
      asm volatile("ds_read_b64_tr_b16 %0,%1 offset:%c2":"=&v"(lo[ks]):"v"(vb),"i"(d0*4096+ks*1024):"memory");
      asm volatile("ds_read_b64_tr_b16 %0,%1 offset:%c2":"=&v"(hi[ks]):"v"(vb),"i"(d0*4096+ks*1024+512):"memory");}
    asm volatile("s_waitcnt lgkmcnt(0)":::"memory");SBAR();
    #define PK(k) (bf16x8){lo[k][0],lo[k][1],lo[k][2],lo[k][3],hi[k][0],hi[k][1],hi[k][2],hi[k][3]}
    o[d0]=__builtin_amdgcn_mfma_f32_32x32x16_bf16(pa0,PK(0),o[d0],0,0,0);
    o[d0]=__builtin_amdgcn_mfma_f32_32x32x16_bf16(pa1,PK(1),o[d0],0,0,0);
    o[d0]=__builtin_amdgcn_mfma_f32_32x32x16_bf16(pa2,PK(2),o[d0],0,0,0);
    o[d0]=__builtin_amdgcn_mfma_f32_32x32x16_bf16(pa3,PK(3),o[d0],0,0,0);
    #undef PK
  }
}

#ifndef ATTN_STORE16
#define ATTN_STORE16(p,v) (*(u32x4*)(p)=(v))
#endif
typedef float f32x4v __attribute__((ext_vector_type(4)));
template<int THRL> __device__ __forceinline__ void attn_unit(int b,int h,int qb,const bf16*Q,const bf16*__restrict__ K,const bf16*__restrict__ V,bf16*O,const float*FB,const bf16*Z,const float*GN,char*shm,const int tidx){
  const int tid=tidx,lane=tid&63,r32=lane&31,hi=lane>>5; const int wid=__builtin_amdgcn_readfirstlane(tid>>6);
  const long rowbase=(long)b*SEQ; const int q0=qb*QB;
  const bf16*Qw=Q+(rowbase+q0+wid*QBLK)*DM+h*D;
  const bf16*Kh=K+rowbase*DM+h*D,*Vh=V+rowbase*DM+h*D;
  const unsigned lds0=(unsigned)(uintptr_t)shm;
  float*wsf=(float*)(shm+LDS_WS)+wid*64;
  const unsigned ksrc=(unsigned)((lane*DM+wid*8)*2);
  const unsigned vsrc=(unsigned)(((16*(wid&3)+(lane>>2))*DM+(wid>>2)*32+(lane&3)*8)*2);
  const unsigned kdst=lds0+LDS_K+wid*1024, vdst=lds0+LDS_V+wid*1024;
  #define DMA_K(t,slot) glds16((const char*)Kh+(long)(NT-1-(t))*(KVBLK*DM*2),ksrc,(unsigned)__builtin_amdgcn_readfirstlane(kdst+(slot)))
  #define DMA_V(t,slot) glds16((const char*)Vh+(long)(NT-1-(t))*(KVBLK*DM*2),vsrc,(unsigned)__builtin_amdgcn_readfirstlane(vdst+(slot)))
  #define vb0 ((int)(lds0+LDS_V)+((lane>>4)&1)*32+(lane&3)*8+(4*hi+((lane&15)>>2))*64)
  const char*Kbase=shm+LDS_K; bf16x8 kf[8];
  const lds_cptr shm3=(lds_cptr)shm; const lds_cptr kp0=shm3+LDS_K+hi*1024+r32*16; const lds_cptr vp0=shm3+LDS_V+((lane>>4)&1)*32+(lane&3)*8+(4*hi+((lane&15)>>2))*64;
  const int NT=(q0+QB)/KVBLK;
  { const float*fbh=FB+((long)b*NHEAD+h)*SEQ; __attribute__((address_space(3))) float*bl=(__attribute__((address_space(3))) float*)((__attribute__((address_space(3))) char*)shm+LDS_BIAS);
    for(int i=tid*4;i<NT*KVBLK;i+=NW*64*4) *(__attribute__((address_space(3))) f32x4v*)(bl+i)=*(const f32x4v*)(fbh+i); }
  #define biasL ((const __attribute__((address_space(3))) float*)(shm3+LDS_BIAS)+4*(lane>>5))
  DMA_K(0,0);DMA_V(0,0);DMA_K(1,SLOTB);
  bf16x8 qr[4];
  #pragma unroll
  for(int d0=0;d0<4;++d0)qr[d0]=*reinterpret_cast<const bf16x8*>(&Qw[(long)r32*DM+d0*16+hi*8]);
  float mhat=0.f,l_reg=0.f;f32x16 o[2];o[0]=f32x16{};o[1]=f32x16{};
  #define qrel (wid*QBLK+r32)
  #define CMASK(P0,P1,t) do{int jb_=3-(t); if(jb_>=0)cmask(P0,P1,jb_,qrel,hi);}while(0)
  bool resc=false;
  #define START(P0,P1) do{ const float rm=rowmax(P0,P1); resc=false; \
    { const float dl=(rm>-1e30f)?rm:0.f; mhat=fadd_s(mhat,dl); \
      _Pragma("unroll") for(int r=0;r<16;++r){P0[r]=fsub_s(P0[r],dl);P1[r]=fsub_s(P1[r],dl);} \
 } \
    _Pragma("unroll") for(int r=0;r<16;++r)P0[r]=__builtin_amdgcn_exp2f(P0[r]); }while(0)
  #define RESC() do{ if(resc){ asm volatile("s_waitcnt lgkmcnt(0)":::"memory"); \
      _Pragma("unroll") for(int d_=0;d_<2;++d_) _Pragma("unroll") for(int r=0;r<16;++r)o[d_][r]*=wsf[crow(r,hi)]; } }while(0)
  #define BIASINIT(C0,C1,t) do{ const __attribute__((address_space(3))) float*bp_=biasL+64*(NT-1-(t)); \
    _Pragma("unroll") for(int g_=0;g_<4;++g_){ const f32x4v u0_=*(const __attribute__((address_space(3))) f32x4v*)(bp_+8*g_); const f32x4v u1_=*(const __attribute__((address_space(3))) f32x4v*)(bp_+32+8*g_); \
      _Pragma("unroll") for(int j_=0;j_<4;++j_){ C0[4*g_+j_]=u0_[j_]-mhat; C1[4*g_+j_]=u1_[j_]-mhat; } } }while(0)
  f32x16 pA0,pA1,pB0,pB1;
  int sl_prev=0,sl_cur=0,sl_next=SLOTB;
  #define ROT() do{sl_prev=sl_cur;sl_cur=sl_next;sl_next=(sl_next==(NSLOT-1)*SLOTB)?0:sl_next+SLOTB;}while(0)
  DMA_K(2,2*SLOTB);
  WAIT_BAR(3);
  mhat=(biasL-4*hi)[q0+qrel]; BIASINIT(pA0,pA1,0); qkt(pA0,pA1,Kbase,qr,r32,hi);asm volatile("s_nop 15\n\ts_nop 7":"+v"(pA0),"+v"(pA1));CMASK(pA0,pA1,0);
  START(pA0,pA1);
  _Pragma("unroll") for(int r=0;r<16;++r)pA1[r]=__builtin_amdgcn_exp2f(pA1[r]);
  WAIT_BAR(0);
  DMA_K(3,0);DMA_V(1,SLOTB);
  ROT();
  kload8(kf,kp0+sl_cur);
  WAIT_BAR(2);
  s16x4 vlo[8],vhi[8]; u32x4 pw0,pw1,pw2,pw3;
  #define PKW(P,B) cvtpk_s(P[B],P[B+1])
  #define PAF(k) __builtin_bit_cast(bf16x8,pw##k)
  #define VFR(i) (bf16x8){vlo[i][0],vlo[i][1],vlo[i][2],vlo[i][3],vhi[i][0],vhi[i][1],vhi[i][2],vhi[i][3]}
  #define PIN(x) asm volatile("":"+v"(x))
  #define MX3(a,b,c) __builtin_fmaxf(__builtin_fmaxf((a),(b)),(c))
  #define GAPA(MF,A0,A1,A2,A3,W0,W1,PW) do{ MF; sacc+=A0; sacc+=A1; sacc+=A2; sacc+=A3; PIN(sacc); W0; W1; PIN(PW); SBAR(); }while(0)
  #define EX(v) __builtin_amdgcn_exp2f(v)
  #define GAPB(MF,X,B) do{ MF; X[B]=EX(X[B]); X[B+1]=EX(X[B+1]); X[B+2]=EX(X[B+2]); X[B+3]=EX(X[B+3]); PIN(X); SBAR(); }while(0)
  #define VRD(i) do{ vlo[i]=vtr(vp_+(((i)>>2)*4096+((i)&3)*1024)); vhi[i]=vtr(vp_+(((i)>>2)*4096+((i)&3)*1024+512)); }while(0)
  #define KRD(G,j) do{ if(G){ kload2(kf,kp0+sl_next,j); SBAR(); } }while(0)
  #define STEP(C0,C1,P0,P1,t,GK,GV,GL) do{ SBAR(); BIASINIT(C0,C1,t); SBAR(); \
    const lds_cptr vp_=vp0+sl_prev; \
    VRD(0); SBAR(); float sacc=(P0[0]+P0[1]); \
    GAPA(C0=__builtin_amdgcn_mfma_f32_32x32x16_bf16(kf[0],qr[0],C0,0,0,0), P0[2],P0[3],P0[4],P0[5],     pw0[0]=PKW(P0,0), pw0[1]=PKW(P0,2), pw0); \
    VRD(4); SBAR(); GAPA(C1=__builtin_amdgcn_mfma_f32_32x32x16_bf16(kf[1],qr[0],C1,0,0,0), P0[6],P0[7],P0[8],P0[9],     pw0[2]=PKW(P0,4), pw0[3]=PKW(P0,6), pw0); \
    VRD(1); SBAR(); GAPA(C0=__builtin_amdgcn_mfma_f32_32x32x16_bf16(kf[2],qr[1],C0,0,0,0),   P0[10],P0[11],P0[12],P0[13], pw1[0]=PKW(P0,8), pw1[1]=PKW(P0,10), pw1); \
    VRD(5); SBAR(); GAPA(C1=__builtin_amdgcn_mfma_f32_32x32x16_bf16(kf[3],qr[1],C1,0,0,0),   P0[14],P0[15],P1[0],P1[1],   pw1[2]=PKW(P0,12),pw1[3]=PKW(P0,14), pw1); \
    VRD(2); SBAR(); GAPA(C0=__builtin_amdgcn_mfma_f32_32x32x16_bf16(kf[4],qr[2],C0,0,0,0),   P1[2],P1[3],P1[4],P1[5],     pw2[0]=PKW(P1,0), pw2[1]=PKW(P1,2), pw2); \
    VRD(6); SBAR(); GAPA(C1=__builtin_amdgcn_mfma_f32_32x32x16_bf16(kf[5],qr[2],C1,0,0,0),   P1[6],P1[7],P1[8],P1[9],     pw2[2]=PKW(P1,4), pw2[3]=PKW(P1,6), pw2); \
    VRD(3); SBAR(); GAPA(C0=__builtin_amdgcn_mfma_f32_32x32x16_bf16(kf[6],qr[3],C0,0,0,0),   P1[10],P1[11],P1[12],P1[13], pw3[0]=PKW(P1,8), pw3[1]=PKW(P1,10), pw3); \
    VRD(7); SBAR(); GAPA(C1=__builtin_amdgcn_mfma_f32_32x32x16_bf16(kf[7],qr[3],C1,0,0,0),   P1[14],P1[15],0.f,0.f,       pw3[2]=PKW(P1,12),pw3[3]=PKW(P1,14), pw3); \
    l_reg+=sacc; \
    if(GK){DMA_K((t)+3,sl_cur);} if(GV){DMA_V((t)+1,sl_next);} \
    CMASK(C0,C1,t); \
    { float a=MX3(C0[0],C0[1],C1[0]),b=MX3(C0[2],C0[3],C1[1]); a=MX3(a,C1[2],C1[3]); \
      _Pragma("unroll") for(int r=4;r<16;r+=4){a=MX3(a,C0[r],C0[r+1]);b=MX3(b,C0[r+2],C0[r+3]);a=MX3(a,C1[r],C1[r+1]);b=MX3(b,C1[r+2],C1[r+3]);} \
      float rm=__builtin_fmaxf(a,b); { auto rr=__builtin_amdgcn_permlane32_swap(__float_as_uint(rm),__float_as_uint(rm),false,false); rm=__builtin_fmaxf(__uint_as_float(rr[0]),__uint_as_float(rr[1])); } \
      resc=false; \
      if(__builtin_expect(__any(rm>(float)THRL),0)){ const float dl=__builtin_fmaxf(rm,0.f); mhat+=dl; \
        _Pragma("unroll") for(int r=0;r<16;++r){C0[r]-=dl;C1[r]-=dl;} \
        const float f=__builtin_amdgcn_exp2f(-dl); l_reg*=f; if(hi==0)wsf[r32]=f; resc=true; } } \
    SBAR(); \
    GAPB(o[0]=__builtin_amdgcn_mfma_f32_32x32x16_bf16(PAF(0),VFR(0),o[0],0,0,0), C0,0); \
    GAPB(o[1]=__builtin_amdgcn_mfma_f32_32x32x16_bf16(PAF(0),VFR(4),o[1],0,0,0), C0,4); \
    KRD(GL,0); GAPB(o[0]=__builtin_amdgcn_mfma_f32_32x32x16_bf16(PAF(1),VFR(1),o[0],0,0,0), C0,8); \
    KRD(GL,1); GAPB(o[1]=__builtin_amdgcn_mfma_f32_32x32x16_bf16(PAF(1),VFR(5),o[1],0,0,0), C0,12); \
    KRD(GL,2); GAPB(o[0]=__builtin_amdgcn_mfma_f32_32x32x16_bf16(PAF(2),VFR(2),o[0],0,0,0), C1,0); \
    KRD(GL,3); GAPB(o[1]=__builtin_amdgcn_mfma_f32_32x32x16_bf16(PAF(2),VFR(6),o[1],0,0,0), C1,4); \
    GAPB(o[0]=__builtin_amdgcn_mfma_f32_32x32x16_bf16(PAF(3),VFR(3),o[0],0,0,0), C1,8); \
    GAPB(o[1]=__builtin_amdgcn_mfma_f32_32x32x16_bf16(PAF(3),VFR(7),o[1],0,0,0), C1,12); \
    }while(0)
  int t=1;
  #define ENDW(tt) do{ if((tt)+3<NT){WAIT_BAR(2);} else if((tt)+2<NT){WAIT_BAR(1);} else {WAIT_BAR(0);} }while(0)
  for(;t+1<NT&&t<4;t+=2){
    STEP(pB0,pB1,pA0,pA1,t,(t+3<NT),(t+1<NT),(t+1<NT));       ENDW(t);   RESC(); ROT();
    STEP(pA0,pA1,pB0,pB1,t+1,(t+4<NT),(t+2<NT),(t+2<NT));     ENDW(t+1); RESC(); ROT();
  }
  #undef CMASK
  #define CMASK(P0,P1,t) do{}while(0)
  for(;t+5<NT;t+=2){
    STEP(pB0,pB1,pA0,pA1,t,true,true,true);     WAIT_BAR(2); RESC(); ROT();
    STEP(pA0,pA1,pB0,pB1,t+1,true,true,true);   WAIT_BAR(2); RESC(); ROT();
  }
  #undef CMASK
  #define CMASK(P0,P1,t) do{int jb_=3-(t); if(jb_>=0)cmask(P0,P1,jb_,qrel,hi);}while(0)
  for(;t+1<NT;t+=2){
    STEP(pB0,pB1,pA0,pA1,t,(t+3<NT),(t+1<NT),(t+1<NT));       ENDW(t);   RESC(); ROT();
    STEP(pA0,pA1,pB0,pB1,t+1,(t+4<NT),(t+2<NT),(t+2<NT));     ENDW(t+1); RESC(); ROT();
  }
  STEP(pB0,pB1,pA0,pA1,NT-1,false,false,false); RESC();
  { float sacc=pB0[0]+pB0[1]; _Pragma("unroll") for(int r=2;r<16;++r)sacc+=pB0[r]; _Pragma("unroll") for(int r=0;r<16;++r)sacc+=pB1[r]; l_reg+=sacc;
    pw0=(u32x4){PKW(pB0,0),PKW(pB0,2),PKW(pB0,4),PKW(pB0,6)};pw1=(u32x4){PKW(pB0,8),PKW(pB0,10),PKW(pB0,12),PKW(pB0,14)};pw2=(u32x4){PKW(pB1,0),PKW(pB1,2),PKW(pB1,4),PKW(pB1,6)};pw3=(u32x4){PKW(pB1,8),PKW(pB1,10),PKW(pB1,12),PKW(pB1,14)};
    SBAR(); pv(o,vb0+sl_cur,PAF(0),PAF(1),PAF(2),PAF(3)); }
  #undef PKW
  #undef PAF
  #undef VFR
  #undef PIN
  #undef MX3
  #undef GAPA
  #undef GAPB
  #undef EX
  #undef VRD
  #undef KRD
  #undef STEP
  #undef ENDW
  {auto rr=__builtin_amdgcn_permlane32_swap(__float_as_uint(l_reg),__float_as_uint(l_reg),false,false);l_reg=__uint_as_float(rr[0])+__uint_as_float(rr[1]);}
  if(hi==0)wsf[32+r32]=l_reg;asm volatile("s_waitcnt lgkmcnt(0)":::"memory");
  float rli[16];
  #pragma unroll
  for(int r=0;r<16;++r)rli[r]=__builtin_amdgcn_rcpf(wsf[32+crow(r,hi)]);
  bf16*Ow=O+(rowbase+q0+wid*QBLK)*DM+h*D; const bf16*Zw=Z+(rowbase+q0+wid*QBLK)*DM+h*D;
  { bf16*stg=(bf16*)(shm+LDS_OST)+wid*2048;
    #pragma unroll
    for(int r=0;r<16;++r){const int orow=crow(r,hi);
      #pragma unroll
      for(int d0=0;d0<2;++d0)stg[orow*64+d0*32+r32]=__float2bfloat16(o[d0][r]*rli[r]);}
    asm volatile("s_waitcnt lgkmcnt(0)":::"memory");
    #pragma unroll
    for(int i=0;i<4;++i){const int row=i*8+(lane>>3),ch=lane&7; const u32x4 v=*(const u32x4*)(stg+row*64+ch*8); const u32x4 zz=*(const u32x4*)(Zw+(long)row*DM+ch*8);
      float a[8]; float ss=0.f;
      _Pragma("unroll") for(int j=0;j<4;++j){a[2*j]=__uint_as_float(v[j]<<16);a[2*j+1]=__uint_as_float(v[j]&0xffff0000u);ss+=a[2*j]*a[2*j]+a[2*j+1]*a[2*j+1];}
      ss+=__shfl_xor(ss,1);ss+=__shfl_xor(ss,2);ss+=__shfl_xor(ss,4);
      const float rs=rsqrtf(ss*(1.f/64.f)+1e-6f); u32x4 w;
      _Pragma("unroll") for(int j=0;j<4;++j){const float z0=__uint_as_float(zz[j]<<16),z1=__uint_as_float(zz[j]&0xffff0000u);
        const float y0=a[2*j]*rs*GN[ch*8+2*j]*(z0/(1.f+__expf(-z0))), y1=a[2*j+1]*rs*GN[ch*8+2*j+1]*(z1/(1.f+__expf(-z1))); w[j]=cvtpk_s(y0,y1);}
      ATTN_STORE16(Ow+(long)row*DM+ch*8,w);} }
  asm volatile("s_waitcnt lgkmcnt(0)\n\ts_barrier":::"memory");
  #undef BIASINIT
  #undef biasL
  #undef qrel
  #undef vb0
  #undef DMA_K
  #undef DMA_V
  #undef CMASK
  #undef START
  #undef RESC
  #undef ROT
}
constexpr int ATTN_LDS_BYTES=LDS_BYTES;
struct AttnTensors { const bf16* Q; const bf16* K; const bf16* V; bf16* O; const float* FB; const bf16* Z; const float* GN; };
struct AttnUnit { int bh; int qb; };
struct StaticOrder {
  int vcu;
  __device__ __forceinline__ explicit StaticOrder(int grid,int block):vcu((block%8)*(grid/8)+block/8){}
  __device__ __forceinline__ bool next(int i,AttnUnit&u)const{ if(i>=4)return false; const int s=vcu&7; u.bh=vcu>>3; u.qb=(i==0)?s:(i==1)?15-s:(i==2)?16+s:31-s; return true; }
  __device__ __forceinline__ void a_ready(const AttnUnit&)const{}
  __device__ __forceinline__ void done(const AttnUnit&)const{}
};
template<class Sched,int THRL=8> __device__ __forceinline__ void attn_phase(char*lds,const AttnTensors&T,const Sched&S,const int tidx){
  AttnUnit u;
  for(int i=0;S.next(i,u);++i){ S.a_ready(u); attn_unit<THRL>(u.bh/NHEAD,u.bh%NHEAD,u.qb,T.Q,T.K,T.V,T.O,T.FB,T.Z,T.GN,lds,tidx); S.done(u); }
}
#undef SBAR
#undef WAIT_BAR
}
namespace pg8 {
typedef unsigned u32x2 __attribute__((ext_vector_type(2)));
__device__ __forceinline__ float bf_lo(unsigned w) { return __uint_as_float(w << 16); }
__device__ __forceinline__ float bf_hi(unsigned w) { return __uint_as_float(w & 0xffff0000u); }
struct EpiIn {
    static constexpr bool PERM = true, AFTER_DRAIN = false;
    bf16_t *ZS, *XBC, *ZA, *Q, *K, *V; float* DTF; float qscale;
    __device__ __forceinline__ void operator()(const f32x4 (&acc)[2][2][4][2], const Unit& u, int wr, int wc, int fr, int fq) const {
        const int pn = u.pn; const int row0 = u.pm * BM + wr * 64 + fr;
        if (pn == 26) {
            if (wc == 0) {
#pragma unroll
                for (int ai = 0; ai < 2; ++ai)
#pragma unroll
                    for (int m = 0; m < 4; ++m) { float* rowp = DTF + (size_t)(row0 + ai * HALF + m * 16) * 32 + 8 * fq;
                        *(f32x4*)(rowp) = acc[ai][0][m][0]; *(f32x4*)(rowp + 4) = acc[ai][0][m][1]; }
            }
            return;
        }
        bf16_t* base; int ldc, colt; float sc = 1.f;
        if (pn < 4) { base = ZS; ldc = 1024; colt = pn * 256; }
        else if (pn < 10) { base = XBC; ldc = 1536; colt = (pn - 4) * 256; }
        else if (pn < 14) { base = ZA; ldc = 1024; colt = (pn - 10) * 256; }
        else if (pn < 18) { base = Q; ldc = 1024; colt = (pn - 14) * 256; sc = qscale; }
        else if (pn < 22) { base = K; ldc = 1024; colt = (pn - 18) * 256; }
        else { base = V; ldc = 1024; colt = (pn - 22) * 256; }
        const int col0 = colt + wc * 32 + 8 * fq;
#pragma unroll
        for (int ai = 0; ai < 2; ++ai)
#pragma unroll
            for (int m = 0; m < 4; ++m) { bf16_t* rowp = base + (size_t)(row0 + ai * HALF + m * 16) * ldc + col0;
#pragma unroll
                for (int bj = 0; bj < 2; ++bj) { const f32x4 v0 = acc[ai][bj][m][0] * sc, v1 = acc[ai][bj][m][1] * sc;
                    u32x4 w; w.x = cvt_pk_bf16(v0[0], v0[1]); w.y = cvt_pk_bf16(v0[2], v0[3]); w.z = cvt_pk_bf16(v1[0], v1[1]); w.w = cvt_pk_bf16(v1[2], v1[3]);
                    *(u32x4*)(rowp + bj * HALF) = w; } }
    }
};
struct EpiRes {
    static constexpr bool PERM = false, AFTER_DRAIN = false;
    const float* base; float* out; int ldc;
    __device__ __forceinline__ void operator()(const f32x4 (&acc)[2][2][4][2], const Unit& u, int wr, int wc, int fr, int fq) const {
        const int col0 = u.pn * BM + wc * 32 + 4 * fq;
#pragma unroll
        for (int ai = 0; ai < 2; ++ai)
#pragma unroll
            for (int m = 0; m < 4; ++m) { const size_t off = (size_t)(u.pm * BM + ai * HALF + wr * 64 + m * 16 + fr) * ldc + col0;
#pragma unroll
                for (int bj = 0; bj < 2; ++bj)
#pragma unroll
                    for (int n = 0; n < 2; ++n) { const size_t o = off + bj * HALF + n * 16; *(f32x4*)(out + o) = *(const f32x4*)(base + o) + acc[ai][bj][m][n]; } }
    }
};
struct EpiGate {
    static constexpr bool PERM = false, AFTER_DRAIN = false;
    float* io; const bf16_t* PP; int ldc;
    __device__ __forceinline__ void operator()(const f32x4 (&acc)[2][2][4][2], const Unit& u, int wr, int wc, int fr, int fq) const {
        const int col0 = u.pn * BM + wc * 32 + 4 * fq;
#pragma unroll
        for (int ai = 0; ai < 2; ++ai)
#pragma unroll
            for (int m = 0; m < 4; ++m) { const size_t off = (size_t)(u.pm * BM + ai * HALF + wr * 64 + m * 16 + fr) * ldc + col0;
#pragma unroll
                for (int bj = 0; bj < 2; ++bj)
#pragma unroll
                    for (int n = 0; n < 2; ++n) { const size_t o = off + bj * HALF + n * 16; const f32x4 h = *(const f32x4*)(io + o); const u32x2 pw = *(const u32x2*)(PP + o);
                        const f32x4 a = acc[ai][bj][m][n]; f32x4 r;
                        r[0] = h[0] + bf_lo(pw.x) / (1.f + __expf(-a[0])); r[1] = h[1] + bf_hi(pw.x) / (1.f + __expf(-a[1]));
                        r[2] = h[2] + bf_lo(pw.y) / (1.f + __expf(-a[2])); r[3] = h[3] + bf_hi(pw.y) / (1.f + __expf(-a[3]));
                        *(f32x4*)(io + o) = r; } }
    }
};
}

namespace ssd {
#define LAS3 __attribute__((address_space(3)))
typedef unsigned short bf16_t;
typedef short bf16x8 __attribute__((ext_vector_type(8)));
typedef float f32x2 __attribute__((ext_vector_type(2)));
typedef float f32x4 __attribute__((ext_vector_type(4)));
typedef float f32x16 __attribute__((ext_vector_type(16)));
typedef unsigned u32x2 __attribute__((ext_vector_type(2)));
typedef unsigned u32x4 __attribute__((ext_vector_type(4)));
typedef __bf16 bf16x2_t __attribute__((ext_vector_type(2)));
__device__ __forceinline__ unsigned pk(float lo, float hi) { f32x2 v = {lo, hi}; bf16x2_t b = __builtin_convertvector(v, bf16x2_t); return __builtin_bit_cast(unsigned, b); }
__device__ __forceinline__ float bf1(bf16_t b) { return __uint_as_float((unsigned)b << 16); }
__device__ __forceinline__ float lo(unsigned w) { return __uint_as_float(w << 16); }
__device__ __forceinline__ float hi16(unsigned w) { return __uint_as_float(w & 0xffff0000u); }
__device__ __forceinline__ bf16_t tobf(float f) { return (bf16_t)(pk(f, 0.f) & 0xffffu); }
__device__ __forceinline__ int crow(int r, int hi) { return (r & 3) + 8 * (r >> 2) + 4 * hi; }
__device__ __forceinline__ bf16x8 pack8(const float* m) { u32x4 w; w.x = pk(m[0], m[1]); w.y = pk(m[2], m[3]); w.z = pk(m[4], m[5]); w.w = pk(m[6], m[7]); return __builtin_bit_cast(bf16x8, w); }
constexpr float LOG2E = 1.4426950408889634f;

constexpr int PRE_RAW = 0, PRE_OUT = 131 * 512, PRE_DT = PRE_OUT + 256 * 272, PRE_TOT = PRE_DT + 2048, PRE_END = PRE_TOT + 64;
__device__ __forceinline__ void pre_item(int item, const bf16_t* __restrict__ XBC, const float* __restrict__ DTF, const float* __restrict__ conv_w, const float* __restrict__ conv_b,
                                         const float* __restrict__ dt_bias, const float* __restrict__ a_log, bf16_t* __restrict__ XDTT, bf16_t* __restrict__ Bn, bf16_t* __restrict__ BT,
                                         bf16_t* __restrict__ Cn, float* __restrict__ ACS, float* __restrict__ DT, LAS3 unsigned char* lds, const int tidx) {
    const int tid = tidx, lane = tid & 63, wid = tid >> 6;
    const int chunk = item / 6, j = item - chunk * 6, c = chunk & 63;
    const long m0 = (long)chunk * 128;
    LAS3 bf16_t* RAW = (LAS3 bf16_t*)(lds + PRE_RAW);
    LAS3 bf16_t* OUT = (LAS3 bf16_t*)(lds + PRE_OUT);
    LAS3 float* s_dt = (LAS3 float*)(lds + PRE_DT);
    LAS3 float* s_tot = (LAS3 float*)(lds + PRE_TOT);
    __syncthreads();
    {
        u32x4 v[9];
#pragma unroll
        for (int i = 0; i < 9; ++i) { const int idx = tid + i * 512, r = idx >> 5, c16 = idx & 31; v[i] = (u32x4){0u, 0u, 0u, 0u};
            if (idx < 131 * 32 && !(c == 0 && r < 3)) v[i] = *(const u32x4*)(XBC + (m0 + r - 3) * 1536 + 256 * j + c16 * 8); }
#pragma unroll
        for (int i = 0; i < 9; ++i) { const int idx = tid + i * 512, r = idx >> 5, c16 = idx & 31; if (idx < 131 * 32) *(LAS3 u32x4*)(RAW + r * 256 + c16 * 8) = v[i]; }
    }
    float cs = 0.f, dtv = 0.f;
    if (j < 4) {
        const int hl = tid >> 7, l = tid & 127, h = 4 * j + hl;
        const float raw = DTF[(m0 + l) * 32 + h] + dt_bias[h];
        dtv = fmaxf(raw, 0.f) + log1pf(expf(-fabsf(raw)));
        cs = -expf(a_log[h]) * dtv;
#pragma unroll
        for (int o = 1; o < 64; o <<= 1) { const float t = __shfl_up(cs, o); if (lane >= o) cs += t; }
        if (lane == 63) s_tot[wid] = cs;
        s_dt[hl * 128 + l] = dtv;
    }
    __syncthreads();
    if (j < 4) {
        const int hl = tid >> 7, l = tid & 127, h = 4 * j + hl;
        if (wid & 1) cs += s_tot[wid - 1];
        ACS[((size_t)chunk * 16 + h) * 128 + l] = cs;
        DT[((size_t)chunk * 16 + h) * 128 + l] = dtv;
    }
    const int ch = tid & 255, half = tid >> 8, cx = 256 * j + ch, l0 = half * 64;
    const float w0 = conv_w[cx], w1 = conv_w[1536 + cx], w2 = conv_w[2 * 1536 + cx], w3 = conv_w[3 * 1536 + cx], cb = conv_b[cx];
    float xm3 = bf1(RAW[(l0 + 0) * 256 + ch]), xm2 = bf1(RAW[(l0 + 1) * 256 + ch]), xm1 = bf1(RAW[(l0 + 2) * 256 + ch]);
    __syncthreads();
    const int hl = ch >> 6;
    for (int g8 = 0; g8 < 8; ++g8) {
        float v[8];
        const int l = l0 + g8 * 8;
#pragma unroll
        for (int i = 0; i < 8; ++i) {
            const float xin = bf1(RAW[(l + i + 3) * 256 + ch]);
            const float cv = cb + w0 * xm3 + w1 * xm2 + w2 * xm1 + w3 * xin;
            xm3 = xm2; xm2 = xm1; xm1 = xin;
            v[i] = cv / (1.f + __expf(-cv));
        }
        if (j < 4) {
#pragma unroll
            for (int i = 0; i < 8; ++i) v[i] *= s_dt[hl * 128 + l + i];
        } else {
#pragma unroll
            for (int i = 0; i < 8; ++i) RAW[(l + i + 3) * 256 + ch] = tobf(v[i]);
        }
        if (j <= 4) *(LAS3 bf16x8*)(OUT + ch * 136 + l) = pack8(v);
    }
    __syncthreads();
    if (j <= 4) {
        bf16_t* dst = (j < 4) ? XDTT + ((size_t)chunk * 1024 + 256 * j) * 128 : BT + (size_t)chunk * 256 * 128;
#pragma unroll
        for (int i = 0; i < 8; ++i) { const int idx = tid + i * 512, row = idx >> 4, c16 = idx & 15; *(u32x4*)(dst + row * 128 + c16 * 8) = *(const LAS3 u32x4*)(OUT + row * 136 + c16 * 8); }
    }
    if (j >= 4) {
        bf16_t* dst = (j == 4 ? Bn : Cn) + m0 * 256;
#pragma unroll
        for (int i = 0; i < 8; ++i) { const int idx = tid + i * 512, row = idx >> 5, c16 = idx & 31; *(u32x4*)(dst + row * 256 + c16 * 8) = *(const LAS3 u32x4*)(RAW + (row + 3) * 256 + c16 * 8); }
    }
}
__device__ __forceinline__ void fb_item(int bh, const float* __restrict__ DTF, const float* __restrict__ fg_bias, float* __restrict__ FB, LAS3 unsigned char* lds, const int tidx) {
    const int tid = tidx, lane = tid & 63, wid = tid >> 6, b = bh >> 4, h = bh & 15;
    LAS3 float* s_tot = (LAS3 float*)lds + 1024;
    __syncthreads();
    const float fb = fg_bias[h];
    float v[16]; float run = 0.f;
#pragma unroll
    for (int i = 0; i < 16; ++i) { const float x = DTF[((size_t)b * 8192 + tid * 16 + i) * 32 + 16 + h] + fb; run += fminf(x, 0.f) - log1pf(expf(-fabsf(x))); v[i] = run; }
    float s = run;
#pragma unroll
    for (int o = 1; o < 64; o <<= 1) { const float t = __shfl_up(s, o); if (lane >= o) s += t; }
    if (lane == 63) s_tot[wid] = s;
    __syncthreads();
    float off = s - run;
    for (int w = 0; w < wid; ++w) off += s_tot[w];
#pragma unroll
    for (int i = 0; i < 16; i += 4) { f32x4 o4; o4[0] = -(off + v[i]) * LOG2E; o4[1] = -(off + v[i + 1]) * LOG2E; o4[2] = -(off + v[i + 2]) * LOG2E; o4[3] = -(off + v[i + 3]) * LOG2E;
        *(f32x4*)(FB + (size_t)bh * 8192 + tid * 16 + i) = o4; }
}
constexpr int ST_BT = 0, ST_ACS = 128 * 272, ST_END = ST_ACS + 4096;
__device__ __forceinline__ void state_item(int item, const bf16_t* __restrict__ XDTT, const bf16_t* __restrict__ BT, const float* __restrict__ ACS, bf16_t* __restrict__ S, LAS3 unsigned char* lds, const int tidx) {
    const int tid = tidx, lane = tid & 63, wid = tid >> 6, r32 = lane & 31, hi = lane >> 5;
    const int chunk = item >> 1, g = item & 1, h = g * 8 + wid;
    LAS3 bf16_t* BTs = (LAS3 bf16_t*)(lds + ST_BT);
    LAS3 float* s_acs = (LAS3 float*)(lds + ST_ACS) + wid * 128;
    __syncthreads();
    { const bf16_t* src = BT + ((size_t)chunk * 256 + g * 128) * 128; u32x4 v[4];
#pragma unroll
      for (int i = 0; i < 4; ++i) { const int idx = tid + i * 512; v[i] = *(const u32x4*)(src + (idx >> 4) * 128 + (idx & 15) * 8); }
#pragma unroll
      for (int i = 0; i < 4; ++i) { const int idx = tid + i * 512; *(LAS3 u32x4*)(BTs + (idx >> 4) * 136 + (idx & 15) * 8) = v[i]; } }
    { const float* acs = ACS + ((size_t)chunk * 16 + h) * 128; s_acs[lane] = acs[lane]; s_acs[lane + 64] = acs[lane + 64]; }
    const bf16_t* xa = XDTT + ((size_t)chunk * 1024 + h * 64 + r32) * 128 + 8 * hi;
    u32x4 xr[2][8];
#pragma unroll
    for (int pt = 0; pt < 2; ++pt)
#pragma unroll
        for (int ks = 0; ks < 8; ++ks) xr[pt][ks] = *(const u32x4*)(xa + (size_t)pt * 32 * 128 + 16 * ks);
    __syncthreads();
    const float aend = s_acs[127];
    bf16_t* sp = S + ((size_t)chunk * 16 + h) * 8192 + r32;
#pragma unroll 1
    for (int nh = 0; nh < 2; ++nh) {
        f32x16 acc[2][2];
#pragma unroll
        for (int a = 0; a < 2; ++a)
#pragma unroll
            for (int b = 0; b < 2; ++b) acc[a][b] = f32x16{};
#pragma unroll
        for (int ks = 0; ks < 8; ++ks) {
            const f32x4 a0 = *(const LAS3 f32x4*)(s_acs + 16 * ks + 8 * hi), a1 = *(const LAS3 f32x4*)(s_acs + 16 * ks + 8 * hi + 4);
            float wv[8];
#pragma unroll
            for (int i = 0; i < 4; ++i) { wv[i] = __expf(aend - a0[i]); wv[4 + i] = __expf(aend - a1[i]); }
            bf16x8 A[2], B[2];
#pragma unroll
            for (int pt = 0; pt < 2; ++pt) { float m[8];
#pragma unroll
                for (int i = 0; i < 4; ++i) { m[2 * i] = lo(xr[pt][ks][i]) * wv[2 * i]; m[2 * i + 1] = hi16(xr[pt][ks][i]) * wv[2 * i + 1]; }
                A[pt] = pack8(m); }
#pragma unroll
            for (int nt = 0; nt < 2; ++nt) B[nt] = *(const LAS3 bf16x8*)(BTs + (32 * (2 * nh + nt) + r32) * 136 + 16 * ks + 8 * hi);
#pragma unroll
            for (int pt = 0; pt < 2; ++pt)
#pragma unroll
                for (int nt = 0; nt < 2; ++nt) acc[pt][nt] = __builtin_amdgcn_mfma_f32_32x32x16_bf16(A[pt], B[nt], acc[pt][nt], 0, 0, 0);
        }
#pragma unroll
        for (int pt = 0; pt < 2; ++pt)
#pragma unroll
            for (int nt = 0; nt < 2; ++nt)
#pragma unroll
                for (int r = 0; r < 16; ++r) sp[(32 * pt + crow(r, hi)) * 128 + 32 * (2 * nh + nt)] = tobf(acc[pt][nt][r]);
    }
}
__device__ __forceinline__ void scan_pair(int gt, bf16_t* __restrict__ S, const float* __restrict__ ACS) {
    const int b = gt >> 16, h = (gt >> 12) & 15, idx = gt & 4095;
    unsigned* S32 = (unsigned*)S;
    float h0 = 0.f, h1 = 0.f;
    for (int c0 = 0; c0 < 64; c0 += 16) {
        unsigned sv[16]; float cd[16];
#pragma unroll
        for (int i = 0; i < 16; ++i) { const size_t ch = (size_t)(b * 64 + c0 + i) * 16 + h; sv[i] = S32[ch * 4096 + idx]; cd[i] = ACS[ch * 128 + 127]; }
#pragma unroll
        for (int i = 0; i < 16; ++i) { const size_t ch = (size_t)(b * 64 + c0 + i) * 16 + h; S32[ch * 4096 + idx] = pk(h0, h1); const float e = __expf(cd[i]); h0 = h0 * e + lo(sv[i]); h1 = h1 * e + hi16(sv[i]); }
    }
}
constexpr int O_CS = 0, O_CB = 128 * 272, O_ACS = 2 * 128 * 272, O_DT = O_ACS + 4096, O_SSQ = O_DT + 4096, O_RSTD = O_SSQ + 4096, O_YST = O_RSTD + 512, OUT_LDS_END = O_YST + 8 * 32 * 144;
__device__ __forceinline__ void out_item(int item, const bf16_t* __restrict__ XDTT, const bf16_t* __restrict__ Bn, const bf16_t* __restrict__ Cn, const float* __restrict__ ACS,
                                         const float* __restrict__ DT, const bf16_t* __restrict__ PREV, const bf16_t* ZS, bf16_t* YS, const float* __restrict__ d_skip,
                                         const float* __restrict__ gnorm, LAS3 unsigned char* lds, const int tidx) {
    const int tid = tidx, lane = tid & 63, wid = tid >> 6, r32 = lane & 31, hi = lane >> 5;
    const int chunk = item >> 1, g = item & 1, h = g * 8 + wid;
    const size_t m0 = (size_t)chunk * 128;
    LAS3 bf16_t* CS = (LAS3 bf16_t*)(lds + O_CS);
    LAS3 bf16_t* CB = (LAS3 bf16_t*)(lds + O_CB);
    LAS3 float* s_acs = (LAS3 float*)(lds + O_ACS) + wid * 128;
    LAS3 float* s_dt = (LAS3 float*)(lds + O_DT) + wid * 128;
    LAS3 float* s_ssq = (LAS3 float*)(lds + O_SSQ);
    LAS3 float* s_rstd = (LAS3 float*)(lds + O_RSTD);
    LAS3 bf16_t* YST = (LAS3 bf16_t*)(lds + O_YST) + wid * (32 * 72);
    __syncthreads();
    { const bf16_t* src = Cn + m0 * 256 + g * 128; u32x4 v[4];
#pragma unroll
      for (int i = 0; i < 4; ++i) { const int idx = tid + i * 512; v[i] = *(const u32x4*)(src + (idx >> 4) * 256 + (idx & 15) * 8); }
#pragma unroll
      for (int i = 0; i < 4; ++i) { const int idx = tid + i * 512; *(LAS3 u32x4*)(CS + (idx >> 4) * 136 + (idx & 15) * 8) = v[i]; } }
    { const float* ap = ACS + ((size_t)chunk * 16 + h) * 128; const float* dp = DT + ((size_t)chunk * 16 + h) * 128;
      s_acs[lane] = ap[lane]; s_acs[lane + 64] = ap[lane + 64]; s_dt[lane] = dp[lane]; s_dt[lane + 64] = dp[lane + 64]; }
    const bf16_t* pv = PREV + (((size_t)chunk * 16 + h) * 64 + r32) * 128 + 8 * hi;
    __syncthreads();
#pragma unroll
    for (int bi = 0; bi < 2; ++bi) {
        const int blk = wid * 2 + bi, lb = blk >> 2, sb = blk & 3;
        if (sb <= lb) {
            f32x16 acc = f32x16{};
            const bf16_t* ba = Bn + (m0 + 32 * sb + r32) * 256 + g * 128 + 8 * hi;
            bf16x8 bfr[8];
#pragma unroll
            for (int ks = 0; ks < 8; ++ks) bfr[ks] = *(const bf16x8*)(ba + 16 * ks);
#pragma unroll
            for (int ks = 0; ks < 8; ++ks) acc = __builtin_amdgcn_mfma_f32_32x32x16_bf16(*(const LAS3 bf16x8*)(CS + (32 * lb + r32) * 136 + 16 * ks + 8 * hi), bfr[ks], acc, 0, 0, 0);
#pragma unroll
            for (int r = 0; r < 16; ++r) CB[(32 * lb + crow(r, hi)) * 136 + 32 * sb + r32] = tobf(acc[r]);
        }
    }
    __syncthreads();
    const bf16_t* xt = XDTT + ((size_t)chunk * 1024 + h * 64 + r32) * 128;
    const float dsk = d_skip[h];
    const int orow = lane >> 3, c8 = lane & 7;
    const size_t gbase = m0 * 1024 + h * 64 + c8 * 8;
#pragma unroll 1
    for (int lb = 0; lb < 4; ++lb) {
        f32x16 yd[2], yo[2]; yd[0] = f32x16{}; yd[1] = f32x16{}; yo[0] = f32x16{}; yo[1] = f32x16{};
        const int lrow = 32 * lb + r32;
        { bf16x8 pvf[2][8];
#pragma unroll
          for (int pt = 0; pt < 2; ++pt)
#pragma unroll
              for (int ks = 0; ks < 8; ++ks) pvf[pt][ks] = *(const bf16x8*)(pv + pt * 4096 + 16 * ks);
#pragma unroll
          for (int ks = 0; ks < 8; ++ks) {
            const bf16x8 a = *(const LAS3 bf16x8*)(CS + lrow * 136 + 16 * ks + 8 * hi);
            yo[0] = __builtin_amdgcn_mfma_f32_32x32x16_bf16(a, pvf[0][ks], yo[0], 0, 0, 0);
            yo[1] = __builtin_amdgcn_mfma_f32_32x32x16_bf16(a, pvf[1][ks], yo[1], 0, 0, 0);
          } }
        asm volatile("" ::: "memory");
        const float al = s_acs[lrow];
#pragma unroll 1
        for (int sb = 0; sb <= lb; ++sb) {
            bf16x8 xb[2][2];
#pragma unroll
            for (int k2 = 0; k2 < 2; ++k2)
#pragma unroll
                for (int pt = 0; pt < 2; ++pt) xb[k2][pt] = *(const bf16x8*)(xt + pt * 4096 + 32 * sb + 16 * k2 + 8 * hi);
#pragma unroll
            for (int k2 = 0; k2 < 2; ++k2) {
                const int s0 = 32 * sb + 16 * k2 + 8 * hi;
                const u32x4 cw = *(const LAS3 u32x4*)(CB + lrow * 136 + s0);
                const f32x4 e0 = *(const LAS3 f32x4*)(s_acs + s0), e1 = *(const LAS3 f32x4*)(s_acs + s0 + 4);
                float m[8];
#pragma unroll
                for (int i = 0; i < 4; ++i) { const float ea = (i < 2) ? e0[2 * i] : e1[2 * i - 4], eb = (i < 2) ? e0[2 * i + 1] : e1[2 * i - 3];
                    m[2 * i] = (s0 + 2 * i <= lrow) ? lo(cw[i]) * __expf(fminf(al - ea, 0.f)) : 0.f;
                    m[2 * i + 1] = (s0 + 2 * i + 1 <= lrow) ? hi16(cw[i]) * __expf(fminf(al - eb, 0.f)) : 0.f; }
                const bf16x8 a = pack8(m);
                yd[0] = __builtin_amdgcn_mfma_f32_32x32x16_bf16(a, xb[k2][0], yd[0], 0, 0, 0);
                yd[1] = __builtin_amdgcn_mfma_f32_32x32x16_bf16(a, xb[k2][1], yd[1], 0, 0, 0);
            }
        }
#pragma unroll
        for (int g4 = 0; g4 < 4; ++g4) {
            const int lq = 32 * lb + 8 * g4 + 4 * hi;
            const f32x4 ea = *(const LAS3 f32x4*)(s_acs + lq), dq = *(const LAS3 f32x4*)(s_dt + lq);
#pragma unroll
            for (int pt = 0; pt < 2; ++pt) {
                const u32x2 xw = *(const u32x2*)(xt + pt * 4096 + lq);
                const float xv[4] = {lo(xw.x), hi16(xw.x), lo(xw.y), hi16(xw.y)};
#pragma unroll
                for (int jj = 0; jj < 4; ++jj) { const int r = 4 * g4 + jj;
                    const float y = yd[pt][r] + __expf(ea[jj]) * yo[pt][r] + dsk * xv[jj] / dq[jj];
                    YST[(8 * g4 + 4 * hi + jj) * 72 + 32 * pt + r32] = tobf(y); }
            }
        }
        asm volatile("s_waitcnt lgkmcnt(0)" ::: "memory");
#pragma unroll
        for (int i = 0; i < 4; ++i) {
            const int row = i * 8 + orow;
            const u32x4 v = *(const LAS3 u32x4*)(YST + row * 72 + c8 * 8);
            const size_t go = gbase + (size_t)(32 * lb + row) * 1024;
            const u32x4 zz = *(const u32x4*)(ZS + go);
            u32x4 w; float ss = 0.f;
#pragma unroll
            for (int jj = 0; jj < 4; ++jj) { const float z0 = lo(zz[jj]), z1 = hi16(zz[jj]);
                const float y0 = lo(v[jj]) * (z0 / (1.f + __expf(-z0))), y1 = hi16(v[jj]) * (z1 / (1.f + __expf(-z1)));
                ss += y0 * y0 + y1 * y1; w[jj] = pk(y0, y1); }
            ss += __shfl_xor(ss, 1); ss += __shfl_xor(ss, 2); ss += __shfl_xor(ss, 4);
            if (c8 == 0) s_ssq[wid * 128 + 32 * lb + row] = ss;
            *(u32x4*)(YS + go) = w;
        }
        asm volatile("s_waitcnt lgkmcnt(0)" ::: "memory");
    }
    __syncthreads();
    if (tid < 128) { float t = 0.f;
#pragma unroll
        for (int w = 0; w < 8; ++w) t += s_ssq[w * 128 + tid];
        s_rstd[tid] = rsqrtf(t * (1.f / 512.f) + 1e-6f); }
    __syncthreads();
    const f32x4 gn0 = *(const f32x4*)(gnorm + h * 64 + c8 * 8), gn1 = *(const f32x4*)(gnorm + h * 64 + c8 * 8 + 4);
#pragma unroll 1
    for (int lb = 0; lb < 4; ++lb)
#pragma unroll
        for (int i = 0; i < 4; ++i) {
            const int row = 32 * lb + i * 8 + orow; const float rs = s_rstd[row];
            const size_t go = gbase + (size_t)row * 1024;
            const u32x4 v = *(const u32x4*)(YS + go); u32x4 w;
            w[0] = pk(lo(v[0]) * rs * gn0[0], hi16(v[0]) * rs * gn0[1]); w[1] = pk(lo(v[1]) * rs * gn0[2], hi16(v[1]) * rs * gn0[3]);
            w[2] = pk(lo(v[2]) * rs * gn1[0], hi16(v[2]) * rs * gn1[1]); w[3] = pk(lo(v[3]) * rs * gn1[2], hi16(v[3]) * rs * gn1[3]);
            *(u32x4*)(YS + go) = w;
        }
}
}
#include <hip/hip_cooperative_groups.h>
namespace cg = cooperative_groups;
#define LAS __attribute__((address_space(3)))
#define GAS __attribute__((address_space(1)))
typedef unsigned short bf16;
typedef unsigned v4u __attribute__((ext_vector_type(4)));
typedef float f32x4 __attribute__((ext_vector_type(4)));
typedef GAS unsigned gu32;
#define RLX_AGENT __ATOMIC_RELAXED, __HIP_MEMORY_SCOPE_AGENT
#define XB_TMO      128
#define XB_XCNT(j)  (256  + 64 * (j))
#define XB_XSUB(j)  (1280 + 64 * (j))
#define XB_XGEN(j)  (2304 + 64 * (j))
#define XB_TOP      3328
#define XB_TOPGEN   3392
#define XCD_BAR_WORDS 3456
#define XB_SPIN_CAP (1u << 18)

__device__ __forceinline__ unsigned xb_ld(unsigned* p)              { return __hip_atomic_load(p, __ATOMIC_RELAXED, __HIP_MEMORY_SCOPE_AGENT); }
__device__ __forceinline__ unsigned xb_add(unsigned* p, unsigned v) { return __hip_atomic_fetch_add(p, v, __ATOMIC_RELAXED, __HIP_MEMORY_SCOPE_AGENT); }
__device__ __forceinline__ unsigned xb_xcc_id() { return (unsigned)__builtin_amdgcn_s_getreg((3 << 11) | 20) & 0xFu; }
#define XB_SPIN(cond, bar) do { unsigned _sp = 0; while (cond) { __builtin_amdgcn_s_sleep(1); \
    if ((++_sp & 255u) == 0u) { if (xb_ld(&(bar)[XB_TMO])) break; if (_sp > XB_SPIN_CAP) { atomicAdd(&(bar)[XB_TMO], 1u); break; } } } } while (0)

struct XcdBarrier {
    unsigned* bar; unsigned x;
    volatile LAS unsigned* st;
};

__device__ __forceinline__ XcdBarrier xcd_barrier_post(unsigned* bar, volatile LAS unsigned* st, const int tidx) {
    XcdBarrier b; b.bar = bar; b.x = xb_xcc_id(); b.st = st;
    if (tidx == 0) (void)xb_add(&bar[XB_XCNT(b.x)], 1u);
    return b;
}
__device__ __forceinline__ void xcd_barrier_complete(unsigned* bar, unsigned x, unsigned& nloc, unsigned& nx) {
    const unsigned G = gridDim.x * gridDim.y * gridDim.z;
    unsigned sum, cnt, mine, sp = 0u;
    for (;;) {
        sum = 0u; cnt = 0u; mine = 0u;
#pragma unroll
        for (unsigned j = 0; j < 16; ++j) { const unsigned c = xb_ld(&bar[XB_XCNT(j)]); sum += c; cnt += (c > 0u) ? 1u : 0u; mine = (j == x) ? c : mine; }
        if (sum == G) break;
        __builtin_amdgcn_s_sleep(1);
        if ((++sp & 255u) == 0u) { if (xb_ld(&bar[XB_TMO])) break; if (sp > XB_SPIN_CAP) { atomicAdd(&bar[XB_TMO], 1u); break; } }
    }
    nloc = mine > 0u ? mine : 1u; nx = cnt > 0u ? cnt : 1u;
}

__device__ __forceinline__ void xcd_barrier(const XcdBarrier& b, const int tidx) {
    asm volatile("s_waitcnt vmcnt(0)" ::: "memory");
    __syncthreads();
    if (tidx == 0) {
        unsigned* bar = b.bar;
        __builtin_amdgcn_s_waitcnt(0);
        unsigned nloc = b.st[0], nx = b.st[1];
        if (nloc == 0u) { xcd_barrier_complete(bar, b.x, nloc, nx); b.st[0] = nloc; b.st[1] = nx; }
        const unsigned old = xb_add(&bar[XB_XSUB(b.x)], 1u);
        const unsigned gen = old / nloc;
        if (old + 1u == (gen + 1u) * nloc) {
            __builtin_amdgcn_fence(__ATOMIC_RELEASE, "agent");
            asm volatile("s_waitcnt vmcnt(0)" ::: "memory");
            const unsigned og = xb_add(&bar[XB_TOP], 1u);
            const unsigned tg = og / nx;
            if (og + 1u == (tg + 1u) * nx) xb_add(&bar[XB_TOPGEN], 1u);
            else XB_SPIN(xb_ld(&bar[XB_TOPGEN]) == tg, bar);
            __builtin_amdgcn_fence(__ATOMIC_ACQUIRE, "agent");
            xb_add(&bar[XB_XGEN(b.x)], 1u);
            asm volatile("s_waitcnt vmcnt(0)" ::: "memory");
        } else {
            XB_SPIN(xb_ld(&bar[XB_XGEN(b.x)]) == gen, bar);
            __builtin_amdgcn_fence(__ATOMIC_ACQUIRE, "agent");
            asm volatile("s_waitcnt vmcnt(0)" ::: "memory");
        }
    }
    __syncthreads();
}

constexpr int NWAVES = 8;
constexpr int LDS_BAR_OFF = 147456 - 64;
constexpr size_t CTL_ZERO_BYTES = 65536;
constexpr int M = 16384, DM = 1024, NINP = 6912, NINR = 6688, DIN = 2048, PLE = 256;
constexpr size_t MiB = 1u << 20;
constexpr size_t WS_WOUT = 1 * MiB, WS_WGATE = 5 * MiB, WS_WPROJ = 7 * MiB, WS_ZS = 8 * MiB, WS_ZA = 40 * MiB, WS_Q = 72 * MiB, WS_K = 104 * MiB, WS_V = 136 * MiB,
                 WS_XBC = 168 * MiB, WS_DTF = 216 * MiB, WS_S = 168 * MiB, WS_PB = 232 * MiB, WS_PP = WS_Q, WS_HN = WS_K, WS_END = 240 * MiB;
constexpr size_t OS_U = 0, OS_WIN = 32 * MiB;
constexpr size_t OS_XDTT = 0, OS_BN = 32 * MiB, OS_BT = 40 * MiB, OS_CN = 48 * MiB, OS_ACS = 56 * MiB, OS_DT = 57 * MiB, OS_FB = 58 * MiB;
constexpr int LDS_BYTES = 147456;
static_assert(attn_body::LDS_BYTES <= 131072 && ssd::OUT_LDS_END <= 147456 && ssd::PRE_END <= 147456 && ssd::ST_END <= 147456, "LDS");

__device__ __forceinline__ unsigned f2bf(float f) { unsigned u = __builtin_bit_cast(unsigned, f); return (u + 0x7fffu + ((u >> 16) & 1u)) >> 16; }
__device__ __forceinline__ unsigned pk2(float lo, float hi) { return f2bf(lo) | (f2bf(hi) << 16); }
__device__ __forceinline__ float wave_sum(float v) {
#pragma unroll
    for (int o = 1; o < 64; o <<= 1) v += __shfl_xor(v, o);
    return v;
}
__device__ __forceinline__ int map_in_row(int n) { return n < 2560 ? n : (n < 2576 ? n + 4096 : (n < 6672 ? n - 16 : n)); }
template <bool MAP> __device__ __forceinline__ void p0_transpose_item(const float* W, int K, int N, bf16* WT, LAS float* scr, int item, int lane) {
    const int nblk = N / 32, kb = item / nblk, nb = item % nblk, k0 = 64 * kb, n0 = 32 * nb;
    { f32x4 v[8];
#pragma unroll
      for (int i = 0; i < 8; ++i) v[i] = *(const f32x4*)(W + (size_t)(k0 + 8 * i + (lane >> 3)) * N + n0 + 4 * (lane & 7));
#pragma unroll
      for (int i = 0; i < 8; ++i) { LAS float* d = scr + (8 * i + (lane >> 3)) * 33 + 4 * (lane & 7); d[0] = v[i].x; d[1] = v[i].y; d[2] = v[i].z; d[3] = v[i].w; } }
    asm volatile("s_waitcnt lgkmcnt(0)" ::: "memory");
    const int c = lane & 7;
#pragma unroll
    for (int j = 0; j < 4; ++j) { const int n = (lane >> 3) + 8 * j; const LAS float* s = scr + (8 * c) * 33 + n;
        v4u o; o.x = pk2(s[0 * 33], s[1 * 33]); o.y = pk2(s[2 * 33], s[3 * 33]); o.z = pk2(s[4 * 33], s[5 * 33]); o.w = pk2(s[6 * 33], s[7 * 33]);
        const int row = MAP ? map_in_row(n0 + n) : (n0 + n);
        *(v4u*)(WT + (size_t)row * K + k0 + 8 * c) = o; }
    asm volatile("s_waitcnt lgkmcnt(0)" ::: "memory");
}
__device__ __forceinline__ void rms_row_to_bf16(const float* xrow, const float* gain, bf16* orow, int lane) {
    const f32x4* xr = (const f32x4*)xrow + lane; const f32x4* gr = (const f32x4*)gain + lane;
    f32x4 v[4]; float s = 0.f;
#pragma unroll
    for (int j = 0; j < 4; ++j) { v[j] = xr[64 * j]; s += (v[j].x * v[j].x + v[j].y * v[j].y) + (v[j].z * v[j].z + v[j].w * v[j].w); }
    const float rstd = rsqrtf(wave_sum(s) * (1.f / 1024.f) + 1e-6f);
    unsigned long long* o8 = (unsigned long long*)orow + lane;
#pragma unroll
    for (int j = 0; j < 4; ++j) { const f32x4 gg = gr[64 * j];
        o8[64 * j] = (unsigned long long)pk2(v[j].x * rstd * gg.x, v[j].y * rstd * gg.y) | ((unsigned long long)pk2(v[j].z * rstd * gg.z, v[j].w * rstd * gg.w) << 32); }
}
template <int NR> __device__ __forceinline__ void rms_rows_to_bf16(const float* x, const float* gain, bf16* o, size_t m0, size_t rstride, int lane) {
    f32x4 v[NR][4]; float s[NR];
#pragma unroll
    for (int r = 0; r < NR; ++r) { const f32x4* xr = (const f32x4*)(x + (m0 + r * rstride) * 1024) + lane;
#pragma unroll
        for (int j = 0; j < 4; ++j) v[r][j] = xr[64 * j]; }
    const f32x4* gr = (const f32x4*)gain + lane; f32x4 gg[4];
#pragma unroll
    for (int j = 0; j < 4; ++j) gg[j] = gr[64 * j];
#pragma unroll
    for (int r = 0; r < NR; ++r) { float t = 0.f;
#pragma unroll
        for (int j = 0; j < 4; ++j) t += (v[r][j].x * v[r][j].x + v[r][j].y * v[r][j].y) + (v[r][j].z * v[r][j].z + v[r][j].w * v[r][j].w);
        s[r] = rsqrtf(wave_sum(t) * (1.f / 1024.f) + 1e-6f); }
#pragma unroll
    for (int r = 0; r < NR; ++r) { unsigned long long* o8 = (unsigned long long*)(o + (m0 + r * rstride) * 1024) + lane;
#pragma unroll
        for (int j = 0; j < 4; ++j) o8[64 * j] = (unsigned long long)pk2(v[r][j].x * s[r] * gg[j].x, v[r][j].y * s[r] * gg[j].y) | ((unsigned long long)pk2(v[r][j].z * s[r] * gg[j].z, v[r][j].w * s[r] * gg[j].w) << 32); }
}
template <int NR> __device__ __forceinline__ void rms_rows_inplace(float* x, const float* gain, size_t m0, size_t rstride, int lane) {
    f32x4 v[NR][4]; float s[NR];
#pragma unroll
    for (int r = 0; r < NR; ++r) { const f32x4* xr = (const f32x4*)(x + (m0 + r * rstride) * 1024) + lane;
#pragma unroll
        for (int j = 0; j < 4; ++j) v[r][j] = xr[64 * j]; }
    const f32x4* gr = (const f32x4*)gain + lane; f32x4 gg[4];
#pragma unroll
    for (int j = 0; j < 4; ++j) gg[j] = gr[64 * j];
#pragma unroll
    for (int r = 0; r < NR; ++r) { float t = 0.f;
#pragma unroll
        for (int j = 0; j < 4; ++j) t += (v[r][j].x * v[r][j].x + v[r][j].y * v[r][j].y) + (v[r][j].z * v[r][j].z + v[r][j].w * v[r][j].w);
        s[r] = rsqrtf(wave_sum(t) * (1.f / 1024.f) + 1e-6f); }
#pragma unroll
    for (int r = 0; r < NR; ++r) { f32x4* xr = (f32x4*)(x + (m0 + r * rstride) * 1024) + lane;
#pragma unroll
        for (int j = 0; j < 4; ++j) xr[64 * j] = v[r][j] * s[r] * gg[j]; }
}
__device__ __forceinline__ void rms_row_inplace(float* xrow, const float* gain, int lane) {
    f32x4* xr = (f32x4*)xrow + lane; const f32x4* gr = (const f32x4*)gain + lane;
    f32x4 v[4]; float s = 0.f;
#pragma unroll
    for (int j = 0; j < 4; ++j) { v[j] = xr[64 * j]; s += (v[j].x * v[j].x + v[j].y * v[j].y) + (v[j].z * v[j].z + v[j].w * v[j].w); }
    const float rstd = rsqrtf(wave_sum(s) * (1.f / 1024.f) + 1e-6f);
#pragma unroll
    for (int j = 0; j < 4; ++j) xr[64 * j] = v[j] * rstd * gr[64 * j];
}

#ifndef MK_SPLIT
#define MK_SPLIT 0
#endif
__device__ __forceinline__ int mk_lane() { int l; asm volatile("v_mbcnt_lo_u32_b32 %0, -1, 0\n\tv_mbcnt_hi_u32_b32 %0, -1, %0" : "=v"(l)); return l; }
__device__ __forceinline__ int mk_tid(int wave_s) { return wave_s * 64 + mk_lane(); }
struct Args { const float* in[17]; float* out; unsigned char* ws; int ph_lo, ph_hi; };
__global__ void __launch_bounds__(NWAVES * 64, 2) mega_fwd(Args args) {
    extern __shared__ __attribute__((aligned(16))) unsigned char lds[];
    cg::grid_group grid = cg::this_grid();
    LAS unsigned char* L = (LAS unsigned char*)lds;
    int wave_s = __builtin_amdgcn_readfirstlane((int)(threadIdx.x >> 6)); asm volatile("" : "+s"(wave_s));
#define lane (mk_lane())
#define tid (mk_tid(wave_s))
#define wave wave_s
#define G ((int)gridDim.x)
#define bx ((int)blockIdx.x)
#define gw (bx * NWAVES + wave)
#define NGW (G * NWAVES)
    typedef const __attribute__((address_space(4))) Args* cargs_t;
#define ARGP(A) cargs_t A = (cargs_t)__builtin_amdgcn_kernarg_segment_ptr(); asm volatile("" : "+s"(A)); unsigned char* ws = A->ws; unsigned char* os = (unsigned char*)A->out; (void)ws; (void)os
#define Wout_t ((bf16*)(ws + WS_WOUT))
#define Wgate_t ((bf16*)(ws + WS_WGATE))
#define Wproj_t ((bf16*)(ws + WS_WPROJ))
#define ZS ((bf16*)(ws + WS_ZS))
#define ZA ((bf16*)(ws + WS_ZA))
#define Qb ((bf16*)(ws + WS_Q))
#define Kb ((bf16*)(ws + WS_K))
#define Vb ((bf16*)(ws + WS_V))
#define XBC ((bf16*)(ws + WS_XBC))
#define DTF ((float*)(ws + WS_DTF))
#define Sst ((ssd::bf16_t*)(ws + WS_S))
#define PB ((bf16*)(ws + WS_PB))
#define PP ((bf16*)(ws + WS_PP))
#define HN ((bf16*)(ws + WS_HN))
#define U ((bf16*)(os + OS_U))
#define Win_t ((bf16*)(os + OS_WIN))
#define XDTT ((bf16*)(os + OS_XDTT))
#define Bn ((bf16*)(os + OS_BN))
#define BT ((bf16*)(os + OS_BT))
#define Cn ((bf16*)(os + OS_CN))
#define ACS ((float*)(os + OS_ACS))
#define DTb ((float*)(os + OS_DT))
#define FB ((float*)(os + OS_FB))
    int lo, hi; { ARGP(A0); lo = A0->ph_lo; hi = A0->ph_hi; }
    if (tid < 16) ((LAS unsigned*)(L + LDS_BAR_OFF))[tid] = 0u;
    __syncthreads();
    XcdBarrier xbar; { ARGP(A1); xbar = xcd_barrier_post((unsigned*)A1->ws, (volatile LAS unsigned*)(L + LDS_BAR_OFF), tid); }
    if (lo > 1000) grid.sync();
#ifdef DBG_ONLY
#define IN(k) ((k) == DBG_ONLY)
#else
#define IN(k) (lo <= (k) && (k) < hi)
#endif
#ifndef PROBE_MASK
#define PROBE_MASK 0
#endif
#if PROBE_MASK
    unsigned long long pr_prev = __builtin_amdgcn_s_memrealtime(), pr_acc = 0ull;
#define SEAM(k) do { if (IN(k) && IN((k) + 1)) xcd_barrier(xbar, tid); { const unsigned long long t_ = __builtin_amdgcn_s_memrealtime(); if ((PROBE_MASK >> (k)) & 1) pr_acc += t_ - pr_prev; pr_prev = t_; } } while (0)
#else
#define SEAM(k) do { if (IN(k) && IN((k) + 1)) xcd_barrier(xbar, tid); } while (0)
#endif

    if (IN(0)) { ARGP(A);
        LAS float* scr = (LAS float*)(L + wave * 16384);
        constexpr int I_IN = 16 * 209, I_OUT = 32 * 32, I_GATE = 16 * 32, I_PROJ = 4 * 32, NITEMS = I_IN + I_OUT + I_GATE + I_PROJ;
        for (int it = gw; it < NITEMS; it += NGW) {
            int r = it;
            if (r < I_IN) { p0_transpose_item<true>(A->in[3], 1024, NINR, Win_t, scr, r, lane); continue; } r -= I_IN;
            if (r < I_OUT) { p0_transpose_item<false>(A->in[12], 2048, 1024, Wout_t, scr, r, lane); continue; } r -= I_OUT;
            if (r < I_GATE) { p0_transpose_item<false>(A->in[14], 1024, 1024, Wgate_t, scr, r, lane); continue; } r -= I_GATE;
            p0_transpose_item<false>(A->in[15], 256, 1024, Wproj_t, scr, r, lane);
        }
        { v4u* z = (v4u*)(Win_t + (size_t)NINR * 1024); const int nz = (NINP - NINR) * 1024 * 2 / 16;
          for (int i = bx * 512 + tid; i < nz; i += G * 512) z[i] = (v4u){0u, 0u, 0u, 0u}; }
        for (int m = gw; m + 3 * NGW < M; m += 4 * NGW) rms_rows_to_bf16<4>(A->in[0], A->in[2], U, (size_t)m, (size_t)NGW, lane);
    }
    SEAM(0);
    if (IN(1)) { ARGP(A);
        pg8::Gemm g{U, Win_t, M, NINP, 1024, 1024, 1 << 30, 0}; pg8::StaticOrder S; S.init(M, NINP, G, bx);
        pg8::EpiIn E{ZS, XBC, ZA, Qb, Kb, Vb, DTF, attn_body::C2};
        pg8::gemm_phase<pg8::EpiIn, pg8::StaticOrder, true, true>(L, g, S, E, tid);
    }
    SEAM(1);
    if (IN(2)) { ARGP(A);
        for (int it = bx; it < 800; it += G) {
            if (it < 768) ssd::pre_item(it, XBC, DTF, A->in[4], A->in[5], A->in[6], A->in[7], XDTT, Bn, BT, Cn, ACS, DTb, L, tid);
            else ssd::fb_item(it - 768, DTF, A->in[10], FB, L, tid);
        }
    }
    SEAM(2);
    if (IN(3)) { ARGP(A); for (int it = bx; it < 256; it += G) ssd::state_item(it, XDTT, BT, ACS, Sst, L, tid); }
    SEAM(3);
    if (IN(4)) { ARGP(A);
        for (int gt = bx * 512 + tid; gt < 131072; gt += G * 512) ssd::scan_pair(gt, Sst, ACS);
        __syncthreads();
        const attn_body::AttnTensors AT{(const attn_body::bf16*)Qb, (const attn_body::bf16*)Kb, (const attn_body::bf16*)Vb, (attn_body::bf16*)ZA, FB, (const attn_body::bf16*)ZA, A->in[11]};
        const attn_body::StaticOrder S(G, bx);
        attn_body::attn_phase<attn_body::StaticOrder>((char*)lds, AT, S, tid);
    }
    SEAM(4);
    if (IN(5)) { ARGP(A);
        for (int it = bx; it < 256; it += G) ssd::out_item(it, XDTT, Bn, Cn, ACS, DTb, Sst, ZS, ZS, A->in[8], A->in[9], L, tid);
        { const f32x4* ps = (const f32x4*)A->in[1]; unsigned long long* pd = (unsigned long long*)PB; const int n4 = M * PLE / 4;
          for (int i = bx * 512 + tid; i < n4; i += G * 512) { const f32x4 v = ps[i]; pd[i] = (unsigned long long)pk2(v.x, v.y) | ((unsigned long long)pk2(v.z, v.w) << 32); } }
    }
    SEAM(5);
    if (IN(6)) { ARGP(A);
        { pg8::Gemm g{ZS, Wout_t, M, 1024, 2048, 1024, 16, (long)(WS_ZA - WS_ZS) - 2048}; pg8::StaticOrder S; S.init(M, 1024, G, bx);
          pg8::EpiRes E{A->in[0], ((float*)os), 1024};
          pg8::gemm_phase<pg8::EpiRes, pg8::StaticOrder, true, true>(L, g, S, E, tid); }
        { pg8::Gemm g{PB, Wproj_t, M, 1024, 256, 256, 1 << 30, 0}; pg8::StaticOrder S; S.init(M, 1024, G, bx);
          pg8::EpiBf16<0> E{PP, 1024, nullptr, 0, 0, 1.f};
          pg8::gemm_phase<pg8::EpiBf16<0>, pg8::StaticOrder, true, true>(L, g, S, E, tid); }
    }
    SEAM(6);
    if (IN(7)) { ARGP(A); for (int m = gw; m + 3 * NGW < M; m += 4 * NGW) rms_rows_to_bf16<4>(((float*)os), A->in[13], HN, (size_t)m, (size_t)NGW, lane); }
    SEAM(7);
    if (IN(8)) { ARGP(A);
        pg8::Gemm g{HN, Wgate_t, M, 1024, 1024, 1024, 1 << 30, 0}; pg8::StaticOrder S; S.init(M, 1024, G, bx);
        pg8::EpiGate E{((float*)os), PP, 1024};
        pg8::gemm_phase<pg8::EpiGate, pg8::StaticOrder, true, true>(L, g, S, E, tid);
    }
    SEAM(8);
    if (IN(9)) { ARGP(A); for (int m = gw; m + 3 * NGW < M; m += 4 * NGW) rms_rows_inplace<4>(((float*)os), A->in[16], (size_t)m, (size_t)NGW, lane); }
#if PROBE_MASK
    { __syncthreads(); const unsigned long long t_ = __builtin_amdgcn_s_memrealtime(); if ((PROBE_MASK >> 9) & 1) pr_acc += t_ - pr_prev;
      if (bx == 0) { while (__builtin_amdgcn_s_memrealtime() - t_ < pr_acc) __builtin_amdgcn_s_sleep(8); } }
#endif
#undef IN
#undef SEAM
#undef tid
#undef lane
#undef wave
#undef G
#undef bx
#undef gw
#undef NGW
}

extern "C" void kernel_launch(void* const* d_in, const int* in_sizes, int n_in, void* d_out, int out_size, void* d_ws, size_t ws_size, hipStream_t stream) {
    static int grid = 0;
    if (grid == 0) {
        if (n_in != 17 || out_size != M * DM || ws_size < WS_END) { fprintf(stderr, "kernel_launch: unexpected shapes (n_in %d out %d ws %zu)\n", n_in, out_size, ws_size); grid = -1; return; }
        int dev = 0, cus = 0, per_cu = 0;
        hipGetDevice(&dev); hipDeviceGetAttribute(&cus, hipDeviceAttributeMultiprocessorCount, dev);
        if (hipFuncSetAttribute((const void*)mega_fwd, hipFuncAttributeMaxDynamicSharedMemorySize, LDS_BYTES) != hipSuccess) { fprintf(stderr, "kernel_launch: hipFuncSetAttribute failed\n"); grid = -1; return; }
        hipOccupancyMaxActiveBlocksPerMultiprocessor(&per_cu, (const void*)mega_fwd, NWAVES * 64, LDS_BYTES);
        (void)hipGetLastError();
        grid = 256;
        if (cus * per_cu < grid) { fprintf(stderr, "kernel_launch: device cannot hold 256 co-resident workgroups (cus %d per_cu %d)\n", cus, per_cu); grid = -1; return; }
    }
    if (grid < 0) return;
    if (hipMemsetAsync(d_ws, 0, CTL_ZERO_BYTES, stream) != hipSuccess) { fprintf(stderr, "kernel_launch: memset failed\n"); return; }
    Args a{};
    for (int i = 0; i < 17; ++i) a.in[i] = (const float*)d_in[i];
    a.out = (float*)d_out; a.ws = (unsigned char*)d_ws;
#if MK_SPLIT
    for (int ph = 0; ph < 10; ++ph) { a.ph_lo = ph; a.ph_hi = ph + 1; void* kargs[] = {&a};
        hipLaunchCooperativeKernel((const void*)mega_fwd, dim3(grid), dim3(NWAVES * 64), kargs, LDS_BYTES, stream); }
#else
    a.ph_lo = 0; a.ph_hi = 10; void* kargs[] = {&a};
    hipError_t e = hipLaunchCooperativeKernel((const void*)mega_fwd, dim3(grid), dim3(NWAVES * 64), kargs, LDS_BYTES, stream);
    if (e != hipSuccess) fprintf(stderr, "cooperative launch failed: %s\n", hipGetErrorString(e));
#endif
}
```

```cpp
#include <hip/hip_runtime.h>
#include <cstdio>
#include <cstdint>
namespace pg8 {
#define PG8_LAS __attribute__((address_space(3)))
typedef unsigned short bf16_t;
typedef short bf16x8 __attribute__((ext_vector_type(8)));
typedef float f32x4 __attribute__((ext_vector_type(4)));
typedef unsigned u32x4 __attribute__((ext_vector_type(4)));
constexpr int BM = 256, BK = 64, HALF = 128, HTB = HALF * BK * 2  , STAGE_BYTES = 8 * HTB, NXCD = 8, WGM = 8;

__host__ __device__ __forceinline__ int lds_byte(int r, int c) { const int st = (r >> 4) * 2 + (c >> 5), rr = r & 15, cc = c & 31, ob = rr * 64 + cc * 2; return st * 1024 + (ob ^ (((ob >> 9) & 1) << 5)); }
__host__ __device__ __forceinline__ void stage_rc(int b, int& R, int& C) { const int st = b / 1024, sb = b % 1024, swz = sb ^ (((sb >> 9) & 1) << 5); R = (st >> 1) * 16 + swz / 64; C = (st & 1) * 32 + (swz % 64) / 2; }
__host__ __device__ __forceinline__ int perm32(int rho) { const int n = rho >> 4, i = rho & 15; return 8 * (i >> 2) + 4 * n + (i & 3); }

struct Unit { int pm, pn; };
struct Gemm { const bf16_t* A; const bf16_t* Bt; int M, N, K; int lda; int ksplit; long asadj; };

struct StaticOrder {
    int nM, nN, nwg, G, c;
    __host__ __device__ void init(int M, int N, int G_, int c_) { nM = M / BM; nN = N / BM; nwg = nM * nN; G = G_; c = c_; }
    __host__ __device__ bool next(int i, Unit& u) const {
        const long L = (long)i * G + c; if (L >= nwg) return false;
        int wgid = (int)L; { const int q = nwg / NXCD, r = nwg % NXCD, xcd = wgid % NXCD, off = wgid / NXCD; wgid = (xcd < r ? xcd * (q + 1) : r * (q + 1) + (xcd - r) * q) + off; }
        const int nig = WGM * nN, gid = wgid / nig, fm = gid * WGM, gsz = (nM - fm) < WGM ? (nM - fm) : WGM;
        u.pm = fm + ((wgid % nig) % gsz); u.pn = (wgid % nig) / gsz; return true;
    }
    __device__ __forceinline__ void a_ready(const Unit&) const {}
    __device__ __forceinline__ void done(const Unit&) const {}
};

__device__ __forceinline__ unsigned cvt_pk_bf16(float lo, float hi) { unsigned r; asm volatile("v_cvt_pk_bf16_f32 %0, %1, %2" : "=v"(r) : "v"(lo), "v"(hi)); return r; }
typedef float f32x2 __attribute__((ext_vector_type(2)));
__device__ __forceinline__ f32x2 gelu_pk(f32x2 v) {
    const f32x2 av = __builtin_elementwise_abs(v), d = av * 0.2316418882f + 1.0f;
    f32x2 t; t.x = __builtin_amdgcn_rcpf(d.x); t.y = __builtin_amdgcn_rcpf(d.y);
    f32x2 q = t * 0.5307027145f + (-0.7265760135f); q = q * t + 0.7107068705f; q = q * t + (-0.142248368f); q = q * t + 0.127414796f; q = q * t;
    const f32x2 s = (v * v) * (-0.72134752044f);
    f32x2 e; e.x = __builtin_amdgcn_exp2f(s.x); e.y = __builtin_amdgcn_exp2f(s.y);
    const f32x2 m = v * (q * e), r = v - m;
    f32x2 o; o.x = v.x < 0.f ? m.x : r.x; o.y = v.y < 0.f ? m.y : r.y; return o;
}

template <int ACT  > struct EpiBf16 {
    static constexpr bool PERM = true, AFTER_DRAIN = false; static_assert(ACT == 0 || ACT == 1, "EpiBf16: ACT is 0 (none) or 1 (gelu_pk)");
    bf16_t* O; int ldc; const float* bias; int split_cols; size_t split_stride; float scale0;
    __device__ __forceinline__ void operator()(const f32x4 (&acc)[2][2][4][2], const Unit& u, int wr, int wc, int fr, int fq) const {
        const int row0 = u.pm * BM + wr * 64 + fr; int colt = u.pn * BM; bf16_t* base = O;
        float sc = 1.f; if (split_cols) { const int t = colt / split_cols; base += (size_t)t * split_stride; colt -= t * split_cols; if (t == 0) sc = scale0; }
        const int col0 = colt + wc * 32 + 8 * fq, bcol0 = u.pn * BM + wc * 32 + 8 * fq;
        f32x4 bv[2][2];
#pragma unroll
        for (int bj = 0; bj < 2; ++bj)
#pragma unroll
            for (int n = 0; n < 2; ++n) bv[bj][n] = bias ? *(const f32x4*)(bias + bcol0 + bj * HALF + 4 * n) : (f32x4){0.f, 0.f, 0.f, 0.f};
#pragma unroll
        for (int ai = 0; ai < 2; ++ai)
#pragma unroll
            for (int m = 0; m < 4; ++m) { bf16_t* rowp = base + (size_t)(row0 + ai * HALF + m * 16) * ldc + col0;
#pragma unroll
                for (int bj = 0; bj < 2; ++bj) { f32x4 v0 = acc[ai][bj][m][0] + bv[bj][0], v1 = acc[ai][bj][m][1] + bv[bj][1];
                    if (ACT == 1) { f32x2 a = gelu_pk((f32x2){v0[0], v0[1]}), b = gelu_pk((f32x2){v0[2], v0[3]}), c = gelu_pk((f32x2){v1[0], v1[1]}), d = gelu_pk((f32x2){v1[2], v1[3]});
                        v0 = (f32x4){a.x, a.y, b.x, b.y}; v1 = (f32x4){c.x, c.y, d.x, d.y}; }
                    v0 = v0 * sc; v1 = v1 * sc; u32x4 w; w.x = cvt_pk_bf16(v0[0], v0[1]); w.y = cvt_pk_bf16(v0[2], v0[3]); w.z = cvt_pk_bf16(v1[0], v1[1]); w.w = cvt_pk_bf16(v1[2], v1[3]);
                    *(u32x4*)(rowp + bj * HALF) = w; } }
    }
};

struct PanelStats {
    unsigned* xbuf;
    unsigned* cnt;
    unsigned* tmo;
    int ntn; float eps;
    unsigned code;
    __device__ __forceinline__ bool run(const f32x4 (&v)[2][2][4][2], const Unit& u, int wr, int wc, int fr, int fq, PG8_LAS unsigned char* lds, int wid, int lane) const {
        typedef float f32x2v __attribute__((ext_vector_type(2)));
        PG8_LAS f32x2v* P = (PG8_LAS f32x2v*)lds;
        PG8_LAS f32x2v* S = (PG8_LAS f32x2v*)(lds + 8192);
        PG8_LAS unsigned* flag = (PG8_LAS unsigned*)(lds + 8192 + 2048);
#pragma unroll
        for (int ai = 0; ai < 2; ++ai)
#pragma unroll
            for (int m = 0; m < 4; ++m) {
                float s = 0.f;
#pragma unroll
                for (int bj = 0; bj < 2; ++bj)
#pragma unroll
                    for (int n = 0; n < 2; ++n) { const f32x4 x = v[ai][bj][m][n]; s += (x[0] + x[1]) + (x[2] + x[3]); }
                s += __shfl_xor(s, 16); s += __shfl_xor(s, 32);
                const float mw = s * (1.0f / 64.0f); float q = 0.f;
#pragma unroll
                for (int bj = 0; bj < 2; ++bj)
#pragma unroll
                    for (int n = 0; n < 2; ++n) { const f32x4 d = v[ai][bj][m][n] - mw; q += (d[0] * d[0] + d[1] * d[1]) + (d[2] * d[2] + d[3] * d[3]); }
                q += __shfl_xor(q, 16); q += __shfl_xor(q, 32);
                if (fq == 0) P[(ai * HALF + wr * 64 + m * 16 + fr) * 4 + wc] = (f32x2v){mw, q};
            }
        asm volatile("s_waitcnt lgkmcnt(0)" ::: "memory"); __builtin_amdgcn_s_barrier(); asm volatile("" ::: "memory");
#if defined(BROKEN_EXCHANGE_NO_WAIT)
#warning BROKEN CONTROL BUILD: the row-statistics exchange does not wait; results are wrong by design
        if (blockIdx.x >= 64) { const long long t0_ = clock64(); while (clock64() - t0_ < 60000) __builtin_amdgcn_s_sleep(8); }
#endif
        const int row = wid * 32 + (lane & 31);
        if (lane < 32) {
            const f32x2v a = P[row * 4 + 0], b = P[row * 4 + 1], c = P[row * 4 + 2], d = P[row * 4 + 3];
            const float mt = (a.x + b.x + c.x + d.x) * 0.25f;
            const float da = a.x - mt, db = b.x - mt, dc = c.x - mt, dd = d.x - mt;
            const float m2 = (a.y + b.y) + (c.y + d.y) + 64.0f * ((da * da + db * db) + (dc * dc + dd * dd));
            unsigned long long* slot = (unsigned long long*)xbuf + ((size_t)(u.pm * BM + row) * 4 + u.pn);
            __hip_atomic_store(slot, ((unsigned long long)__float_as_uint(m2) << 32) | __float_as_uint(mt), __ATOMIC_RELAXED, __HIP_MEMORY_SCOPE_AGENT);
        }
        asm volatile("s_waitcnt vmcnt(0)" ::: "memory");
        if (lane == 0) __hip_atomic_fetch_add(cnt + 64 * u.pm, 1u, __ATOMIC_RELAXED, __HIP_MEMORY_SCOPE_AGENT);
        if (wid == 0) {
            bool dead = false; const unsigned long long t0 = __builtin_amdgcn_s_memrealtime(); const unsigned want = 8u * (unsigned)ntn;
            for (;;) {
#if defined(BROKEN_EXCHANGE_NO_WAIT)
                break;
#endif
                if ((unsigned)__builtin_amdgcn_readfirstlane(__hip_atomic_load(cnt + 64 * u.pm, __ATOMIC_RELAXED, __HIP_MEMORY_SCOPE_AGENT)) >= want) break;
                if (__builtin_amdgcn_s_memrealtime() - t0 > 2000000ull) {
                    if (lane == 0) { unsigned expect = 0u; __hip_atomic_compare_exchange_strong(tmo + 1, &expect, code | (unsigned)(u.pm & 0xff), __ATOMIC_RELAXED, __ATOMIC_RELAXED, __HIP_MEMORY_SCOPE_AGENT);
                                     __hip_atomic_store(tmo, 1u, __ATOMIC_RELAXED, __HIP_MEMORY_SCOPE_AGENT); }
                    dead = true; break; }
                __builtin_amdgcn_s_sleep(2);
            }
            __builtin_amdgcn_fence(__ATOMIC_ACQUIRE, "agent");
            if (lane == 0) flag[0] = dead ? 1u : 0u;
        }
        asm volatile("s_waitcnt vmcnt(0) lgkmcnt(0)" ::: "memory"); __builtin_amdgcn_s_barrier(); asm volatile("" ::: "memory");
        const bool bad = flag[0] != 0u;
        if (lane < 32) {
            const unsigned long long* slot = (const unsigned long long*)xbuf + (size_t)(u.pm * BM + row) * 4; float mt[4], m2[4]; float ms = 0.f;
#pragma unroll
            for (int t = 0; t < 4; ++t) { if (t < ntn) { const unsigned long long w = __hip_atomic_load(slot + t, __ATOMIC_RELAXED, __HIP_MEMORY_SCOPE_AGENT); mt[t] = __uint_as_float((unsigned)w); m2[t] = __uint_as_float((unsigned)(w >> 32)); } else { mt[t] = 0.f; m2[t] = 0.f; } ms += mt[t]; }
            const float mean = ms / (float)ntn; float q = 0.f;
#pragma unroll
            for (int t = 0; t < 4; ++t) if (t < ntn) { const float dm = mt[t] - mean; q += m2[t] + 256.0f * dm * dm; }
            S[row] = (f32x2v){mean, 1.0f / sqrtf(q / (256.0f * (float)ntn) + eps)};
        }
        asm volatile("s_waitcnt lgkmcnt(0)" ::: "memory"); __builtin_amdgcn_s_barrier(); asm volatile("" ::: "memory");
        return bad;
    }
};
struct EpiLnRes {
    static constexpr bool PERM = false, AFTER_DRAIN = true;
    const float* base; float* out; int ldc; const float* bias; PanelStats st; unsigned poison;
    __device__ __forceinline__ void fused(f32x4 (&acc)[2][2][4][2], const Unit& u, int wr, int wc, int fr, int fq, PG8_LAS unsigned char* lds, int wid, int lane) const {
        typedef float f32x2v __attribute__((ext_vector_type(2)));
        const PG8_LAS f32x2v* S = (const PG8_LAS f32x2v*)(lds + 8192);
        const int col0 = u.pn * BM + wc * 32 + 4 * fq;
#pragma unroll
        for (int bj = 0; bj < 2; ++bj)
#pragma unroll
            for (int n = 0; n < 2; ++n) { const f32x4 bv = bias ? *(const f32x4*)(bias + col0 + bj * HALF + n * 16) : (f32x4){0.f, 0.f, 0.f, 0.f};
#pragma unroll
                for (int ai = 0; ai < 2; ++ai)
#pragma unroll
                    for (int m = 0; m < 4; ++m) acc[ai][bj][m][n] += bv; }
        f32x4 pre[4][2][2];
#pragma unroll
        for (int m = 0; m < 4; ++m) { const size_t off = (size_t)(u.pm * BM + wr * 64 + m * 16 + fr) * ldc + col0;
#pragma unroll
            for (int bj = 0; bj < 2; ++bj)
#pragma unroll
                for (int n = 0; n < 2; ++n) pre[m][bj][n] = *(const f32x4*)(base + off + bj * HALF + n * 16); }
        const bool bad = st.run(acc, u, wr, wc, fr, fq, lds, wid, lane) || poison != 0u;
        const float qnan = __builtin_nanf("");
#pragma unroll
        for (int ai = 0; ai < 2; ++ai)
#pragma unroll
            for (int m = 0; m < 4; ++m) { const int r = ai * HALF + wr * 64 + m * 16 + fr; const f32x2v sr = S[r]; const size_t off = (size_t)(u.pm * BM + r) * ldc + col0;
#pragma unroll
                for (int bj = 0; bj < 2; ++bj)
#pragma unroll
                    for (int n = 0; n < 2; ++n) { const f32x4 bs = ai == 0 ? pre[m][bj][n] : *(const f32x4*)(base + off + bj * HALF + n * 16); f32x4 o = bs + (acc[ai][bj][m][n] - sr.x) * sr.y;
                        if (bad) o = (f32x4){qnan, qnan, qnan, qnan}; *(f32x4*)(out + off + bj * HALF + n * 16) = o; }
                if (m & 1) asm volatile("" ::: "memory"); }
    }
};
struct EpiLnResLn {
    static constexpr bool PERM = false, AFTER_DRAIN = true;
    const float* base; float* out; bf16_t* xn; int ldc; const float* bias; PanelStats st1, st2; unsigned poison;
    __device__ __forceinline__ void fused(f32x4 (&acc)[2][2][4][2], const Unit& u, int wr, int wc, int fr, int fq, PG8_LAS unsigned char* lds, int wid, int lane) const {
        typedef float f32x2v __attribute__((ext_vector_type(2))); typedef unsigned u32x2v __attribute__((ext_vector_type(2)));
        const PG8_LAS f32x2v* S = (const PG8_LAS f32x2v*)(lds + 8192);
        const int col0 = u.pn * BM + wc * 32 + 4 * fq;
#pragma unroll
        for (int bj = 0; bj < 2; ++bj)
#pragma unroll
            for (int n = 0; n < 2; ++n) { const f32x4 bv = bias ? *(const f32x4*)(bias + col0 + bj * HALF + n * 16) : (f32x4){0.f, 0.f, 0.f, 0.f};
#pragma unroll
                for (int ai = 0; ai < 2; ++ai)
#pragma unroll
                    for (int m = 0; m < 4; ++m) acc[ai][bj][m][n] += bv; }
        bool bad = st1.run(acc, u, wr, wc, fr, fq, lds, wid, lane) || poison != 0u;
        const float qnan = __builtin_nanf("");
#pragma unroll
        for (int ai = 0; ai < 2; ++ai)
#pragma unroll
            for (int m = 0; m < 4; ++m) { const int r = ai * HALF + wr * 64 + m * 16 + fr; const f32x2v sr = S[r]; const size_t off = (size_t)(u.pm * BM + r) * ldc + col0;
#pragma unroll
                for (int bj = 0; bj < 2; ++bj)
#pragma unroll
                    for (int n = 0; n < 2; ++n) { const f32x4 bs = *(const f32x4*)(base + off + bj * HALF + n * 16); acc[ai][bj][m][n] = bs + (acc[ai][bj][m][n] - sr.x) * sr.y; }
                asm volatile("" : "+v"(acc[ai][0][m][0]), "+v"(acc[ai][0][m][1]), "+v"(acc[ai][1][m][0]), "+v"(acc[ai][1][m][1]));
                if (m & 1) asm volatile("" ::: "memory"); }
        const bool bad1 = bad;
        bad = st2.run(acc, u, wr, wc, fr, fq, lds, wid, lane) || bad;
#pragma unroll
        for (int ai = 0; ai < 2; ++ai)
#pragma unroll
            for (int m = 0; m < 4; ++m) { const int r = ai * HALF + wr * 64 + m * 16 + fr; const f32x2v sr = S[r]; const size_t off = (size_t)(u.pm * BM + r) * ldc + col0;
#pragma unroll
                for (int bj = 0; bj < 2; ++bj)
#pragma unroll
                    for (int n = 0; n < 2; ++n) { const f32x4 x1 = acc[ai][bj][m][n]; *(f32x4*)(out + off + bj * HALF + n * 16) = bad1 ? (f32x4){qnan, qnan, qnan, qnan} : x1;
                        const f32x4 o = (x1 - sr.x) * sr.y; u32x2v w; w.x = cvt_pk_bf16(o[0], o[1]); w.y = cvt_pk_bf16(o[2], o[3]);
                        if (bad) { w.x = 0x7fc07fc0u; w.y = 0x7fc07fc0u; } *(u32x2v*)(xn + off + bj * HALF + n * 16) = w; }
                asm volatile("" ::: "memory"); }
    }
};

template <class Epi, class Sched, bool ALIGN_EPI = false, bool SP2 = false>
__device__ __forceinline__ void gemm_phase(PG8_LAS unsigned char* lds, const Gemm g, const Sched& S, const Epi& E, const int tidx) {
    static_assert(SP2, "only the SP2 loop carries the lda / split-A changes");
    const int tid = tidx, wid = __builtin_amdgcn_readfirstlane(tid >> 6), lane = tid & 63, wr = wid >> 2, wc = wid & 3, fr = lane & 15, fq = lane >> 4;
    const int K = g.K, nt = K / BK;
    unsigned voffA[2], voffB[2];
#pragma unroll
    for (int i = 0; i < 2; ++i) { int R, C; stage_rc(tid * 16 + i * 8192, R, C); const int Rb = Epi::PERM ? ((R & ~31) + perm32(R & 31)) : R;
        voffA[i] = (unsigned)(R * g.lda + C) * 2u; voffB[i] = (unsigned)(Rb * K + C) * 2u; }
    const size_t kstep = (size_t)(BK * 2);
    const size_t hstep = (size_t)HALF * K * 2, hstepA = (size_t)HALF * g.lda * 2;
    const size_t tstep = 2 * hstep, tstepA = 2 * hstepA; const int ksplit = g.ksplit; const long asadj = g.asadj;
    const unsigned ldsw = (unsigned)wid * 1024u;
    const int aoff = lds_byte(wr * 64 + fr, fq * 8), boff = lds_byte(wc * 32 + fr, fq * 8);
#define PG8_SA(b, h) (((b) * 2 + (h)) * HTB)
#define PG8_SB(b, h) ((4 + (b) * 2 + (h)) * HTB)
#define PG8_STAGE(bufoff, gbase, voff) do { _Pragma("unroll") for (int _i = 0; _i < 2; ++_i) \
        __builtin_amdgcn_global_load_lds((const unsigned*)((const char*)(gbase) + (voff)[_i]), (PG8_LAS unsigned*)(lds + (bufoff) + ldsw + _i * 8192), 16, 0, 0); } while (0)
#define PG8_LDA(dst, b, h) do { _Pragma("unroll") for (int m = 0; m < 4; ++m) _Pragma("unroll") for (int k = 0; k < 2; ++k) dst[m][k] = *(const PG8_LAS bf16x8*)(lds + PG8_SA(b, h) + aoff + m * 2048 + k * 1024); } while (0)
#define PG8_LDB(dst, b, h) do { _Pragma("unroll") for (int n = 0; n < 2; ++n) _Pragma("unroll") for (int k = 0; k < 2; ++k) dst[n][k] = *(const PG8_LAS bf16x8*)(lds + PG8_SB(b, h) + boff + n * 2048 + k * 1024); } while (0)
#define PG8_MMA(ai, bj, At, Bt) do { __builtin_amdgcn_s_setprio(1); _Pragma("unroll") for (int m = 0; m < 4; ++m) _Pragma("unroll") for (int n = 0; n < 2; ++n) _Pragma("unroll") for (int k = 0; k < 2; ++k) \
        acc[ai][bj][m][n] = __builtin_amdgcn_mfma_f32_16x16x32_bf16(Bt[n][k], At[m][k], acc[ai][bj][m][n], 0, 0, 0); __builtin_amdgcn_s_setprio(0); } while (0)
#define PG8_WAIT_V(n) asm volatile("s_waitcnt vmcnt(" #n ")" ::: "memory")
#define PG8_WAIT_L(n) asm volatile("s_waitcnt lgkmcnt(" #n ")" ::: "memory")
#define PG8_BAR __builtin_amdgcn_s_barrier()
#define PG8_SCHED __builtin_amdgcn_sched_barrier(0)
    Unit cur, nxt; int ui = 0;
    if (!S.next(0, cur)) return;
    f32x4 acc[2][2][4][2];
#pragma unroll
    for (int a = 0; a < 2; ++a)
#pragma unroll
        for (int b = 0; b < 2; ++b)
#pragma unroll
            for (int m = 0; m < 4; ++m)
#pragma unroll
                for (int n = 0; n < 2; ++n) acc[a][b][m][n] = (f32x4){0.f, 0.f, 0.f, 0.f};
    bf16x8 At[4][2], B0[2][2], B1[2][2];
    const char* cA = (const char*)g.A + (size_t)cur.pm * tstepA; const char* cB = (const char*)g.Bt + (size_t)cur.pn * tstep;
    S.a_ready(cur);
    if constexpr (SP2) {
        PG8_STAGE(PG8_SB(0, 0), cB, voffB); PG8_STAGE(PG8_SB(0, 1), cB + hstep, voffB); PG8_STAGE(PG8_SA(0, 0), cA, voffA); PG8_STAGE(PG8_SA(0, 1), cA + hstepA, voffA);
        if (wr == 1) PG8_BAR;
        PG8_WAIT_V(2); PG8_BAR;
        PG8_STAGE(PG8_SB(1, 0), cB + kstep, voffB); PG8_STAGE(PG8_SA(1, 0), cA + kstep, voffA); PG8_STAGE(PG8_SB(1, 1), cB + hstep + kstep, voffB);
        PG8_WAIT_V(6); PG8_BAR;
    } else {
        PG8_STAGE(PG8_SB(0, 0), cB, voffB); PG8_STAGE(PG8_SA(0, 0), cA, voffA); PG8_STAGE(PG8_SB(0, 1), cB + hstep, voffB); PG8_STAGE(PG8_SA(0, 1), cA + hstep, voffA);
        if (wr == 1) PG8_BAR;
        PG8_WAIT_V(4); PG8_BAR;
        PG8_STAGE(PG8_SB(1, 0), cB + kstep, voffB); PG8_STAGE(PG8_SA(1, 0), cA + kstep, voffA); PG8_STAGE(PG8_SB(1, 1), cB + hstep + kstep, voffB);
        PG8_WAIT_V(6); PG8_BAR;
    }
    for (;;) {
        const bool has_next = S.next(ui + 1, nxt);
        const char* nA = has_next ? (const char*)g.A + (size_t)nxt.pm * tstepA : cA; const char* nB = has_next ? (const char*)g.Bt + (size_t)nxt.pn * tstep : cB;
        for (int t = 0; t < nt; t += 2) {
            const bool last = (t == nt - 2);
            const char* a1 = cA + (size_t)(t + 1) * kstep + ((t + 1) >= ksplit ? asadj : 0);
            const char* a2 = last ? nA : cA + (size_t)(t + 2) * kstep + ((t + 2) >= ksplit ? asadj : 0); const char* b2 = last ? nB : cB + (size_t)(t + 2) * kstep;
            const char* a3 = a2 + kstep; const char* b3 = b2 + kstep;
            if (last && has_next) S.a_ready(nxt);
            if constexpr (SP2) {
            PG8_LDB(B0, 0, 0); PG8_LDB(B1, 0, 1); PG8_SCHED; PG8_LDA(At, 0, 0); PG8_STAGE(PG8_SA(1, 1), a1 + hstepA, voffA);
            PG8_WAIT_V(8); PG8_WAIT_L(0); PG8_BAR; PG8_MMA(0, 0, At, B0); PG8_MMA(0, 1, At, B1); PG8_BAR; PG8_SCHED;
            PG8_LDA(At, 0, 1); PG8_STAGE(PG8_SB(0, 0), b2, voffB); PG8_STAGE(PG8_SB(0, 1), b2 + hstep, voffB); PG8_STAGE(PG8_SA(0, 0), a2, voffA);
            PG8_WAIT_V(8); PG8_WAIT_L(0); PG8_BAR; PG8_MMA(1, 0, At, B0); PG8_MMA(1, 1, At, B1); PG8_BAR; PG8_SCHED;
            PG8_LDB(B0, 1, 0); PG8_LDB(B1, 1, 1); PG8_SCHED; PG8_LDA(At, 1, 0); PG8_STAGE(PG8_SA(0, 1), a2 + hstepA, voffA);
            PG8_WAIT_V(8); PG8_WAIT_L(0); PG8_BAR; PG8_MMA(0, 0, At, B0); PG8_MMA(0, 1, At, B1); PG8_BAR; PG8_SCHED;
            PG8_LDA(At, 1, 1); PG8_STAGE(PG8_SB(1, 0), b3, voffB); PG8_STAGE(PG8_SB(1, 1), b3 + hstep, voffB); PG8_STAGE(PG8_SA(1, 0), a3, voffA);
            PG8_WAIT_V(8); PG8_WAIT_L(0); PG8_BAR; PG8_MMA(1, 0, At, B0); PG8_MMA(1, 1, At, B1); PG8_BAR; PG8_SCHED;
            } else {
            PG8_LDB(B0, 0, 0); PG8_SCHED; PG8_LDA(At, 0, 0); PG8_STAGE(PG8_SA(1, 1), a1 + hstep, voffA);
            PG8_WAIT_L(8); PG8_BAR; PG8_WAIT_L(0); PG8_MMA(0, 0, At, B0); PG8_BAR; PG8_SCHED;
            PG8_LDB(B1, 0, 1); PG8_STAGE(PG8_SB(0, 0), b2, voffB);
            PG8_BAR; PG8_WAIT_L(0); PG8_MMA(0, 1, At, B1); PG8_BAR;
            PG8_LDA(At, 0, 1); PG8_STAGE(PG8_SA(0, 0), a2, voffA);
            PG8_BAR; PG8_WAIT_L(0); PG8_MMA(1, 0, At, B0); PG8_BAR; PG8_SCHED;
            PG8_STAGE(PG8_SB(0, 1), b2 + hstep, voffB);
            PG8_WAIT_V(6); PG8_BAR; PG8_MMA(1, 1, At, B1); PG8_BAR;
            PG8_LDB(B0, 1, 0); PG8_SCHED; PG8_LDA(At, 1, 0); PG8_STAGE(PG8_SA(0, 1), a2 + hstep, voffA);
            PG8_WAIT_L(8); PG8_BAR; PG8_WAIT_L(0); PG8_MMA(0, 0, At, B0); PG8_BAR; PG8_SCHED;
            PG8_LDB(B1, 1, 1); PG8_STAGE(PG8_SB(1, 0), b3, voffB);
            PG8_BAR; PG8_WAIT_L(0); PG8_MMA(0, 1, At, B1); PG8_BAR;
            PG8_LDA(At, 1, 1); PG8_STAGE(PG8_SA(1, 0), a3, voffA);
            PG8_BAR; PG8_WAIT_L(0); PG8_MMA(1, 0, At, B0); PG8_BAR; PG8_SCHED;
            PG8_STAGE(PG8_SB(1, 1), b3 + hstep, voffB);
            PG8_WAIT_V(6); PG8_BAR; PG8_MMA(1, 1, At, B1); PG8_BAR;
            }
        }
        if constexpr (ALIGN_EPI) { if (wr == 0) PG8_BAR; }
        if constexpr (!Epi::AFTER_DRAIN) { E(acc, cur, wr, wc, fr, fq); S.done(cur); }
        if (!has_next) break;
#pragma unroll
        for (int a = 0; a < 2; ++a)
#pragma unroll
            for (int b = 0; b < 2; ++b)
#pragma unroll
                for (int m = 0; m < 4; ++m)
#pragma unroll
                    for (int n = 0; n < 2; ++n) acc[a][b][m][n] = (f32x4){0.f, 0.f, 0.f, 0.f};
        cur = nxt; cA = nA; cB = nB; ++ui;
        if constexpr (ALIGN_EPI) { if (wr == 1) PG8_BAR; }
    }
    PG8_WAIT_V(0);
    if constexpr (!ALIGN_EPI) { if (wr == 0) PG8_BAR; }
    PG8_BAR;
    if constexpr (Epi::AFTER_DRAIN) { E.fused(acc, cur, wr, wc, fr, fq, lds, wid, lane); S.done(cur); }
#undef PG8_SA
#undef PG8_SB
#undef PG8_STAGE
#undef PG8_LDA
#undef PG8_LDB
#undef PG8_MMA
#undef PG8_WAIT_V
#undef PG8_WAIT_L
#undef PG8_BAR
#undef PG8_SCHED
}
}

#ifndef PG8_SP2
#define PG8_SP2 true
#endif
#ifndef PG8_ALIGN
#define PG8_ALIGN true
#endif
#include <hip/hip_bf16.h>
#include <cmath>
namespace attn_body {
using bf16=__hip_bfloat16;
using bf16x8=__attribute__((ext_vector_type(8)))short;
using s16x4=__attribute__((ext_vector_type(4)))short;
using f32x16=__attribute__((ext_vector_type(16)))float;
using u32x4=__attribute__((ext_vector_type(4)))unsigned;
constexpr int BATCH=2,NHEAD=16,SEQ=8192,D=64,DM=NHEAD*D;
constexpr int NW=8,QBLK=32,QB=QBLK*NW,KVBLK=64,NQB=SEQ/QB;
constexpr int ATTN_PITCH=DM, ATTN_UNIT_ROWS=QB;
__device__ __forceinline__ int crow(int r,int hi){return (r&3)+8*(r>>2)+4*hi;}
#define SBAR() __builtin_amdgcn_sched_barrier(0)
__device__ __forceinline__ void cmask(f32x16&p0,f32x16&p1,int jb,int qrel,int hi){
  const float NEG=-INFINITY; int kb=64*jb+4*hi;
  #pragma unroll
  for(int r=0;r<16;++r){int kv=kb+(r&3)+8*(r>>2); if(kv>qrel)p0[r]=NEG; if(kv+32>qrel)p1[r]=NEG;}
}

constexpr int NSLOT=3, SLOTB=8192;
constexpr int LDS_K=0, LDS_V=NSLOT*SLOTB, LDS_WS=2*NSLOT*SLOTB, LDS_OST=LDS_WS+NW*64*4, LDS_BIAS=LDS_OST+NW*4096, LDS_CNT=LDS_BIAS+SEQ*4, LDS_QSLOT=LDS_CNT+32, LDS_BYTES=LDS_CNT+64;
constexpr float C2=0.125f*1.4426950408889634f;
__device__ __forceinline__ void glds16(const void*sbase,unsigned voff,unsigned lds_dst){unsigned keep;
  asm volatile("s_mov_b32 %0, m0\n\ts_mov_b32 m0, %2\n\ts_nop 0\n\tglobal_load_lds_dwordx4 %1, %3\n\ts_mov_b32 m0, %0":"=&s"(keep):"v"(voff),"s"(lds_dst),"s"(sbase):"memory");}
__device__ __forceinline__ float max3f(float a,float b,float c){float r;asm("v_max3_f32 %0, %1, %2, %3":"=v"(r):"v"(a),"v"(b),"v"(c));return r;}
__device__ __forceinline__ float max2f(float a,float b){float r;asm("v_max_f32_e32 %0, %1, %2":"=v"(r):"v"(a),"v"(b));return r;}
__device__ __forceinline__ float fadd_s(float a,float b){float r;asm("v_add_f32_e32 %0, %1, %2":"=v"(r):"v"(a),"v"(b));return r;}
__device__ __forceinline__ float fsub_s(float a,float b){float r;asm("v_sub_f32_e32 %0, %1, %2":"=v"(r):"v"(a),"v"(b));return r;}
typedef float f32x2_t __attribute__((ext_vector_type(2))); typedef __bf16 bf16x2_t __attribute__((ext_vector_type(2)));
__device__ __forceinline__ unsigned cvtpk_s(float lo,float hi){f32x2_t v={lo,hi};bf16x2_t b=__builtin_convertvector(v,bf16x2_t);return __builtin_bit_cast(unsigned,b);}
#define WAIT_BAR(N) asm volatile("s_waitcnt vmcnt(" #N ") lgkmcnt(0)\n\ts_barrier":::"memory")

__device__ __forceinline__ void qkt(f32x16&p0,f32x16&p1,const char*Kslot,const bf16x8*qr,int r32,int hi){
  const char*kb=Kslot+hi*1024+r32*16;
  #pragma unroll
  for(int d0=0;d0<4;++d0){
    const bf16x8 b0=*reinterpret_cast<const bf16x8*>(kb+d0*2048);
    const bf16x8 b1=*reinterpret_cast<const bf16x8*>(kb+d0*2048+512);
    {p0=__builtin_amdgcn_mfma_f32_32x32x16_bf16(b0,qr[d0],p0,0,0,0);p1=__builtin_amdgcn_mfma_f32_32x32x16_bf16(b1,qr[d0],p1,0,0,0);}}
}
typedef __attribute__((address_space(3))) const char* lds_cptr;
typedef short v4i16_t __attribute__((ext_vector_type(4)));
__device__ __forceinline__ void kload8(bf16x8*kf,lds_cptr kp){
  kf[0]=*(const __attribute__((address_space(3))) bf16x8*)(kp);      kf[1]=*(const __attribute__((address_space(3))) bf16x8*)(kp+512);
  kf[2]=*(const __attribute__((address_space(3))) bf16x8*)(kp+2048); kf[3]=*(const __attribute__((address_space(3))) bf16x8*)(kp+2560);
  kf[4]=*(const __attribute__((address_space(3))) bf16x8*)(kp+4096); kf[5]=*(const __attribute__((address_space(3))) bf16x8*)(kp+4608);
  kf[6]=*(const __attribute__((address_space(3))) bf16x8*)(kp+6144); kf[7]=*(const __attribute__((address_space(3))) bf16x8*)(kp+6656);
}
__device__ __forceinline__ void kload2(bf16x8*kf,lds_cptr kp,int j){ kf[2*j]=*(const __attribute__((address_space(3))) bf16x8*)(kp+j*2048); kf[2*j+1]=*(const __attribute__((address_space(3))) bf16x8*)(kp+j*2048+512); }
__device__ __forceinline__ s16x4 vtr(lds_cptr p){ return __builtin_bit_cast(s16x4,__builtin_amdgcn_ds_read_tr16_b64_v4i16((__attribute__((address_space(3))) v4i16_t*)p)); }
__device__ __forceinline__ float rowmax(const f32x16&p0,const f32x16&p1){
  float a=max3f(p0[0],p0[1],p1[0]),b=max3f(p0[2],p0[3],p1[1]);a=max3f(a,p1[2],p1[3]);
  #pragma unroll
  for(int r=4;r<16;r+=4){a=max3f(a,p0[r],p0[r+1]);b=max3f(b,p0[r+2],p0[r+3]);a=max3f(a,p1[r],p1[r+1]);b=max3f(b,p1[r+2],p1[r+3]);}
  const float m=max2f(a,b);
  auto rr=__builtin_amdgcn_permlane32_swap(__float_as_uint(m),__float_as_uint(m),false,false);
  return max2f(__uint_as_float(rr[0]),__uint_as_float(rr[1]));
}
__device__ __forceinline__ void pv(f32x16*o,int vb,bf16x8 pa0,bf16x8 pa1,bf16x8 pa2,bf16x8 pa3){
  #pragma unroll
  for(int d0=0;d0<2;++d0){s16x4 lo[4],hi[4];
    #pragma unroll
    for(int ks=0;ks<4;++ks){
      asm volatile("ds_read_b64_tr_b16 %0,%1 offset:%c2":"=&v"(lo[ks]):"v"(vb),"i"(d0*4096+ks*1024):"memory");
      asm volatile("ds_read_b64_tr_b16 %0,%1 offset:%c2":"=&v"(hi[ks]):"v"(vb),"i"(d0*4096+ks*1024+512):"memory");}
    asm volatile("s_waitcnt lgkmcnt(0)":::"memory");SBAR();
    #define PK(k) (bf16x8){lo[k][0],lo[k][1],lo[k][2],lo[k][3],hi[k][0],hi[k][1],hi[k][2],hi[k][3]}
    o[d0]=__builtin_amdgcn_mfma_f32_32x32x16_bf16(pa0,PK(0),o[d0],0,0,0);
    o[d0]=__builtin_amdgcn_mfma_f32_32x32x16_bf16(pa1,PK(1),o[d0],0,0,0);
    o[d0]=__builtin_amdgcn_mfma_f32_32x32x16_bf16(pa2,PK(2),o[d0],0,0,0);
    o[d0]=__builtin_amdgcn_mfma_f32_32x32x16_bf16(pa3,PK(3),o[d0],0,0,0);
    #undef PK
  }
}

#ifndef ATTN_STORE16
#define ATTN_STORE16(p,v) (*(u32x4*)(p)=(v))
#endif
typedef float f32x4v __attribute__((ext_vector_type(4)));
template<int THRL> __device__ __forceinline__ void attn_unit(int b,int h,int qb,const bf16*Q,const bf16*__restrict__ K,const bf16*__restrict__ V,bf16*O,const float*FB,const bf16*Z,const float*GN,const unsigned*QM,char*shm,const int tidx){
  const int tid=tidx,lane=tid&63,r32=lane&31,hi=lane>>5; const int wid=__builtin_amdgcn_readfirstlane(tid>>6);
  const long rowbase=(long)b*SEQ; const int q0=qb*QB;
  const bf16*Qw=Q+(rowbase+q0+wid*QBLK)*DM+h*D;
  const bf16*Kh=K+rowbase*DM+h*D,*Vh=V+rowbase*DM+h*D;
  const unsigned lds0=(unsigned)(uintptr_t)shm;
  float*wsf=(float*)(shm+LDS_WS)+wid*64;
  const unsigned ksrc=(unsigned)((lane*DM+wid*8)*2);
  const unsigned vsrc=(unsigned)(((16*(wid&3)+(lane>>2))*DM+(wid>>2)*32+(lane&3)*8)*2);
  const unsigned kdst=lds0+LDS_K+wid*1024, vdst=lds0+LDS_V+wid*1024;
  #define DMA_K(t,slot) glds16((const char*)Kh+(long)(NTP-1-(t))*(KVBLK*DM*2),ksrc,(unsigned)__builtin_amdgcn_readfirstlane(kdst+(slot)))
  #define DMA_V(t,slot) glds16((const char*)Vh+(long)(NTP-1-(t))*(KVBLK*DM*2),vsrc,(unsigned)__builtin_amdgcn_readfirstlane(vdst+(slot)))
  #define vb0 ((int)(lds0+LDS_V)+((lane>>4)&1)*32+(lane&3)*8+(4*hi+((lane&15)>>2))*64)
  const char*Kbase=shm+LDS_K; bf16x8 kf[8];
  const lds_cptr shm3=(lds_cptr)shm; const lds_cptr kp0=shm3+LDS_K+hi*1024+r32*16; const lds_cptr vp0=shm3+LDS_V+((lane>>4)&1)*32+(lane&3)*8+(4*hi+((lane&15)>>2))*64;
  const int NTP=(q0+QB)/KVBLK; int NT=NTP;
  { const float*fbh=FB+((long)b*NHEAD+h)*SEQ; __attribute__((address_space(3))) float*bl=(__attribute__((address_space(3))) float*)((__attribute__((address_space(3))) char*)shm+LDS_BIAS);
    const float thr_=fbh[q0]-(46.f+2.02f*sqrtf(__uint_as_float(QM[2*(b*NHEAD+h)])*__uint_as_float(QM[2*(b*NHEAD+h)+1]))); int cnt_=0;
    for(int i=tid*4;i<NTP*KVBLK;i+=NW*64*4){ const f32x4v v_=*(const f32x4v*)(fbh+i); *(__attribute__((address_space(3))) f32x4v*)(bl+i)=v_; cnt_+=(v_[0]<=thr_)+(v_[1]<=thr_)+(v_[2]<=thr_)+(v_[3]<=thr_); }
    _Pragma("unroll") for(int o_=1;o_<64;o_<<=1) cnt_+=__shfl_xor(cnt_,o_);
    if(lane==0) ((__attribute__((address_space(3))) int*)((__attribute__((address_space(3))) char*)shm+LDS_CNT))[wid]=cnt_; }
  #define biasL ((const __attribute__((address_space(3))) float*)(shm3+LDS_BIAS)+4*(lane>>5))
  DMA_K(0,0);DMA_V(0,0);DMA_K(1,SLOTB);
  bf16x8 qr[4];
  #pragma unroll
  for(int d0=0;d0<4;++d0)qr[d0]=*reinterpret_cast<const bf16x8*>(&Qw[(long)r32*DM+d0*16+hi*8]);
  float mhat=0.f,l_reg=0.f;f32x16 o[2];o[0]=f32x16{};o[1]=f32x16{};
  #define qrel (wid*QBLK+r32)
  #define CMASK(P0,P1,t) do{int jb_=3-(t); if(jb_>=0)cmask(P0,P1,jb_,qrel,hi);}while(0)
  bool resc=false;
  #define START(P0,P1) do{ const float rm=rowmax(P0,P1); resc=false; \
    { const float dl=(rm>-1e30f)?rm:0.f; mhat=fadd_s(mhat,dl); \
      _Pragma("unroll") for(int r=0;r<16;++r){P0[r]=fsub_s(P0[r],dl);P1[r]=fsub_s(P1[r],dl);} \
 } \
    _Pragma("unroll") for(int r=0;r<16;++r)P0[r]=__builtin_amdgcn_exp2f(P0[r]); }while(0)
  #define RESC() do{ if(resc){ asm volatile("s_waitcnt lgkmcnt(0)":::"memory"); \
      _Pragma("unroll") for(int d_=0;d_<2;++d_) _Pragma("unroll") for(int r=0;r<16;++r)o[d_][r]*=wsf[crow(r,hi)]; } }while(0)
  #define BIASINIT(C0,C1,t) do{ const __attribute__((address_space(3))) float*bp_=biasL+64*(NTP-1-(t)); \
    _Pragma("unroll") for(int g_=0;g_<4;++g_){ const f32x4v u0_=*(const __attribute__((address_space(3))) f32x4v*)(bp_+8*g_); const f32x4v u1_=*(const __attribute__((address_space(3))) f32x4v*)(bp_+32+8*g_); \
      _Pragma("unroll") for(int j_=0;j_<4;++j_){ C0[4*g_+j_]=u0_[j_]-mhat; C1[4*g_+j_]=u1_[j_]-mhat; } } }while(0)
  f32x16 pA0,pA1,pB0,pB1;
  int sl_prev=0,sl_cur=0,sl_next=SLOTB;
  #define ROT() do{sl_prev=sl_cur;sl_cur=sl_next;sl_next=(sl_next==(NSLOT-1)*SLOTB)?0:sl_next+SLOTB;}while(0)
  DMA_K(2,2*SLOTB);
  WAIT_BAR(3);
  { const __attribute__((address_space(3))) int*cl_=(const __attribute__((address_space(3))) int*)(shm3+LDS_CNT); int c_=0; _Pragma("unroll") for(int w_=0;w_<NW;++w_)c_+=cl_[w_];
    c_=__builtin_amdgcn_readfirstlane(c_); int nt_=NTP-(c_>>6); nt_=(nt_+1)&~1; nt_=nt_<4?4:nt_; NT=nt_>NTP?NTP:nt_; }
  mhat=(biasL-4*hi)[q0+qrel]; BIASINIT(pA0,pA1,0); qkt(pA0,pA1,Kbase,qr,r32,hi);asm volatile("s_nop 15\n\ts_nop 7":"+v"(pA0),"+v"(pA1));CMASK(pA0,pA1,0);
  START(pA0,pA1);
  _Pragma("unroll") for(int r=0;r<16;++r)pA1[r]=__builtin_amdgcn_exp2f(pA1[r]);
  WAIT_BAR(0);
  DMA_K(3,0);DMA_V(1,SLOTB);
  ROT();
  kload8(kf,kp0+sl_cur);
  WAIT_BAR(2);
  s16x4 vlo[8],vhi[8]; u32x4 pw0,pw1,pw2,pw3;
  #define PKW(P,B) cvtpk_s(P[B],P[B+1])
  #define PAF(k) __builtin_bit_cast(bf16x8,pw##k)
  #define VFR(i) (bf16x8){vlo[i][0],vlo[i][1],vlo[i][2],vlo[i][3],vhi[i][0],vhi[i][1],vhi[i][2],vhi[i][3]}
  #define PIN(x) asm volatile("":"+v"(x))
  #define MX3(a,b,c) __builtin_fmaxf(__builtin_fmaxf((a),(b)),(c))
  #define GAPA(MF,A0,A1,A2,A3,W0,W1,PW) do{ MF; sacc+=A0; sacc+=A1; sacc+=A2; sacc+=A3; PIN(sacc); W0; W1; PIN(PW); SBAR(); }while(0)
  #define EX(v) __builtin_amdgcn_exp2f(v)
  #define GAPB(MF,X,B) do{ MF; X[B]=EX(X[B]); X[B+1]=EX(X[B+1]); X[B+2]=EX(X[B+2]); X[B+3]=EX(X[B+3]); PIN(X); SBAR(); }while(0)
  #define VRD(i) do{ vlo[i]=vtr(vp_+(((i)>>2)*4096+((i)&3)*1024)); vhi[i]=vtr(vp_+(((i)>>2)*4096+((i)&3)*1024+512)); }while(0)
  #define KRD(G,j) do{ if(G){ kload2(kf,kp0+sl_next,j); SBAR(); } }while(0)
  #define STEP(C0,C1,P0,P1,t,GK,GV,GL) do{ SBAR(); BIASINIT(C0,C1,t); SBAR(); \
    const lds_cptr vp_=vp0+sl_prev; \
    VRD(0); SBAR(); float sacc=(P0[0]+P0[1]); \
    GAPA(C0=__builtin_amdgcn_mfma_f32_32x32x16_bf16(kf[0],qr[0],C0,0,0,0), P0[2],P0[3],P0[4],P0[5],     pw0[0]=PKW(P0,0), pw0[1]=PKW(P0,2), pw0); \
    VRD(4); SBAR(); GAPA(C1=__builtin_amdgcn_mfma_f32_32x32x16_bf16(kf[1],qr[0],C1,0,0,0), P0[6],P0[7],P0[8],P0[9],     pw0[2]=PKW(P0,4), pw0[3]=PKW(P0,6), pw0); \
    VRD(1); SBAR(); GAPA(C0=__builtin_amdgcn_mfma_f32_32x32x16_bf16(kf[2],qr[1],C0,0,0,0),   P0[10],P0[11],P0[12],P0[13], pw1[0]=PKW(P0,8), pw1[1]=PKW(P0,10), pw1); \
    VRD(5); SBAR(); GAPA(C1=__builtin_amdgcn_mfma_f32_32x32x16_bf16(kf[3],qr[1],C1,0,0,0),   P0[14],P0[15],P1[0],P1[1],   pw1[2]=PKW(P0,12),pw1[3]=PKW(P0,14), pw1); \
    VRD(2); SBAR(); GAPA(C0=__builtin_amdgcn_mfma_f32_32x32x16_bf16(kf[4],qr[2],C0,0,0,0),   P1[2],P1[3],P1[4],P1[5],     pw2[0]=PKW(P1,0), pw2[1]=PKW(P1,2), pw2); \
    VRD(6); SBAR(); GAPA(C1=__builtin_amdgcn_mfma_f32_32x32x16_bf16(kf[5],qr[2],C1,0,0,0),   P1[6],P1[7],P1[8],P1[9],     pw2[2]=PKW(P1,4), pw2[3]=PKW(P1,6), pw2); \
    VRD(3); SBAR(); GAPA(C0=__builtin_amdgcn_mfma_f32_32x32x16_bf16(kf[6],qr[3],C0,0,0,0),   P1[10],P1[11],P1[12],P1[13], pw3[0]=PKW(P1,8), pw3[1]=PKW(P1,10), pw3); \
    VRD(7); SBAR(); GAPA(C1=__builtin_amdgcn_mfma_f32_32x32x16_bf16(kf[7],qr[3],C1,0,0,0),   P1[14],P1[15],0.f,0.f,       pw3[2]=PKW(P1,12),pw3[3]=PKW(P1,14), pw3); \
    l_reg+=sacc; \
    if(GK){DMA_K((t)+3,sl_cur);} if(GV){DMA_V((t)+1,sl_next);} \
    CMASK(C0,C1,t); \
    { float a=MX3(C0[0],C0[1],C1[0]),b=MX3(C0[2],C0[3],C1[1]); a=MX3(a,C1[2],C1[3]); \
      _Pragma("unroll") for(int r=4;r<16;r+=4){a=MX3(a,C0[r],C0[r+1]);b=MX3(b,C0[r+2],C0[r+3]);a=MX3(a,C1[r],C1[r+1]);b=MX3(b,C1[r+2],C1[r+3]);} \
      float rm=__builtin_fmaxf(a,b); { auto rr=__builtin_amdgcn_permlane32_swap(__float_as_uint(rm),__float_as_uint(rm),false,false); rm=__builtin_fmaxf(__uint_as_float(rr[0]),__uint_as_float(rr[1])); } \
      resc=false; \
      if(__builtin_expect(__any(rm>(float)THRL),0)){ const float dl=__builtin_fmaxf(rm,0.f); mhat+=dl; \
        _Pragma("unroll") for(int r=0;r<16;++r){C0[r]-=dl;C1[r]-=dl;} \
        const float f=__builtin_amdgcn_exp2f(-dl); l_reg*=f; if(hi==0)wsf[r32]=f; resc=true; } } \
    SBAR(); \
    GAPB(o[0]=__builtin_amdgcn_mfma_f32_32x32x16_bf16(PAF(0),VFR(0),o[0],0,0,0), C0,0); \
    GAPB(o[1]=__builtin_amdgcn_mfma_f32_32x32x16_bf16(PAF(0),VFR(4),o[1],0,0,0), C0,4); \
    KRD(GL,0); GAPB(o[0]=__builtin_amdgcn_mfma_f32_32x32x16_bf16(PAF(1),VFR(1),o[0],0,0,0), C0,8); \
    KRD(GL,1); GAPB(o[1]=__builtin_amdgcn_mfma_f32_32x32x16_bf16(PAF(1),VFR(5),o[1],0,0,0), C0,12); \
    KRD(GL,2); GAPB(o[0]=__builtin_amdgcn_mfma_f32_32x32x16_bf16(PAF(2),VFR(2),o[0],0,0,0), C1,0); \
    KRD(GL,3); GAPB(o[1]=__builtin_amdgcn_mfma_f32_32x32x16_bf16(PAF(2),VFR(6),o[1],0,0,0), C1,4); \
    GAPB(o[0]=__builtin_amdgcn_mfma_f32_32x32x16_bf16(PAF(3),VFR(3),o[0],0,0,0), C1,8); \
    GAPB(o[1]=__builtin_amdgcn_mfma_f32_32x32x16_bf16(PAF(3),VFR(7),o[1],0,0,0), C1,12); \
    }while(0)
  int t=1;
  #define ENDW(tt) do{ if((tt)+3<NT){WAIT_BAR(2);} else if((tt)+2<NT){WAIT_BAR(1);} else {WAIT_BAR(0);} }while(0)
  for(;t+1<NT&&t<4;t+=2){
    STEP(pB0,pB1,pA0,pA1,t,(t+3<NT),(t+1<NT),(t+1<NT));       ENDW(t);   RESC(); ROT();
    STEP(pA0,pA1,pB0,pB1,t+1,(t+4<NT),(t+2<NT),(t+2<NT));     ENDW(t+1); RESC(); ROT();
  }
  #undef CMASK
  #define CMASK(P0,P1,t) do{}while(0)
  for(;t+5<NT;t+=2){
    STEP(pB0,pB1,pA0,pA1,t,true,true,true);     WAIT_BAR(2); RESC(); ROT();
    STEP(pA0,pA1,pB0,pB1,t+1,true,true,true);   WAIT_BAR(2); RESC(); ROT();
  }
  #undef CMASK
  #define CMASK(P0,P1,t) do{int jb_=3-(t); if(jb_>=0)cmask(P0,P1,jb_,qrel,hi);}while(0)
  for(;t+1<NT;t+=2){
    STEP(pB0,pB1,pA0,pA1,t,(t+3<NT),(t+1<NT),(t+1<NT));       ENDW(t);   RESC(); ROT();
    STEP(pA0,pA1,pB0,pB1,t+1,(t+4<NT),(t+2<NT),(t+2<NT));     ENDW(t+1); RESC(); ROT();
  }
  STEP(pB0,pB1,pA0,pA1,NT-1,false,false,false); RESC();
  { float sacc=pB0[0]+pB0[1]; _Pragma("unroll") for(int r=2;r<16;++r)sacc+=pB0[r]; _Pragma("unroll") for(int r=0;r<16;++r)sacc+=pB1[r]; l_reg+=sacc;
    pw0=(u32x4){PKW(pB0,0),PKW(pB0,2),PKW(pB0,4),PKW(pB0,6)};pw1=(u32x4){PKW(pB0,8),PKW(pB0,10),PKW(pB0,12),PKW(pB0,14)};pw2=(u32x4){PKW(pB1,0),PKW(pB1,2),PKW(pB1,4),PKW(pB1,6)};pw3=(u32x4){PKW(pB1,8),PKW(pB1,10),PKW(pB1,12),PKW(pB1,14)};
    SBAR(); pv(o,vb0+sl_cur,PAF(0),PAF(1),PAF(2),PAF(3)); }
  #undef PKW
  #undef PAF
  #undef VFR
  #undef PIN
  #undef MX3
  #undef GAPA
  #undef GAPB
  #undef EX
  #undef VRD
  #undef KRD
  #undef STEP
  #undef ENDW
  {auto rr=__builtin_amdgcn_permlane32_swap(__float_as_uint(l_reg),__float_as_uint(l_reg),false,false);l_reg=__uint_as_float(rr[0])+__uint_as_float(rr[1]);}
  if(hi==0)wsf[32+r32]=l_reg;asm volatile("s_waitcnt lgkmcnt(0)":::"memory");
  float rli[16];
  #pragma unroll
  for(int r=0;r<16;++r)rli[r]=__builtin_amdgcn_rcpf(wsf[32+crow(r,hi)]);
  bf16*Ow=O+(rowbase+q0+wid*QBLK)*DM+h*D; const bf16*Zw=Z+(rowbase+q0+wid*QBLK)*DM+h*D;
  { bf16*stg=(bf16*)(shm+LDS_OST)+wid*2048;
    #pragma unroll
    for(int r=0;r<16;++r){const int orow=crow(r,hi);
      #pragma unroll
      for(int d0=0;d0<2;++d0)stg[orow*64+d0*32+r32]=__float2bfloat16(o[d0][r]*rli[r]);}
    asm volatile("s_waitcnt lgkmcnt(0)":::"memory");
    #pragma unroll
    for(int i=0;i<4;++i){const int row=i*8+(lane>>3),ch=lane&7; const u32x4 v=*(const u32x4*)(stg+row*64+ch*8); const u32x4 zz=*(const u32x4*)(Zw+(long)row*DM+ch*8);
      float a[8]; float ss=0.f;
      _Pragma("unroll") for(int j=0;j<4;++j){a[2*j]=__uint_as_float(v[j]<<16);a[2*j+1]=__uint_as_float(v[j]&0xffff0000u);ss+=a[2*j]*a[2*j]+a[2*j+1]*a[2*j+1];}
      ss+=__shfl_xor(ss,1);ss+=__shfl_xor(ss,2);ss+=__shfl_xor(ss,4);
      const float rs=rsqrtf(ss*(1.f/64.f)+1e-6f); u32x4 w;
      _Pragma("unroll") for(int j=0;j<4;++j){const float z0=__uint_as_float(zz[j]<<16),z1=__uint_as_float(zz[j]&0xffff0000u);
        const float y0=a[2*j]*rs*GN[ch*8+2*j]*(z0/(1.f+__expf(-z0))), y1=a[2*j+1]*rs*GN[ch*8+2*j+1]*(z1/(1.f+__expf(-z1))); w[j]=cvtpk_s(y0,y1);}
      ATTN_STORE16(Ow+(long)row*DM+ch*8,w);} }
  asm volatile("s_waitcnt lgkmcnt(0)\n\ts_barrier":::"memory");
  #undef BIASINIT
  #undef biasL
  #undef qrel
  #undef vb0
  #undef DMA_K
  #undef DMA_V
  #undef CMASK
  #undef START
  #undef RESC
  #undef ROT
}
constexpr int ATTN_LDS_BYTES=LDS_BYTES;
struct AttnTensors { const bf16* Q; const bf16* K; const bf16* V; bf16* O; const float* FB; const bf16* Z; const float* GN; const unsigned* QM; unsigned* qctr; };
struct AttnUnit { int bh; int qb; };
struct StaticOrder {
  int vcu;
  __device__ __forceinline__ explicit StaticOrder(int grid,int block):vcu((block%8)*(grid/8)+block/8){}
  __device__ __forceinline__ bool next(int i,AttnUnit&u)const{ if(i>=4)return false; const int s=vcu&7; u.bh=vcu>>3; u.qb=(i==0)?s:(i==1)?15-s:(i==2)?16+s:31-s; return true; }
  __device__ __forceinline__ void a_ready(const AttnUnit&)const{}
  __device__ __forceinline__ void done(const AttnUnit&)const{}
};
struct QueueOrder {
  unsigned*ctr; char*lds; int tid;
  __device__ __forceinline__ bool next(int i,AttnUnit&u)const{ volatile __attribute__((address_space(3))) unsigned*sl=(volatile __attribute__((address_space(3))) unsigned*)((__attribute__((address_space(3))) char*)lds+LDS_QSLOT);
    if(tid==0) sl[i&1]=__hip_atomic_fetch_add(ctr,1u,__ATOMIC_RELAXED,__HIP_MEMORY_SCOPE_AGENT);
    __syncthreads(); const unsigned v=(unsigned)__builtin_amdgcn_readfirstlane((int)sl[i&1]); if(v>=(unsigned)(BATCH*NHEAD*NQB))return false; u.qb=NQB-1-(int)(v>>5); u.bh=(int)(v&31u); return true; }
  __device__ __forceinline__ void a_ready(const AttnUnit&)const{}
  __device__ __forceinline__ void done(const AttnUnit&)const{}
};
template<class Sched,int THRL=8> __device__ __forceinline__ void attn_phase(char*lds,const AttnTensors&T,const Sched&S,const int tidx){
  AttnUnit u;
  for(int i=0;S.next(i,u);++i){ S.a_ready(u); attn_unit<THRL>(u.bh/NHEAD,u.bh%NHEAD,u.qb,T.Q,T.K,T.V,T.O,T.FB,T.Z,T.GN,T.QM,lds,tidx); S.done(u); }
}
#undef SBAR
#undef WAIT_BAR
}
namespace pg8 {
typedef unsigned u32x2 __attribute__((ext_vector_type(2)));
__device__ __forceinline__ float bf_lo(unsigned w) { return __uint_as_float(w << 16); }
__device__ __forceinline__ float bf_hi(unsigned w) { return __uint_as_float(w & 0xffff0000u); }
struct EpiIn {
    static constexpr bool PERM = true, AFTER_DRAIN = false;
    bf16_t *ZS, *XBC, *ZA, *Q, *K, *V; float* DTF; float qscale;
    __device__ __forceinline__ void operator()(const f32x4 (&acc)[2][2][4][2], const Unit& u, int wr, int wc, int fr, int fq) const {
        const int pn = u.pn; const int row0 = u.pm * BM + wr * 64 + fr;
        if (pn == 26) {
            if (wc == 0) {
#pragma unroll
                for (int ai = 0; ai < 2; ++ai)
#pragma unroll
                    for (int m = 0; m < 4; ++m) { float* rowp = DTF + (size_t)(row0 + ai * HALF + m * 16) * 32 + 8 * fq;
                        *(f32x4*)(rowp) = acc[ai][0][m][0]; *(f32x4*)(rowp + 4) = acc[ai][0][m][1]; }
            }
            return;
        }
        bf16_t* base; int ldc, colt; float sc = 1.f;
        if (pn < 4) { base = ZS; ldc = 1024; colt = pn * 256; }
        else if (pn < 10) { base = XBC; ldc = 1536; colt = (pn - 4) * 256; }
        else if (pn < 14) { base = ZA; ldc = 1024; colt = (pn - 10) * 256; }
        else if (pn < 18) { base = Q; ldc = 1024; colt = (pn - 14) * 256; sc = qscale; }
        else if (pn < 22) { base = K; ldc = 1024; colt = (pn - 18) * 256; }
        else { base = V; ldc = 1024; colt = (pn - 22) * 256; }
        const int col0 = colt + wc * 32 + 8 * fq;
#pragma unroll
        for (int ai = 0; ai < 2; ++ai)
#pragma unroll
            for (int m = 0; m < 4; ++m) { bf16_t* rowp = base + (size_t)(row0 + ai * HALF + m * 16) * ldc + col0;
#pragma unroll
                for (int bj = 0; bj < 2; ++bj) { const f32x4 v0 = acc[ai][bj][m][0] * sc, v1 = acc[ai][bj][m][1] * sc;
                    u32x4 w; w.x = cvt_pk_bf16(v0[0], v0[1]); w.y = cvt_pk_bf16(v0[2], v0[3]); w.z = cvt_pk_bf16(v1[0], v1[1]); w.w = cvt_pk_bf16(v1[2], v1[3]);
                    *(u32x4*)(rowp + bj * HALF) = w; } }
    }
};
struct EpiRes {
    static constexpr bool PERM = false, AFTER_DRAIN = false;
    const float* base; float* out; int ldc;
    __device__ __forceinline__ void operator()(const f32x4 (&acc)[2][2][4][2], const Unit& u, int wr, int wc, int fr, int fq) const {
        const int col0 = u.pn * BM + wc * 32 + 4 * fq;
#pragma unroll
        for (int ai = 0; ai < 2; ++ai)
#pragma unroll
            for (int m = 0; m < 4; ++m) { const size_t off = (size_t)(u.pm * BM + ai * HALF + wr * 64 + m * 16 + fr) * ldc + col0;
#pragma unroll
                for (int bj = 0; bj < 2; ++bj)
#pragma unroll
                    for (int n = 0; n < 2; ++n) { const size_t o = off + bj * HALF + n * 16; *(f32x4*)(out + o) = *(const f32x4*)(base + o) + acc[ai][bj][m][n]; } }
    }
};
struct EpiGate {
    static constexpr bool PERM = false, AFTER_DRAIN = false;
    float* io; const bf16_t* PP; int ldc;
    __device__ __forceinline__ void operator()(const f32x4 (&acc)[2][2][4][2], const Unit& u, int wr, int wc, int fr, int fq) const {
        const int col0 = u.pn * BM + wc * 32 + 4 * fq;
#pragma unroll
        for (int ai = 0; ai < 2; ++ai)
#pragma unroll
            for (int m = 0; m < 4; ++m) { const size_t off = (size_t)(u.pm * BM + ai * HALF + wr * 64 + m * 16 + fr) * ldc + col0;
#pragma unroll
                for (int bj = 0; bj < 2; ++bj)
#pragma unroll
                    for (int n = 0; n < 2; ++n) { const size_t o = off + bj * HALF + n * 16; const f32x4 h = *(const f32x4*)(io + o); const u32x2 pw = *(const u32x2*)(PP + o);
                        const f32x4 a = acc[ai][bj][m][n]; f32x4 r;
                        r[0] = h[0] + bf_lo(pw.x) / (1.f + __expf(-a[0])); r[1] = h[1] + bf_hi(pw.x) / (1.f + __expf(-a[1]));
                        r[2] = h[2] + bf_lo(pw.y) / (1.f + __expf(-a[2])); r[3] = h[3] + bf_hi(pw.y) / (1.f + __expf(-a[3]));
                        *(f32x4*)(io + o) = r; } }
    }
};
}

namespace ssd {
#define LAS3 __attribute__((address_space(3)))
typedef unsigned short bf16_t;
typedef short bf16x8 __attribute__((ext_vector_type(8)));
typedef float f32x2 __attribute__((ext_vector_type(2)));
typedef float f32x4 __attribute__((ext_vector_type(4)));
typedef float f32x16 __attribute__((ext_vector_type(16)));
typedef unsigned u32x2 __attribute__((ext_vector_type(2)));
typedef unsigned u32x4 __attribute__((ext_vector_type(4)));
typedef __bf16 bf16x2_t __attribute__((ext_vector_type(2)));
__device__ __forceinline__ unsigned pk(float lo, float hi) { f32x2 v = {lo, hi}; bf16x2_t b = __builtin_convertvector(v, bf16x2_t); return __builtin_bit_cast(unsigned, b); }
__device__ __forceinline__ float bf1(bf16_t b) { return __uint_as_float((unsigned)b << 16); }
__device__ __forceinline__ float lo(unsigned w) { return __uint_as_float(w << 16); }
__device__ __forceinline__ float hi16(unsigned w) { return __uint_as_float(w & 0xffff0000u); }
__device__ __forceinline__ bf16_t tobf(float f) { return (bf16_t)(pk(f, 0.f) & 0xffffu); }
__device__ __forceinline__ int crow(int r, int hi) { return (r & 3) + 8 * (r >> 2) + 4 * hi; }
__device__ __forceinline__ bf16x8 pack8(const float* m) { u32x4 w; w.x = pk(m[0], m[1]); w.y = pk(m[2], m[3]); w.z = pk(m[4], m[5]); w.w = pk(m[6], m[7]); return __builtin_bit_cast(bf16x8, w); }
constexpr float LOG2E = 1.4426950408889634f;

constexpr int PRE_RAW = 0, PRE_OUT = 131 * 512, PRE_DT = PRE_OUT + 256 * 272, PRE_TOT = PRE_DT + 2048, PRE_END = PRE_TOT + 64;
__device__ __forceinline__ void pre_item(int item, const bf16_t* __restrict__ XBC, const float* __restrict__ DTF, const float* __restrict__ conv_w, const float* __restrict__ conv_b,
                                         const float* __restrict__ dt_bias, const float* __restrict__ a_log, bf16_t* __restrict__ XDTT, bf16_t* __restrict__ Bn, bf16_t* __restrict__ BT,
                                         bf16_t* __restrict__ Cn, float* __restrict__ ACS, float* __restrict__ DT, LAS3 unsigned char* lds, const int tidx) {
    const int tid = tidx, lane = tid & 63, wid = tid >> 6;
    const int chunk = item / 6, j = item - chunk * 6, c = chunk & 63;
    const long m0 = (long)chunk * 128;
    LAS3 bf16_t* RAW = (LAS3 bf16_t*)(lds + PRE_RAW);
    LAS3 bf16_t* OUT = (LAS3 bf16_t*)(lds + PRE_OUT);
    LAS3 float* s_dt = (LAS3 float*)(lds + PRE_DT);
    LAS3 float* s_tot = (LAS3 float*)(lds + PRE_TOT);
    __syncthreads();
    {
        u32x4 v[9];
#pragma unroll
        for (int i = 0; i < 9; ++i) { const int idx = tid + i * 512, r = idx >> 5, c16 = idx & 31; v[i] = (u32x4){0u, 0u, 0u, 0u};
            if (idx < 131 * 32 && !(c == 0 && r < 3)) v[i] = *(const u32x4*)(XBC + (m0 + r - 3) * 1536 + 256 * j + c16 * 8); }
#pragma unroll
        for (int i = 0; i < 9; ++i) { const int idx = tid + i * 512, r = idx >> 5, c16 = idx & 31; if (idx < 131 * 32) *(LAS3 u32x4*)(RAW + r * 256 + c16 * 8) = v[i]; }
    }
    float cs = 0.f, dtv = 0.f;
    if (j < 4) {
        const int hl = tid >> 7, l = tid & 127, h = 4 * j + hl;
        const float raw = DTF[(m0 + l) * 32 + h] + dt_bias[h];
        dtv = fmaxf(raw, 0.f) + log1pf(expf(-fabsf(raw)));
        cs = -expf(a_log[h]) * dtv;
#pragma unroll
        for (int o = 1; o < 64; o <<= 1) { const float t = __shfl_up(cs, o); if (lane >= o) cs += t; }
        if (lane == 63) s_tot[wid] = cs;
        s_dt[hl * 128 + l] = dtv;
    }
    __syncthreads();
    if (j < 4) {
        const int hl = tid >> 7, l = tid & 127, h = 4 * j + hl;
        if (wid & 1) cs += s_tot[wid - 1];
        ACS[((size_t)chunk * 16 + h) * 128 + l] = cs;
        DT[((size_t)chunk * 16 + h) * 128 + l] = dtv;
    }
    const int ch = tid & 255, half = tid >> 8, cx = 256 * j + ch, l0 = half * 64;
    const float w0 = conv_w[cx], w1 = conv_w[1536 + cx], w2 = conv_w[2 * 1536 + cx], w3 = conv_w[3 * 1536 + cx], cb = conv_b[cx];
    float xm3 = bf1(RAW[(l0 + 0) * 256 + ch]), xm2 = bf1(RAW[(l0 + 1) * 256 + ch]), xm1 = bf1(RAW[(l0 + 2) * 256 + ch]);
    __syncthreads();
    const int hl = ch >> 6;
    for (int g8 = 0; g8 < 8; ++g8) {
        float v[8];
        const int l = l0 + g8 * 8;
#pragma unroll
        for (int i = 0; i < 8; ++i) {
            const float xin = bf1(RAW[(l + i + 3) * 256 + ch]);
            const float cv = cb + w0 * xm3 + w1 * xm2 + w2 * xm1 + w3 * xin;
            xm3 = xm2; xm2 = xm1; xm1 = xin;
            v[i] = cv / (1.f + __expf(-cv));
        }
        if (j < 4) {
#pragma unroll
            for (int i = 0; i < 8; ++i) v[i] *= s_dt[hl * 128 + l + i];
        } else {
#pragma unroll
            for (int i = 0; i < 8; ++i) RAW[(l + i + 3) * 256 + ch] = tobf(v[i]);
        }
        if (j <= 4) *(LAS3 bf16x8*)(OUT + ch * 136 + l) = pack8(v);
    }
    __syncthreads();
    if (j <= 4) {
        bf16_t* dst = (j < 4) ? XDTT + ((size_t)chunk * 1024 + 256 * j) * 128 : BT + (size_t)chunk * 256 * 128;
#pragma unroll
        for (int i = 0; i < 8; ++i) { const int idx = tid + i * 512, row = idx >> 4, c16 = idx & 15; *(u32x4*)(dst + row * 128 + c16 * 8) = *(const LAS3 u32x4*)(OUT + row * 136 + c16 * 8); }
    }
    if (j >= 4) {
        bf16_t* dst = (j == 4 ? Bn : Cn) + m0 * 256;
#pragma unroll
        for (int i = 0; i < 8; ++i) { const int idx = tid + i * 512, row = idx >> 5, c16 = idx & 31; *(u32x4*)(dst + row * 256 + c16 * 8) = *(const LAS3 u32x4*)(RAW + (row + 3) * 256 + c16 * 8); }
    }
}
__device__ __forceinline__ void qkmax_item(int item, const bf16_t* __restrict__ Q, const bf16_t* __restrict__ K, unsigned* QM, const int tidx) {
    const int tid = tidx, lane = tid & 63, bh = item >> 3, seg = item & 7, b = bh >> 4, h = bh & 15;
    float mq = 0.f, mk = 0.f;
#pragma unroll
    for (int k = 0; k < 2; ++k) {
        const size_t base = ((size_t)b * 8192 + seg * 1024 + k * 512 + tid) * 1024 + h * 64;
        u32x4 q[8], kk[8];
#pragma unroll
        for (int i = 0; i < 8; ++i) { q[i] = *(const u32x4*)(Q + base + 8 * i); kk[i] = *(const u32x4*)(K + base + 8 * i); }
        float sq = 0.f, sk = 0.f;
#pragma unroll
        for (int i = 0; i < 8; ++i)
#pragma unroll
            for (int j = 0; j < 4; ++j) { sq += lo(q[i][j]) * lo(q[i][j]) + hi16(q[i][j]) * hi16(q[i][j]); sk += lo(kk[i][j]) * lo(kk[i][j]) + hi16(kk[i][j]) * hi16(kk[i][j]); }
        mq = fmaxf(mq, sq); mk = fmaxf(mk, sk);
    }
#pragma unroll
    for (int o = 1; o < 64; o <<= 1) { mq = fmaxf(mq, __shfl_xor(mq, o)); mk = fmaxf(mk, __shfl_xor(mk, o)); }
    if (lane == 0) { atomicMax(QM + 2 * bh, __float_as_uint(mq)); atomicMax(QM + 2 * bh + 1, __float_as_uint(mk)); }
}
__device__ __forceinline__ void fb_item(int bh, const float* __restrict__ DTF, const float* __restrict__ fg_bias, float* __restrict__ FB, LAS3 unsigned char* lds, const int tidx) {
    const int tid = tidx, lane = tid & 63, wid = tid >> 6, b = bh >> 4, h = bh & 15;
    LAS3 float* s_tot = (LAS3 float*)lds + 1024;
    __syncthreads();
    const float fb = fg_bias[h];
    float v[16]; float run = 0.f;
#pragma unroll
    for (int i = 0; i < 16; ++i) { const float x = DTF[((size_t)b * 8192 + tid * 16 + i) * 32 + 16 + h] + fb; run += fminf(x, 0.f) - log1pf(expf(-fabsf(x))); v[i] = run; }
    float s = run;
#pragma unroll
    for (int o = 1; o < 64; o <<= 1) { const float t = __shfl_up(s, o); if (lane >= o) s += t; }
    if (lane == 63) s_tot[wid] = s;
    __syncthreads();
    float off = s - run;
    for (int w = 0; w < wid; ++w) off += s_tot[w];
#pragma unroll
    for (int i = 0; i < 16; i += 4) { f32x4 o4; o4[0] = -(off + v[i]) * LOG2E; o4[1] = -(off + v[i + 1]) * LOG2E; o4[2] = -(off + v[i + 2]) * LOG2E; o4[3] = -(off + v[i + 3]) * LOG2E;
        *(f32x4*)(FB + (size_t)bh * 8192 + tid * 16 + i) = o4; }
}
constexpr int ST_BT = 0, ST_ACS = 128 * 272, ST_END = ST_ACS + 4096;
__device__ __forceinline__ void state_item(int item, const bf16_t* __restrict__ XDTT, const bf16_t* __restrict__ BT, const float* __restrict__ ACS, bf16_t* __restrict__ S, LAS3 unsigned char* lds, const int tidx) {
    const int tid = tidx, lane = tid & 63, wid = tid >> 6, r32 = lane & 31, hi = lane >> 5;
    const int chunk = item >> 1, g = item & 1, h = g * 8 + wid;
    LAS3 bf16_t* BTs = (LAS3 bf16_t*)(lds + ST_BT);
    LAS3 float* s_acs = (LAS3 float*)(lds + ST_ACS) + wid * 128;
    __syncthreads();
    { const bf16_t* src = BT + ((size_t)chunk * 256 + g * 128) * 128; u32x4 v[4];
#pragma unroll
      for (int i = 0; i < 4; ++i) { const int idx = tid + i * 512; v[i] = *(const u32x4*)(src + (idx >> 4) * 128 + (idx & 15) * 8); }
#pragma unroll
      for (int i = 0; i < 4; ++i) { const int idx = tid + i * 512; *(LAS3 u32x4*)(BTs + (idx >> 4) * 136 + (idx & 15) * 8) = v[i]; } }
    { const float* acs = ACS + ((size_t)chunk * 16 + h) * 128; s_acs[lane] = acs[lane]; s_acs[lane + 64] = acs[lane + 64]; }
    const bf16_t* xa = XDTT + ((size_t)chunk * 1024 + h * 64 + r32) * 128 + 8 * hi;
    u32x4 xr[2][8];
#pragma unroll
    for (int pt = 0; pt < 2; ++pt)
#pragma unroll
        for (int ks = 0; ks < 8; ++ks) xr[pt][ks] = *(const u32x4*)(xa + (size_t)pt * 32 * 128 + 16 * ks);
    __syncthreads();
    const float aend = s_acs[127];
    bf16_t* sp = S + ((size_t)chunk * 16 + h) * 8192 + r32;
#pragma unroll 1
    for (int nh = 0; nh < 2; ++nh) {
        f32x16 acc[2][2];
#pragma unroll
        for (int a = 0; a < 2; ++a)
#pragma unroll
            for (int b = 0; b < 2; ++b) acc[a][b] = f32x16{};
#pragma unroll
        for (int ks = 0; ks < 8; ++ks) {
            const f32x4 a0 = *(const LAS3 f32x4*)(s_acs + 16 * ks + 8 * hi), a1 = *(const LAS3 f32x4*)(s_acs + 16 * ks + 8 * hi + 4);
            float wv[8];
#pragma unroll
            for (int i = 0; i < 4; ++i) { wv[i] = __expf(aend - a0[i]); wv[4 + i] = __expf(aend - a1[i]); }
            bf16x8 A[2], B[2];
#pragma unroll
            for (int pt = 0; pt < 2; ++pt) { float m[8];
#pragma unroll
                for (int i = 0; i < 4; ++i) { m[2 * i] = lo(xr[pt][ks][i]) * wv[2 * i]; m[2 * i + 1] = hi16(xr[pt][ks][i]) * wv[2 * i + 1]; }
                A[pt] = pack8(m); }
#pragma unroll
            for (int nt = 0; nt < 2; ++nt) B[nt] = *(const LAS3 bf16x8*)(BTs + (32 * (2 * nh + nt) + r32) * 136 + 16 * ks + 8 * hi);
#pragma unroll
            for (int pt = 0; pt < 2; ++pt)
#pragma unroll
                for (int nt = 0; nt < 2; ++nt) acc[pt][nt] = __builtin_amdgcn_mfma_f32_32x32x16_bf16(A[pt], B[nt], acc[pt][nt], 0, 0, 0);
        }
#pragma unroll
        for (int pt = 0; pt < 2; ++pt)
#pragma unroll
            for (int nt = 0; nt < 2; ++nt)
#pragma unroll
                for (int r = 0; r < 16; ++r) sp[(32 * pt + crow(r, hi)) * 128 + 32 * (2 * nh + nt)] = tobf(acc[pt][nt][r]);
    }
}
__device__ __forceinline__ void scan_pair(int gt, bf16_t* __restrict__ S, const float* __restrict__ ACS) {
    const int b = gt >> 16, h = (gt >> 12) & 15, idx = gt & 4095;
    unsigned* S32 = (unsigned*)S;
    float h0 = 0.f, h1 = 0.f;
    for (int c0 = 0; c0 < 64; c0 += 16) {
        unsigned sv[16]; float cd[16];
#pragma unroll
        for (int i = 0; i < 16; ++i) { const size_t ch = (size_t)(b * 64 + c0 + i) * 16 + h; sv[i] = S32[ch * 4096 + idx]; cd[i] = ACS[ch * 128 + 127]; }
#pragma unroll
        for (int i = 0; i < 16; ++i) { const size_t ch = (size_t)(b * 64 + c0 + i) * 16 + h; S32[ch * 4096 + idx] = pk(h0, h1); const float e = __expf(cd[i]); h0 = h0 * e + lo(sv[i]); h1 = h1 * e + hi16(sv[i]); }
    }
}
constexpr int O_CS = 0, O_CB = 128 * 272, O_ACS = 2 * 128 * 272, O_DT = O_ACS + 4096, O_SSQ = O_DT + 4096, O_RSTD = O_SSQ + 4096, O_YST = O_RSTD + 512, OUT_LDS_END = O_YST + 8 * 32 * 144;
__device__ __forceinline__ void out_item(int item, const bf16_t* __restrict__ XDTT, const bf16_t* __restrict__ Bn, const bf16_t* __restrict__ Cn, const float* __restrict__ ACS,
                                         const float* __restrict__ DT, const bf16_t* __restrict__ PREV, const bf16_t* ZS, bf16_t* YS, const float* __restrict__ d_skip,
                                         const float* __restrict__ gnorm, LAS3 unsigned char* lds, const int tidx) {
    const int tid = tidx, lane = tid & 63, wid = tid >> 6, r32 = lane & 31, hi = lane >> 5;
    const int chunk = item >> 1, g = item & 1, h = g * 8 + wid;
    const size_t m0 = (size_t)chunk * 128;
    LAS3 bf16_t* CS = (LAS3 bf16_t*)(lds + O_CS);
    LAS3 bf16_t* CB = (LAS3 bf16_t*)(lds + O_CB);
    LAS3 float* s_acs = (LAS3 float*)(lds + O_ACS) + wid * 128;
    LAS3 float* s_dt = (LAS3 float*)(lds + O_DT) + wid * 128;
    LAS3 float* s_ssq = (LAS3 float*)(lds + O_SSQ);
    LAS3 float* s_rstd = (LAS3 float*)(lds + O_RSTD);
    LAS3 bf16_t* YST = (LAS3 bf16_t*)(lds + O_YST) + wid * (32 * 72);
    __syncthreads();
    { const bf16_t* src = Cn + m0 * 256 + g * 128; u32x4 v[4];
#pragma unroll
      for (int i = 0; i < 4; ++i) { const int idx = tid + i * 512; v[i] = *(const u32x4*)(src + (idx >> 4) * 256 + (idx & 15) * 8); }
#pragma unroll
      for (int i = 0; i < 4; ++i) { const int idx = tid + i * 512; *(LAS3 u32x4*)(CS + (idx >> 4) * 136 + (idx & 15) * 8) = v[i]; } }
    { const float* ap = ACS + ((size_t)chunk * 16 + h) * 128; const float* dp = DT + ((size_t)chunk * 16 + h) * 128;
      s_acs[lane] = ap[lane]; s_acs[lane + 64] = ap[lane + 64]; s_dt[lane] = dp[lane]; s_dt[lane + 64] = dp[lane + 64]; }
    const bf16_t* pv = PREV + (((size_t)chunk * 16 + h) * 64 + r32) * 128 + 8 * hi;
    __syncthreads();
#pragma unroll
    for (int bi = 0; bi < 2; ++bi) {
        const int blk = wid * 2 + bi, lb = blk >> 2, sb = blk & 3;
        if (sb <= lb) {
            f32x16 acc = f32x16{};
            const bf16_t* ba = Bn + (m0 + 32 * sb + r32) * 256 + g * 128 + 8 * hi;
            bf16x8 bfr[8];
#pragma unroll
            for (int ks = 0; ks < 8; ++ks) bfr[ks] = *(const bf16x8*)(ba + 16 * ks);
#pragma unroll
            for (int ks = 0; ks < 8; ++ks) acc = __builtin_amdgcn_mfma_f32_32x32x16_bf16(*(const LAS3 bf16x8*)(CS + (32 * lb + r32) * 136 + 16 * ks + 8 * hi), bfr[ks], acc, 0, 0, 0);
#pragma unroll
            for (int r = 0; r < 16; ++r) CB[(32 * lb + crow(r, hi)) * 136 + 32 * sb + r32] = tobf(acc[r]);
        }
    }
    __syncthreads();
    const bf16_t* xt = XDTT + ((size_t)chunk * 1024 + h * 64 + r32) * 128;
    const float dsk = d_skip[h];
    const int orow = lane >> 3, c8 = lane & 7;
    const size_t gbase = m0 * 1024 + h * 64 + c8 * 8;
#pragma unroll 1
    for (int lb = 0; lb < 4; ++lb) {
        f32x16 yd[2], yo[2]; yd[0] = f32x16{}; yd[1] = f32x16{}; yo[0] = f32x16{}; yo[1] = f32x16{};
        const int lrow = 32 * lb + r32;
        { bf16x8 pvf[2][8];
#pragma unroll
          for (int pt = 0; pt < 2; ++pt)
#pragma unroll
              for (int ks = 0; ks < 8; ++ks) pvf[pt][ks] = *(const bf16x8*)(pv + pt * 4096 + 16 * ks);
#pragma unroll
          for (int ks = 0; ks < 8; ++ks) {
            const bf16x8 a = *(const LAS3 bf16x8*)(CS + lrow * 136 + 16 * ks + 8 * hi);
            yo[0] = __builtin_amdgcn_mfma_f32_32x32x16_bf16(a, pvf[0][ks], yo[0], 0, 0, 0);
            yo[1] = __builtin_amdgcn_mfma_f32_32x32x16_bf16(a, pvf[1][ks], yo[1], 0, 0, 0);
          } }
        asm volatile("" ::: "memory");
        const float al = s_acs[lrow];
#pragma unroll 1
        for (int sb = 0; sb <= lb; ++sb) {
            bf16x8 xb[2][2];
#pragma unroll
            for (int k2 = 0; k2 < 2; ++k2)
#pragma unroll
                for (int pt = 0; pt < 2; ++pt) xb[k2][pt] = *(const bf16x8*)(xt + pt * 4096 + 32 * sb + 16 * k2 + 8 * hi);
#pragma unroll
            for (int k2 = 0; k2 < 2; ++k2) {
                const int s0 = 32 * sb + 16 * k2 + 8 * hi;
                const u32x4 cw = *(const LAS3 u32x4*)(CB + lrow * 136 + s0);
                const f32x4 e0 = *(const LAS3 f32x4*)(s_acs + s0), e1 = *(const LAS3 f32x4*)(s_acs + s0 + 4);
                float m[8];
#pragma unroll
                for (int i = 0; i < 4; ++i) { const float ea = (i < 2) ? e0[2 * i] : e1[2 * i - 4], eb = (i < 2) ? e0[2 * i + 1] : e1[2 * i - 3];
                    m[2 * i] = (s0 + 2 * i <= lrow) ? lo(cw[i]) * __expf(fminf(al - ea, 0.f)) : 0.f;
                    m[2 * i + 1] = (s0 + 2 * i + 1 <= lrow) ? hi16(cw[i]) * __expf(fminf(al - eb, 0.f)) : 0.f; }
                const bf16x8 a = pack8(m);
                yd[0] = __builtin_amdgcn_mfma_f32_32x32x16_bf16(a, xb[k2][0], yd[0], 0, 0, 0);
                yd[1] = __builtin_amdgcn_mfma_f32_32x32x16_bf16(a, xb[k2][1], yd[1], 0, 0, 0);
            }
        }
#pragma unroll
        for (int g4 = 0; g4 < 4; ++g4) {
            const int lq = 32 * lb + 8 * g4 + 4 * hi;
            const f32x4 ea = *(const LAS3 f32x4*)(s_acs + lq), dq = *(const LAS3 f32x4*)(s_dt + lq);
#pragma unroll
            for (int pt = 0; pt < 2; ++pt) {
                const u32x2 xw = *(const u32x2*)(xt + pt * 4096 + lq);
                const float xv[4] = {lo(xw.x), hi16(xw.x), lo(xw.y), hi16(xw.y)};
#pragma unroll
                for (int jj = 0; jj < 4; ++jj) { const int r = 4 * g4 + jj;
                    const float y = yd[pt][r] + __expf(ea[jj]) * yo[pt][r] + dsk * xv[jj] / dq[jj];
                    YST[(8 * g4 + 4 * hi + jj) * 72 + 32 * pt + r32] = tobf(y); }
            }
        }
        asm volatile("s_waitcnt lgkmcnt(0)" ::: "memory");
#pragma unroll
        for (int i = 0; i < 4; ++i) {
            const int row = i * 8 + orow;
            const u32x4 v = *(const LAS3 u32x4*)(YST + row * 72 + c8 * 8);
            const size_t go = gbase + (size_t)(32 * lb + row) * 1024;
            const u32x4 zz = *(const u32x4*)(ZS + go);
            u32x4 w; float ss = 0.f;
#pragma unroll
            for (int jj = 0; jj < 4; ++jj) { const float z0 = lo(zz[jj]), z1 = hi16(zz[jj]);
                const float y0 = lo(v[jj]) * (z0 / (1.f + __expf(-z0))), y1 = hi16(v[jj]) * (z1 / (1.f + __expf(-z1)));
                ss += y0 * y0 + y1 * y1; w[jj] = pk(y0, y1); }
            ss += __shfl_xor(ss, 1); ss += __shfl_xor(ss, 2); ss += __shfl_xor(ss, 4);
            if (c8 == 0) s_ssq[wid * 128 + 32 * lb + row] = ss;
            *(u32x4*)(YS + go) = w;
        }
        asm volatile("s_waitcnt lgkmcnt(0)" ::: "memory");
    }
    __syncthreads();
    if (tid < 128) { float t = 0.f;
#pragma unroll
        for (int w = 0; w < 8; ++w) t += s_ssq[w * 128 + tid];
        s_rstd[tid] = rsqrtf(t * (1.f / 512.f) + 1e-6f); }
    __syncthreads();
    const f32x4 gn0 = *(const f32x4*)(gnorm + h * 64 + c8 * 8), gn1 = *(const f32x4*)(gnorm + h * 64 + c8 * 8 + 4);
#pragma unroll 1
    for (int lb = 0; lb < 4; ++lb)
#pragma unroll
        for (int i = 0; i < 4; ++i) {
            const int row = 32 * lb + i * 8 + orow; const float rs = s_rstd[row];
            const size_t go = gbase + (size_t)row * 1024;
            const u32x4 v = *(const u32x4*)(YS + go); u32x4 w;
            w[0] = pk(lo(v[0]) * rs * gn0[0], hi16(v[0]) * rs * gn0[1]); w[1] = pk(lo(v[1]) * rs * gn0[2], hi16(v[1]) * rs * gn0[3]);
            w[2] = pk(lo(v[2]) * rs * gn1[0], hi16(v[2]) * rs * gn1[1]); w[3] = pk(lo(v[3]) * rs * gn1[2], hi16(v[3]) * rs * gn1[3]);
            *(u32x4*)(YS + go) = w;
        }
}
}
#include <hip/hip_cooperative_groups.h>
namespace cg = cooperative_groups;
#define LAS __attribute__((address_space(3)))
#define GAS __attribute__((address_space(1)))
typedef unsigned short bf16;
typedef unsigned v4u __attribute__((ext_vector_type(4)));
typedef float f32x4 __attribute__((ext_vector_type(4)));
typedef GAS unsigned gu32;
#define RLX_AGENT __ATOMIC_RELAXED, __HIP_MEMORY_SCOPE_AGENT
#define XB_TMO      128
#define XB_XCNT(j)  (256  + 64 * (j))
#define XB_XSUB(j)  (1280 + 64 * (j))
#define XB_XGEN(j)  (2304 + 64 * (j))
#define XB_TOP      3328
#define XB_TOPGEN   3392
#define XCD_BAR_WORDS 3456
#define XB_SPIN_CAP (1u << 18)

__device__ __forceinline__ unsigned xb_ld(unsigned* p)              { return __hip_atomic_load(p, __ATOMIC_RELAXED, __HIP_MEMORY_SCOPE_AGENT); }
__device__ __forceinline__ unsigned xb_add(unsigned* p, unsigned v) { return __hip_atomic_fetch_add(p, v, __ATOMIC_RELAXED, __HIP_MEMORY_SCOPE_AGENT); }
__device__ __forceinline__ unsigned xb_xcc_id() { return (unsigned)__builtin_amdgcn_s_getreg((3 << 11) | 20) & 0xFu; }
#define XB_SPIN(cond, bar) do { unsigned _sp = 0; while (cond) { __builtin_amdgcn_s_sleep(1); \
    if ((++_sp & 255u) == 0u) { if (xb_ld(&(bar)[XB_TMO])) break; if (_sp > XB_SPIN_CAP) { atomicAdd(&(bar)[XB_TMO], 1u); break; } } } } while (0)

struct XcdBarrier {
    unsigned* bar; unsigned x;
    volatile LAS unsigned* st;
};

__device__ __forceinline__ XcdBarrier xcd_barrier_post(unsigned* bar, volatile LAS unsigned* st, const int tidx) {
    XcdBarrier b; b.bar = bar; b.x = xb_xcc_id(); b.st = st;
    if (tidx == 0) (void)xb_add(&bar[XB_XCNT(b.x)], 1u);
    return b;
}
__device__ __forceinline__ void xcd_barrier_complete(unsigned* bar, unsigned x, unsigned& nloc, unsigned& nx) {
    const unsigned G = gridDim.x * gridDim.y * gridDim.z;
    unsigned sum, cnt, mine, sp = 0u;
    for (;;) {
        sum = 0u; cnt = 0u; mine = 0u;
#pragma unroll
        for (unsigned j = 0; j < 16; ++j) { const unsigned c = xb_ld(&bar[XB_XCNT(j)]); sum += c; cnt += (c > 0u) ? 1u : 0u; mine = (j == x) ? c : mine; }
        if (sum == G) break;
        __builtin_amdgcn_s_sleep(1);
        if ((++sp & 255u) == 0u) { if (xb_ld(&bar[XB_TMO])) break; if (sp > XB_SPIN_CAP) { atomicAdd(&bar[XB_TMO], 1u); break; } }
    }
    nloc = mine > 0u ? mine : 1u; nx = cnt > 0u ? cnt : 1u;
}

__device__ __forceinline__ void xcd_barrier(const XcdBarrier& b, const int tidx) {
    asm volatile("s_waitcnt vmcnt(0)" ::: "memory");
    __syncthreads();
    if (tidx == 0) {
        unsigned* bar = b.bar;
        __builtin_amdgcn_s_waitcnt(0);
        unsigned nloc = b.st[0], nx = b.st[1];
        if (nloc == 0u) { xcd_barrier_complete(bar, b.x, nloc, nx); b.st[0] = nloc; b.st[1] = nx; }
        const unsigned old = xb_add(&bar[XB_XSUB(b.x)], 1u);
        const unsigned gen = old / nloc;
        if (old + 1u == (gen + 1u) * nloc) {
            __builtin_amdgcn_fence(__ATOMIC_RELEASE, "agent");
            asm volatile("s_waitcnt vmcnt(0)" ::: "memory");
            const unsigned og = xb_add(&bar[XB_TOP], 1u);
            const unsigned tg = og / nx;
            if (og + 1u == (tg + 1u) * nx) xb_add(&bar[XB_TOPGEN], 1u);
            else XB_SPIN(xb_ld(&bar[XB_TOPGEN]) == tg, bar);
            __builtin_amdgcn_fence(__ATOMIC_ACQUIRE, "agent");
            xb_add(&bar[XB_XGEN(b.x)], 1u);
            asm volatile("s_waitcnt vmcnt(0)" ::: "memory");
        } else {
            XB_SPIN(xb_ld(&bar[XB_XGEN(b.x)]) == gen, bar);
            __builtin_amdgcn_fence(__ATOMIC_ACQUIRE, "agent");
            asm volatile("s_waitcnt vmcnt(0)" ::: "memory");
        }
    }
    __syncthreads();
}

constexpr int NWAVES = 8;
constexpr int LDS_BAR_OFF = 147456 - 64;
constexpr int CW_QKMAX = 8192, CW_QCTR = 8192 + 128;
constexpr size_t CTL_ZERO_BYTES = 65536;
constexpr int M = 16384, DM = 1024, NINP = 6912, NINR = 6688, DIN = 2048, PLE = 256;
constexpr size_t MiB = 1u << 20;
constexpr size_t WS_WOUT = 1 * MiB, WS_WGATE = 5 * MiB, WS_WPROJ = 7 * MiB, WS_ZS = 8 * MiB, WS_ZA = 40 * MiB, WS_Q = 72 * MiB, WS_K = 104 * MiB, WS_V = 136 * MiB,
                 WS_XBC = 168 * MiB, WS_DTF = 216 * MiB, WS_S = 168 * MiB, WS_PB = 232 * MiB, WS_PP = WS_Q, WS_HN = WS_K, WS_END = 240 * MiB;
constexpr size_t OS_U = 0, OS_WIN = 32 * MiB;
constexpr size_t OS_XDTT = 0, OS_BN = 32 * MiB, OS_BT = 40 * MiB, OS_CN = 48 * MiB, OS_ACS = 56 * MiB, OS_DT = 57 * MiB, OS_FB = 58 * MiB;
constexpr int LDS_BYTES = 147456;
static_assert(attn_body::LDS_BYTES <= 131072 && ssd::OUT_LDS_END <= 147456 && ssd::PRE_END <= 147456 && ssd::ST_END <= 147456, "LDS");

__device__ __forceinline__ unsigned f2bf(float f) { unsigned u = __builtin_bit_cast(unsigned, f); return (u + 0x7fffu + ((u >> 16) & 1u)) >> 16; }
__device__ __forceinline__ unsigned pk2(float lo, float hi) { return f2bf(lo) | (f2bf(hi) << 16); }
__device__ __forceinline__ float wave_sum(float v) {
#pragma unroll
    for (int o = 1; o < 64; o <<= 1) v += __shfl_xor(v, o);
    return v;
}
__device__ __forceinline__ int map_in_row(int n) { return n < 2560 ? n : (n < 2576 ? n + 4096 : (n < 6672 ? n - 16 : n)); }
template <bool MAP> __device__ __forceinline__ void p0_transpose_item(const float* W, int K, int N, bf16* WT, LAS float* scr, int item, int lane) {
    const int nblk = N / 32, kb = item / nblk, nb = item % nblk, k0 = 64 * kb, n0 = 32 * nb;
    { f32x4 v[8];
#pragma unroll
      for (int i = 0; i < 8; ++i) v[i] = *(const f32x4*)(W + (size_t)(k0 + 8 * i + (lane >> 3)) * N + n0 + 4 * (lane & 7));
#pragma unroll
      for (int i = 0; i < 8; ++i) { LAS float* d = scr + (8 * i + (lane >> 3)) * 33 + 4 * (lane & 7); d[0] = v[i].x; d[1] = v[i].y; d[2] = v[i].z; d[3] = v[i].w; } }
    asm volatile("s_waitcnt lgkmcnt(0)" ::: "memory");
    const int c = lane & 7;
#pragma unroll
    for (int j = 0; j < 4; ++j) { const int n = (lane >> 3) + 8 * j; const LAS float* s = scr + (8 * c) * 33 + n;
        v4u o; o.x = pk2(s[0 * 33], s[1 * 33]); o.y = pk2(s[2 * 33], s[3 * 33]); o.z = pk2(s[4 * 33], s[5 * 33]); o.w = pk2(s[6 * 33], s[7 * 33]);
        const int row = MAP ? map_in_row(n0 + n) : (n0 + n);
        *(v4u*)(WT + (size_t)row * K + k0 + 8 * c) = o; }
    asm volatile("s_waitcnt lgkmcnt(0)" ::: "memory");
}
__device__ __forceinline__ void rms_row_to_bf16(const float* xrow, const float* gain, bf16* orow, int lane) {
    const f32x4* xr = (const f32x4*)xrow + lane; const f32x4* gr = (const f32x4*)gain + lane;
    f32x4 v[4]; float s = 0.f;
#pragma unroll
    for (int j = 0; j < 4; ++j) { v[j] = xr[64 * j]; s += (v[j].x * v[j].x + v[j].y * v[j].y) + (v[j].z * v[j].z + v[j].w * v[j].w); }
    const float rstd = rsqrtf(wave_sum(s) * (1.f / 1024.f) + 1e-6f);
    unsigned long long* o8 = (unsigned long long*)orow + lane;
#pragma unroll
    for (int j = 0; j < 4; ++j) { const f32x4 gg = gr[64 * j];
        o8[64 * j] = (unsigned long long)pk2(v[j].x * rstd * gg.x, v[j].y * rstd * gg.y) | ((unsigned long long)pk2(v[j].z * rstd * gg.z, v[j].w * rstd * gg.w) << 32); }
}
template <int NR> __device__ __forceinline__ void rms_rows_to_bf16(const float* x, const float* gain, bf16* o, size_t m0, size_t rstride, int lane) {
    f32x4 v[NR][4]; float s[NR];
#pragma unroll
    for (int r = 0; r < NR; ++r) { const f32x4* xr = (const f32x4*)(x + (m0 + r * rstride) * 1024) + lane;
#pragma unroll
        for (int j = 0; j < 4; ++j) v[r][j] = xr[64 * j]; }
    const f32x4* gr = (const f32x4*)gain + lane; f32x4 gg[4];
#pragma unroll
    for (int j = 0; j < 4; ++j) gg[j] = gr[64 * j];
#pragma unroll
    for (int r = 0; r < NR; ++r) { float t = 0.f;
#pragma unroll
        for (int j = 0; j < 4; ++j) t += (v[r][j].x * v[r][j].x + v[r][j].y * v[r][j].y) + (v[r][j].z * v[r][j].z + v[r][j].w * v[r][j].w);
        s[r] = rsqrtf(wave_sum(t) * (1.f / 1024.f) + 1e-6f); }
#pragma unroll
    for (int r = 0; r < NR; ++r) { unsigned long long* o8 = (unsigned long long*)(o + (m0 + r * rstride) * 1024) + lane;
#pragma unroll
        for (int j = 0; j < 4; ++j) o8[64 * j] = (unsigned long long)pk2(v[r][j].x * s[r] * gg[j].x, v[r][j].y * s[r] * gg[j].y) | ((unsigned long long)pk2(v[r][j].z * s[r] * gg[j].z, v[r][j].w * s[r] * gg[j].w) << 32); }
}
template <int NR> __device__ __forceinline__ void rms_rows_inplace(float* x, const float* gain, size_t m0, size_t rstride, int lane) {
    f32x4 v[NR][4]; float s[NR];
#pragma unroll
    for (int r = 0; r < NR; ++r) { const f32x4* xr = (const f32x4*)(x + (m0 + r * rstride) * 1024) + lane;
#pragma unroll
        for (int j = 0; j < 4; ++j) v[r][j] = xr[64 * j]; }
    const f32x4* gr = (const f32x4*)gain + lane; f32x4 gg[4];
#pragma unroll
    for (int j = 0; j < 4; ++j) gg[j] = gr[64 * j];
#pragma unroll
    for (int r = 0; r < NR; ++r) { float t = 0.f;
#pragma unroll
        for (int j = 0; j < 4; ++j) t += (v[r][j].x * v[r][j].x + v[r][j].y * v[r][j].y) + (v[r][j].z * v[r][j].z + v[r][j].w * v[r][j].w);
        s[r] = rsqrtf(wave_sum(t) * (1.f / 1024.f) + 1e-6f); }
#pragma unroll
    for (int r = 0; r < NR; ++r) { f32x4* xr = (f32x4*)(x + (m0 + r * rstride) * 1024) + lane;
#pragma unroll
        for (int j = 0; j < 4; ++j) xr[64 * j] = v[r][j] * s[r] * gg[j]; }
}
__device__ __forceinline__ void rms_row_inplace(float* xrow, const float* gain, int lane) {
    f32x4* xr = (f32x4*)xrow + lane; const f32x4* gr = (const f32x4*)gain + lane;
    f32x4 v[4]; float s = 0.f;
#pragma unroll
    for (int j = 0; j < 4; ++j) { v[j] = xr[64 * j]; s += (v[j].x * v[j].x + v[j].y * v[j].y) + (v[j].z * v[j].z + v[j].w * v[j].w); }
    const float rstd = rsqrtf(wave_sum(s) * (1.f / 1024.f) + 1e-6f);
#pragma unroll
    for (int j = 0; j < 4; ++j) xr[64 * j] = v[j] * rstd * gr[64 * j];
}

#ifndef MK_SPLIT
#define MK_SPLIT 0
#endif
__device__ __forceinline__ int mk_lane() { int l; asm volatile("v_mbcnt_lo_u32_b32 %0, -1, 0\n\tv_mbcnt_hi_u32_b32 %0, -1, %0" : "=v"(l)); return l; }
__device__ __forceinline__ int mk_tid(int wave_s) { return wave_s * 64 + mk_lane(); }
struct Args { const float* in[17]; float* out; unsigned char* ws; int ph_lo, ph_hi; };
__global__ void __launch_bounds__(NWAVES * 64, 2) mega_fwd(Args args) {
    extern __shared__ __attribute__((aligned(16))) unsigned char lds[];
    cg::grid_group grid = cg::this_grid();
    LAS unsigned char* L = (LAS unsigned char*)lds;
    int wave_s = __builtin_amdgcn_readfirstlane((int)(threadIdx.x >> 6)); asm volatile("" : "+s"(wave_s));
#define lane (mk_lane())
#define tid (mk_tid(wave_s))
#define wave wave_s
#define G ((int)gridDim.x)
#define bx ((int)blockIdx.x)
#define gw (bx * NWAVES + wave)
#define NGW (G * NWAVES)
    typedef const __attribute__((address_space(4))) Args* cargs_t;
#define ARGP(A) cargs_t A = (cargs_t)__builtin_amdgcn_kernarg_segment_ptr(); asm volatile("" : "+s"(A)); unsigned char* ws = A->ws; unsigned char* os = (unsigned char*)A->out; (void)ws; (void)os
#define Wout_t ((bf16*)(ws + WS_WOUT))
#define Wgate_t ((bf16*)(ws + WS_WGATE))
#define Wproj_t ((bf16*)(ws + WS_WPROJ))
#define ZS ((bf16*)(ws + WS_ZS))
#define ZA ((bf16*)(ws + WS_ZA))
#define Qb ((bf16*)(ws + WS_Q))
#define Kb ((bf16*)(ws + WS_K))
#define Vb ((bf16*)(ws + WS_V))
#define XBC ((bf16*)(ws + WS_XBC))
#define DTF ((float*)(ws + WS_DTF))
#define Sst ((ssd::bf16_t*)(ws + WS_S))
#define PB ((bf16*)(ws + WS_PB))
#define PP ((bf16*)(ws + WS_PP))
#define HN ((bf16*)(ws + WS_HN))
#define U ((bf16*)(os + OS_U))
#define Win_t ((bf16*)(os + OS_WIN))
#define XDTT ((bf16*)(os + OS_XDTT))
#define Bn ((bf16*)(os + OS_BN))
#define BT ((bf16*)(os + OS_BT))
#define Cn ((bf16*)(os + OS_CN))
#define ACS ((float*)(os + OS_ACS))
#define DTb ((float*)(os + OS_DT))
#define FB ((float*)(os + OS_FB))
    int lo, hi; { ARGP(A0); lo = A0->ph_lo; hi = A0->ph_hi; }
    if (tid < 16) ((LAS unsigned*)(L + LDS_BAR_OFF))[tid] = 0u;
    __syncthreads();
    XcdBarrier xbar; { ARGP(A1); xbar = xcd_barrier_post((unsigned*)A1->ws, (volatile LAS unsigned*)(L + LDS_BAR_OFF), tid); }
    if (lo > 1000) grid.sync();
#ifdef DBG_ONLY
#define IN(k) ((k) == DBG_ONLY)
#else
#define IN(k) (lo <= (k) && (k) < hi)
#endif
#ifndef PROBE_MASK
#define PROBE_MASK 0
#endif
#if PROBE_MASK
    unsigned long long pr_prev = __builtin_amdgcn_s_memrealtime(), pr_acc = 0ull;
#define SEAM(k) do { if (IN(k) && IN((k) + 1)) xcd_barrier(xbar, tid); { const unsigned long long t_ = __builtin_amdgcn_s_memrealtime(); if ((PROBE_MASK >> (k)) & 1) pr_acc += t_ - pr_prev; pr_prev = t_; } } while (0)
#else
#define SEAM(k) do { if (IN(k) && IN((k) + 1)) xcd_barrier(xbar, tid); } while (0)
#endif

    if (IN(0)) { ARGP(A);
        LAS float* scr = (LAS float*)(L + wave * 16384);
        constexpr int I_IN = 16 * 209, I_OUT = 32 * 32, I_GATE = 16 * 32, I_PROJ = 4 * 32, NITEMS = I_IN + I_OUT + I_GATE + I_PROJ;
        for (int it = gw; it < NITEMS; it += NGW) {
            int r = it;
            if (r < I_IN) { p0_transpose_item<true>(A->in[3], 1024, NINR, Win_t, scr, r, lane); continue; } r -= I_IN;
            if (r < I_OUT) { p0_transpose_item<false>(A->in[12], 2048, 1024, Wout_t, scr, r, lane); continue; } r -= I_OUT;
            if (r < I_GATE) { p0_transpose_item<false>(A->in[14], 1024, 1024, Wgate_t, scr, r, lane); continue; } r -= I_GATE;
            p0_transpose_item<false>(A->in[15], 256, 1024, Wproj_t, scr, r, lane);
        }
        { v4u* z = (v4u*)(Win_t + (size_t)NINR * 1024); const int nz = (NINP - NINR) * 1024 * 2 / 16;
          for (int i = bx * 512 + tid; i < nz; i += G * 512) z[i] = (v4u){0u, 0u, 0u, 0u}; }
        for (int m = gw; m + 3 * NGW < M; m += 4 * NGW) rms_rows_to_bf16<4>(A->in[0], A->in[2], U, (size_t)m, (size_t)NGW, lane);
    }
    SEAM(0);
    if (IN(1)) { ARGP(A);
        pg8::Gemm g{U, Win_t, M, NINP, 1024, 1024, 1 << 30, 0}; pg8::StaticOrder S; S.init(M, NINP, G, bx);
        pg8::EpiIn E{ZS, XBC, ZA, Qb, Kb, Vb, DTF, attn_body::C2};
        pg8::gemm_phase<pg8::EpiIn, pg8::StaticOrder, true, true>(L, g, S, E, tid);
    }
    SEAM(1);
    if (IN(2)) { ARGP(A);
        for (int it = bx; it < 1056; it += G) {
            if (it >= 800) ssd::qkmax_item(it - 800, Qb, Kb, (unsigned*)ws + CW_QKMAX, tid);
            else if (it < 768) ssd::pre_item(it, XBC, DTF, A->in[4], A->in[5], A->in[6], A->in[7], XDTT, Bn, BT, Cn, ACS, DTb, L, tid);
            else ssd::fb_item(it - 768, DTF, A->in[10], FB, L, tid);
        }
    }
    SEAM(2);
    if (IN(3)) { ARGP(A); for (int it = bx; it < 256; it += G) ssd::state_item(it, XDTT, BT, ACS, Sst, L, tid); }
    SEAM(3);
    if (IN(4)) { ARGP(A);
        for (int gt = bx * 512 + tid; gt < 131072; gt += G * 512) ssd::scan_pair(gt, Sst, ACS);
        __syncthreads();
        const attn_body::AttnTensors AT{(const attn_body::bf16*)Qb, (const attn_body::bf16*)Kb, (const attn_body::bf16*)Vb, (attn_body::bf16*)ZA, FB, (const attn_body::bf16*)ZA, A->in[11], (const unsigned*)ws + CW_QKMAX, (unsigned*)ws + CW_QCTR};
        const attn_body::QueueOrder S{AT.qctr, (char*)lds, tid};
        attn_body::attn_phase<attn_body::QueueOrder>((char*)lds, AT, S, tid);
    }
    SEAM(4);
    if (IN(5)) { ARGP(A);
        for (int it = bx; it < 256; it += G) ssd::out_item(it, XDTT, Bn, Cn, ACS, DTb, Sst, ZS, ZS, A->in[8], A->in[9], L, tid);
        { const f32x4* ps = (const f32x4*)A->in[1]; unsigned long long* pd = (unsigned long long*)PB; const int n4 = M * PLE / 4;
          for (int i = bx * 512 + tid; i < n4; i += G * 512) { const f32x4 v = ps[i]; pd[i] = (unsigned long long)pk2(v.x, v.y) | ((unsigned long long)pk2(v.z, v.w) << 32); } }
    }
    SEAM(5);
    if (IN(6)) { ARGP(A);
        { pg8::Gemm g{ZS, Wout_t, M, 1024, 2048, 1024, 16, (long)(WS_ZA - WS_ZS) - 2048}; pg8::StaticOrder S; S.init(M, 1024, G, bx);
          pg8::EpiRes E{A->in[0], ((float*)os), 1024};
          pg8::gemm_phase<pg8::EpiRes, pg8::StaticOrder, true, true>(L, g, S, E, tid); }
        { pg8::Gemm g{PB, Wproj_t, M, 1024, 256, 256, 1 << 30, 0}; pg8::StaticOrder S; S.init(M, 1024, G, bx);
          pg8::EpiBf16<0> E{PP, 1024, nullptr, 0, 0, 1.f};
          pg8::gemm_phase<pg8::EpiBf16<0>, pg8::StaticOrder, true, true>(L, g, S, E, tid); }
    }
    SEAM(6);
    if (IN(7)) { ARGP(A); for (int m = gw; m + 3 * NGW < M; m += 4 * NGW) rms_rows_to_bf16<4>(((float*)os), A->in[13], HN, (size_t)m, (size_t)NGW, lane); }
    SEAM(7);
    if (IN(8)) { ARGP(A);
        pg8::Gemm g{HN, Wgate_t, M, 1024, 1024, 1024, 1 << 30, 0}; pg8::StaticOrder S; S.init(M, 1024, G, bx);
        pg8::EpiGate E{((float*)os), PP, 1024};
        pg8::gemm_phase<pg8::EpiGate, pg8::StaticOrder, true, true>(L, g, S, E, tid);
    }
    SEAM(8);
    if (IN(9)) { ARGP(A); for (int m = gw; m + 3 * NGW < M; m += 4 * NGW) rms_rows_inplace<4>(((float*)os), A->in[16], (size_t)m, (size_t)NGW, lane); }
#if PROBE_MASK
    { __syncthreads(); const unsigned long long t_ = __builtin_amdgcn_s_memrealtime(); if ((PROBE_MASK >> 9) & 1) pr_acc += t_ - pr_prev;
      if (bx == 0) { while (__builtin_amdgcn_s_memrealtime() - t_ < pr_acc) __builtin_amdgcn_s_sleep(8); } }
#endif
#undef IN
#undef SEAM
#undef tid
#undef lane
#undef wave
#undef G
#undef bx
#undef gw
#undef NGW
}

extern "C" void kernel_launch(void* const* d_in, const int* in_sizes, int n_in, void* d_out, int out_size, void* d_ws, size_t ws_size, hipStream_t stream) {
    static int grid = 0;
    if (grid == 0) {
        if (n_in != 17 || out_size != M * DM || ws_size < WS_END) { fprintf(stderr, "kernel_launch: unexpected shapes (n_in %d out %d ws %zu)\n", n_in, out_size, ws_size); grid = -1; return; }
        int dev = 0, cus = 0, per_cu = 0;
        hipGetDevice(&dev); hipDeviceGetAttribute(&cus, hipDeviceAttributeMultiprocessorCount, dev);
        if (hipFuncSetAttribute((const void*)mega_fwd, hipFuncAttributeMaxDynamicSharedMemorySize, LDS_BYTES) != hipSuccess) { fprintf(stderr, "kernel_launch: hipFuncSetAttribute failed\n"); grid = -1; return; }
        hipOccupancyMaxActiveBlocksPerMultiprocessor(&per_cu, (const void*)mega_fwd, NWAVES * 64, LDS_BYTES);
        (void)hipGetLastError();
        grid = 256;
        if (cus * per_cu < grid) { fprintf(stderr, "kernel_launch: device cannot hold 256 co-resident workgroups (cus %d per_cu %d)\n", cus, per_cu); grid = -1; return; }
    }
    if (grid < 0) return;
    if (hipMemsetAsync(d_ws, 0, CTL_ZERO_BYTES, stream) != hipSuccess) { fprintf(stderr, "kernel_launch: memset failed\n"); return; }
    Args a{};
    for (int i = 0; i < 17; ++i) a.in[i] = (const float*)d_in[i];
    a.out = (float*)d_out; a.ws = (unsigned char*)d_ws;
#if MK_SPLIT
    for (int ph = 0; ph < 10; ++ph) { a.ph_lo = ph; a.ph_hi = ph + 1; void* kargs[] = {&a};
        hipLaunchCooperativeKernel((const void*)mega_fwd, dim3(grid), dim3(NWAVES * 64), kargs, LDS_BYTES, stream); }
#else
    a.ph_lo = 0; a.ph_hi = 10; void* kargs[] = {&a};
    hipError_t e = hipLaunchCooperativeKernel((const void*)mega_fwd, dim3(grid), dim3(NWAVES * 64), kargs, LDS_BYTES, stream);
    if (e != hipSuccess) fprintf(stderr, "cooperative launch failed: %s\n", hipGetErrorString(e));
#endif
}
```
